# Optimizing an MI355X kernel written in HIP

```python
import jax, jax.numpy as jnp
from jax import lax
import numpy as np

D_MODEL = 1024
BATCH = 8
SEQ = 4096
DEPTH = 1

N_HEADS_A = 8
HEAD_DIM_A = 64
N_IDX_HEADS = 8
IDX_DIM = 64
TOPK_MAX = 256
Q_BLOCK = 128
N_HEADS_B = 4
HEAD_K_B = 128
HEAD_V_B = 128
CHUNK_B = 64
N_HEADS_C = 4
HEAD_DIM_C = 128
MEM_LEN = 256
N_BRANCH = 3
EPS = 1e-6

WIDTH_A = N_HEADS_A * HEAD_DIM_A
WIDTH_BK = N_HEADS_B * HEAD_K_B
WIDTH_BV = N_HEADS_B * HEAD_V_B
WIDTH_C = N_HEADS_C * HEAD_DIM_C
BRANCH_WIDTH = WIDTH_A
IDX_SCALE = (IDX_DIM ** -0.5) * (N_IDX_HEADS ** -0.5)
IN_SPLITS = (WIDTH_A, WIDTH_A, WIDTH_A, WIDTH_A,
             N_IDX_HEADS * IDX_DIM, IDX_DIM, N_IDX_HEADS,
             WIDTH_BK, WIDTH_BK, WIDTH_BV, WIDTH_BV,
             WIDTH_C, WIDTH_C,
             N_BRANCH * D_MODEL)
N_IN = sum(IN_SPLITS)

kernel_name = "hybrid_dsa_hgrn2_memxattn_gated"


def rms_norm(x, g):
    xf = x.astype(jnp.float32)
    y = xf * lax.rsqrt(jnp.mean(xf * xf, axis=-1, keepdims=True) + EPS)
    return (y * g.astype(jnp.float32)).astype(x.dtype)


def alibi_slopes(n):
    return jnp.exp2(-8.0 * (jnp.arange(n, dtype=jnp.float32) + 1.0) / n)


def dsa_attention(q, k, v, qi, ki, wi):
    B, S = q.shape[0], q.shape[1]
    topk = min(TOPK_MAX, S // 4)
    nb = S // Q_BLOCK
    slopes = alibi_slopes(N_HEADS_A)
    neg = jnp.finfo(jnp.float32).min
    kif = ki.astype(jnp.float32)
    spos = jnp.arange(S, dtype=jnp.int32)

    def to_blocks(a):
        return jnp.swapaxes(a.reshape((B, nb, Q_BLOCK) + a.shape[2:]), 0, 1)

    def block(args):
        qb, qib, wib, start = args
        tpos = start + jnp.arange(Q_BLOCK, dtype=jnp.int32)
        rel = jnp.einsum('bthd,bsd->bths', qib.astype(jnp.float32), kif)
        score = jnp.einsum('bths,bth->bts', jax.nn.relu(rel), wib.astype(jnp.float32)) * IDX_SCALE
        causal = spos[None, :] <= tpos[:, None]
        score = jnp.where(causal[None], score, -jnp.inf)
        _, idx = lax.top_k(score, topk)
        kg = jax.vmap(lambda kk, ii: kk[ii])(k, idx)
        vg = jax.vmap(lambda vv, ii: vv[ii])(v, idx)
        logits = jnp.einsum('bthd,btkhd->bhtk', qb, kg).astype(jnp.float32) * (HEAD_DIM_A ** -0.5)
        dist = (tpos[None, :, None] - idx).astype(jnp.float32)
        logits = logits - slopes[None, :, None, None] * dist[:, None]
        valid = idx <= tpos[None, :, None]
        logits = jnp.where(valid[:, None], logits, neg)
        p = jax.nn.softmax(logits, axis=-1).astype(v.dtype)
        return jnp.einsum('bhtk,btkhd->bthd', p, vg)

    starts = jnp.arange(nb, dtype=jnp.int32) * Q_BLOCK
    o = lax.map(block, (to_blocks(q), to_blocks(qi), to_blocks(wi), starts))
    return jnp.swapaxes(o, 0, 1).reshape(B, S, N_HEADS_A, HEAD_DIM_A)


def hgrn2_recurrence(q, f_pre, i, lb):
    B, S = q.shape[0], q.shape[1]
    n = S // CHUNK_B
    f = lb + (1.0 - lb) * jax.nn.sigmoid(f_pre.astype(jnp.float32))
    logf = jnp.log(f)
    kk = 1.0 - f

    def chunks(a, d):
        return a.astype(jnp.float32).reshape(B, n, CHUNK_B, N_HEADS_B, d).transpose(1, 0, 3, 2, 4)

    qs, ks, gs = chunks(q, HEAD_K_B), chunks(kk, HEAD_K_B), chunks(logf, HEAD_K_B)
    vs = chunks(i, HEAD_V_B)
    tril = jnp.tril(jnp.ones((CHUNK_B, CHUNK_B), dtype=bool))

    def step(state, inp):
        qc, kc, vc, gc = inp
        b = jnp.cumsum(gc, axis=-2)
        diff = b[..., :, None, :] - b[..., None, :, :]
        decay = jnp.exp(jnp.where(tril[:, :, None], diff, -jnp.inf))
        scores = jnp.einsum('bhtsd,bhsd->bhts', qc[..., :, None, :] * decay, kc)
        o = (jnp.einsum('bhts,bhsv->bhtv', scores, vc)
             + jnp.einsum('bhtd,bhdv->bhtv', qc * jnp.exp(b), state))
        b_last = b[..., -1:, :]
        state = (jnp.exp(b_last[..., 0, :])[..., None] * state
                 + jnp.einsum('bhsd,bhsv->bhdv', kc * jnp.exp(b_last - b), vc))
        return state, o

    s0 = jnp.zeros((B, N_HEADS_B, HEAD_K_B, HEAD_V_B), jnp.float32)
    _, o = lax.scan(step, s0, (qs, ks, vs, gs))
    return o.transpose(1, 0, 3, 2, 4).reshape(B, S, N_HEADS_B, HEAD_V_B).astype(i.dtype)


def memory_attention(q, k, v):
    logits = jnp.einsum('bthd,bmhd->bhtm', q, k).astype(jnp.float32) * (HEAD_DIM_C ** -0.5)
    p = jax.nn.softmax(logits, axis=-1).astype(v.dtype)
    return jnp.einsum('bhtm,bmhd->bthd', p, v)


def hybrid_layer(x, mem, norm_in, norm_mem, w_in, q_norm_a, k_norm_a, lb,
                 o_norm_b, w_mem_kv, q_norm_c, k_norm_c, w_branch, w_out):
    B, S, _ = x.shape
    M = mem.shape[1]
    h = rms_norm(x, norm_in)
    proj = h @ w_in
    offsets = np.cumsum(IN_SPLITS)[:-1].tolist()
    (qa, ka, va, za, qi, ki, wi, qb, fb, ib, gb, qc, zc, gates) = jnp.split(proj, offsets, axis=-1)

    qa = rms_norm(qa.reshape(B, S, N_HEADS_A, HEAD_DIM_A), q_norm_a)
    ka = rms_norm(ka.reshape(B, S, N_HEADS_A, HEAD_DIM_A), k_norm_a)
    va = va.reshape(B, S, N_HEADS_A, HEAD_DIM_A)
    oa = dsa_attention(qa, ka, va, qi.reshape(B, S, N_IDX_HEADS, IDX_DIM), ki, wi)
    oa = oa.reshape(B, S, WIDTH_A) * jax.nn.silu(za)

    ob = hgrn2_recurrence(jax.nn.silu(qb), fb, ib, lb)
    ob = rms_norm(ob, o_norm_b).reshape(B, S, WIDTH_BV) * jax.nn.silu(gb)

    mkv = rms_norm(mem, norm_mem) @ w_mem_kv
    kc, vc = jnp.split(mkv, 2, axis=-1)
    kc = rms_norm(kc.reshape(B, M, N_HEADS_C, HEAD_DIM_C), k_norm_c)
    vc = vc.reshape(B, M, N_HEADS_C, HEAD_DIM_C)
    qc = rms_norm(qc.reshape(B, S, N_HEADS_C, HEAD_DIM_C), q_norm_c)
    oc = memory_attention(qc, kc, vc).reshape(B, S, WIDTH_C) * jax.nn.silu(zc)

    branches = jnp.stack([oa, ob, oc], axis=2)
    ys = jnp.einsum('bsnc,ncd->bsnd', branches, w_branch)
    g = jax.nn.sigmoid(gates.reshape(B, S, N_BRANCH, D_MODEL))
    merged = jnp.einsum('bsnd,bsnd->bsd', g, ys)
    return x + merged @ w_out


def setup_inputs(seed: int = 0) -> dict:
    key = jax.random.key(seed)
    ks = jax.random.split(key, 14)
    f32 = jnp.float32

    def gain(k, shape):
        return 1.0 + 0.1 * jax.random.normal(k, shape, f32)

    return {
        "x": jax.random.normal(ks[0], (BATCH, SEQ, D_MODEL), f32),
        "mem": jax.random.normal(ks[1], (BATCH, MEM_LEN, D_MODEL), f32),
        "norm_in": gain(ks[2], (DEPTH, D_MODEL)),
        "norm_mem": gain(ks[3], (DEPTH, D_MODEL)),
        "w_in": jax.random.normal(ks[4], (DEPTH, D_MODEL, N_IN), f32) * D_MODEL ** -0.5,
        "q_norm_a": gain(ks[5], (DEPTH, HEAD_DIM_A)),
        "k_norm_a": gain(ks[6], (DEPTH, HEAD_DIM_A)),
        "lower_bounds": 0.1 * jax.random.normal(ks[7], (DEPTH + 1, WIDTH_BK), f32),
        "o_norm_b": gain(ks[8], (DEPTH, HEAD_V_B)),
        "w_mem_kv": jax.random.normal(ks[9], (DEPTH, D_MODEL, 2 * WIDTH_C), f32) * D_MODEL ** -0.5,
        "q_norm_c": gain(ks[10], (DEPTH, HEAD_DIM_C)),
        "k_norm_c": gain(ks[11], (DEPTH, HEAD_DIM_C)),
        "w_branch": jax.random.normal(ks[12], (DEPTH, N_BRANCH, BRANCH_WIDTH, D_MODEL), f32) * BRANCH_WIDTH ** -0.5,
        "w_out": jax.random.normal(ks[13], (DEPTH, D_MODEL, D_MODEL), f32) * D_MODEL ** -0.5,
    }


def reference(x, mem, norm_in, norm_mem, w_in, q_norm_a, k_norm_a, lower_bounds,
              o_norm_b, w_mem_kv, q_norm_c, k_norm_c, w_branch, w_out):
    lb_all = jnp.cumsum(jax.nn.softmax(lower_bounds.astype(jnp.float32), axis=0), axis=0)
    for layer in range(DEPTH):
        x = hybrid_layer(x, mem, norm_in[layer], norm_mem[layer], w_in[layer],
                         q_norm_a[layer], k_norm_a[layer], lb_all[layer],
                         o_norm_b[layer], w_mem_kv[layer], q_norm_c[layer], k_norm_c[layer],
                         w_branch[layer], w_out[layer])
    return x
```

```cpp
#include <hip/hip_runtime.h>
#include <hip/hip_cooperative_groups.h>
#include <cstdio>
#include <cstdint>
#define N_LAUNCH_MODE 1
namespace pg8 {
#define PG8_LAS __attribute__((address_space(3)))
typedef unsigned short bf16_t;
typedef short bf16x8 __attribute__((ext_vector_type(8)));
typedef float f32x4 __attribute__((ext_vector_type(4)));
typedef unsigned u32x4 __attribute__((ext_vector_type(4)));
constexpr int BM = 256, BK = 64, HALF = 128, HTB = HALF * BK * 2  , STAGE_BYTES = 8 * HTB, NXCD = 8, WGM = 8;

__host__ __device__ __forceinline__ int lds_byte(int r, int c) { const int st = (r >> 4) * 2 + (c >> 5), rr = r & 15, cc = c & 31, ob = rr * 64 + cc * 2; return st * 1024 + (ob ^ (((ob >> 9) & 1) << 5)); }
__host__ __device__ __forceinline__ void stage_rc(int b, int& R, int& C) { const int st = b / 1024, sb = b % 1024, swz = sb ^ (((sb >> 9) & 1) << 5); R = (st >> 1) * 16 + swz / 64; C = (st & 1) * 32 + (swz % 64) / 2; }
__host__ __device__ __forceinline__ int perm32(int rho) { const int n = rho >> 4, i = rho & 15; return 8 * (i >> 2) + 4 * n + (i & 3); }

struct Unit { int pm, pn, n; };
struct Gemm { const bf16_t* A; const bf16_t* Bt; int M, N, K; };
constexpr float F8_DESCALE = 1.f / 256.f;

struct StaticOrder {
    int nM, nN, nwg, G, c;
    __host__ __device__ void init(int M, int N, int G_, int c_) { nM = M / BM; nN = N / BM; nwg = nM * nN; G = G_; c = c_; }
    __host__ __device__ bool next(int i, Unit& u) const {
        const long L = (long)i * G + c; if (L >= nwg) return false;
        int wgid = (int)L; { const int q = nwg / NXCD, r = nwg % NXCD, xcd = wgid % NXCD, off = wgid / NXCD; wgid = (xcd < r ? xcd * (q + 1) : r * (q + 1) + (xcd - r) * q) + off; }
        const int nig = WGM * nN, gid = wgid / nig, fm = gid * WGM, gsz = (nM - fm) < WGM ? (nM - fm) : WGM;
        u.pm = fm + ((wgid % nig) % gsz); u.pn = (wgid % nig) / gsz; u.n = 0; return true;
    }
    __device__ __forceinline__ const char* abase(const Gemm& g, const Unit&) const { return (const char*)g.A; }
    __device__ __forceinline__ const char* bbase(const Gemm& g, const Unit&) const { return (const char*)g.Bt; }
    __device__ __forceinline__ void a_ready(const Unit&) const {}
    __device__ __forceinline__ void done(const Unit&) const {}
};

struct SkipOrder {
    StaticOrder so; int lo, skip;
    __host__ __device__ bool next(int i, Unit& u) const { if (!so.next(i, u)) return false; if (u.pn >= lo) u.pn += skip; return true; }
    __device__ __forceinline__ const char* abase(const Gemm& g, const Unit&) const { return (const char*)g.A; }
    __device__ __forceinline__ const char* bbase(const Gemm& g, const Unit&) const { return (const char*)g.Bt; }
    __device__ __forceinline__ void a_ready(const Unit&) const {}
    __device__ __forceinline__ void done(const Unit&) const {}
};

struct MergeOrder {
    StaticOrder so; const char* a0; const char* b0; long da1, da2, db1, db2;
    __host__ __device__ bool next(int i, Unit& u) const { const int t = i / 3; if (!so.next(t, u)) return false; u.n = i - 3 * t; return true; }
    __device__ __forceinline__ const char* abase(const Gemm&, const Unit& u) const { const long m1 = -(long)(u.n == 1), m2 = -(long)(u.n == 2); return a0 + ((da1 & m1) | (da2 & m2)); }
    __device__ __forceinline__ const char* bbase(const Gemm&, const Unit& u) const { const long m1 = -(long)(u.n == 1), m2 = -(long)(u.n == 2); return b0 + ((db1 & m1) | (db2 & m2)); }
    __device__ __forceinline__ void a_ready(const Unit&) const {}
    __device__ __forceinline__ void done(const Unit&) const {}
};

__device__ __forceinline__ unsigned cvt_pk_bf16(float lo, float hi) { unsigned r; asm volatile("v_cvt_pk_bf16_f32 %0, %1, %2" : "=v"(r) : "v"(lo), "v"(hi)); return r; }
typedef float f32x2 __attribute__((ext_vector_type(2)));
__device__ __forceinline__ f32x2 gelu_pk(f32x2 v) {
    const f32x2 av = __builtin_elementwise_abs(v), d = av * 0.2316418882f + 1.0f;
    f32x2 t; t.x = __builtin_amdgcn_rcpf(d.x); t.y = __builtin_amdgcn_rcpf(d.y);
    f32x2 q = t * 0.5307027145f + (-0.7265760135f); q = q * t + 0.7107068705f; q = q * t + (-0.142248368f); q = q * t + 0.127414796f; q = q * t;
    const f32x2 s = (v * v) * (-0.72134752044f);
    f32x2 e; e.x = __builtin_amdgcn_exp2f(s.x); e.y = __builtin_amdgcn_exp2f(s.y);
    const f32x2 m = v * (q * e), r = v - m;
    f32x2 o; o.x = v.x < 0.f ? m.x : r.x; o.y = v.y < 0.f ? m.y : r.y; return o;
}

template <int ACT  > struct EpiBf16 {
    static constexpr bool PERM = true, AFTER_DRAIN = false; static_assert(ACT == 0 || ACT == 1, "EpiBf16: ACT is 0 (none) or 1 (gelu_pk)");
    bf16_t* O; int ldc; const float* bias; int split_cols; size_t split_stride; float scale0;
    __device__ __forceinline__ void operator()(const f32x4 (&acc)[2][2][4][2], const Unit& u, int wr, int wc, int fr, int fq) const {
        const int row0 = u.pm * BM + wr * 64 + fr; int colt = u.pn * BM; bf16_t* base = O;
        float sc = 1.f; if (split_cols) { const int t = colt / split_cols; base += (size_t)t * split_stride; colt -= t * split_cols; if (t == 0) sc = scale0; }
        const int col0 = colt + wc * 32 + 8 * fq, bcol0 = u.pn * BM + wc * 32 + 8 * fq;
        f32x4 bv[2][2];
#pragma unroll
        for (int bj = 0; bj < 2; ++bj)
#pragma unroll
            for (int n = 0; n < 2; ++n) bv[bj][n] = bias ? *(const f32x4*)(bias + bcol0 + bj * HALF + 4 * n) : (f32x4){0.f, 0.f, 0.f, 0.f};
#pragma unroll
        for (int ai = 0; ai < 2; ++ai)
#pragma unroll
            for (int m = 0; m < 4; ++m) { bf16_t* rowp = base + (size_t)(row0 + ai * HALF + m * 16) * ldc + col0;
#pragma unroll
                for (int bj = 0; bj < 2; ++bj) { f32x4 v0 = acc[ai][bj][m][0] + bv[bj][0], v1 = acc[ai][bj][m][1] + bv[bj][1];
                    if (ACT == 1) { f32x2 a = gelu_pk((f32x2){v0[0], v0[1]}), b = gelu_pk((f32x2){v0[2], v0[3]}), c = gelu_pk((f32x2){v1[0], v1[1]}), d = gelu_pk((f32x2){v1[2], v1[3]});
                        v0 = (f32x4){a.x, a.y, b.x, b.y}; v1 = (f32x4){c.x, c.y, d.x, d.y}; }
                    v0 = v0 * sc; v1 = v1 * sc; u32x4 w; w.x = cvt_pk_bf16(v0[0], v0[1]); w.y = cvt_pk_bf16(v0[2], v0[3]); w.z = cvt_pk_bf16(v1[0], v1[1]); w.w = cvt_pk_bf16(v1[2], v1[3]);
                    *(u32x4*)(rowp + bj * HALF) = w; } }
    }
};
typedef int pg8_v8i __attribute__((ext_vector_type(8))); typedef int pg8_v4i __attribute__((ext_vector_type(4)));
__device__ __forceinline__ pg8_v8i pg8_cat(bf16x8 lo, bf16x8 hi) { const pg8_v4i a = __builtin_bit_cast(pg8_v4i, lo), b = __builtin_bit_cast(pg8_v4i, hi); return __builtin_shufflevector(a, b, 0, 1, 2, 3, 4, 5, 6, 7); }
template <class Epi, class Sched, bool ALIGN_EPI = false, bool SP2 = false, bool F8 = false>
__device__ __forceinline__ void gemm_phase(PG8_LAS unsigned char* lds, const Gemm g, const Sched& S, const Epi& E) {
    int tid_ = threadIdx.x; asm volatile("" : "+v"(tid_));
    const int tid = tid_, wid = __builtin_amdgcn_readfirstlane(tid >> 6), lane = tid & 63, wr = wid >> 2, wc = wid & 3, fr = lane & 15, fq = lane >> 4;
    const int K = g.K, nt = K / BK;
    unsigned voffA, voffB;
    { int R, C; stage_rc(tid * 16, R, C); const int Rb = Epi::PERM ? ((R & ~31) + perm32(R & 31)) : R;
        voffA = (unsigned)(R * K + C) * 2u; voffB = (unsigned)(Rb * K + C) * 2u; }
    const size_t rstep = (size_t)64 * K * 2;
    const size_t kstep = (size_t)(BK * 2);
    const size_t hstep = (size_t)HALF * K * 2;
    const size_t tstep = 2 * hstep;
    const unsigned ldsw = (unsigned)wid * 1024u;
    const int aoff = lds_byte(wr * 64 + fr, F8 ? fq * 16 : fq * 8), boff = lds_byte(wc * 32 + fr, F8 ? fq * 16 : fq * 8);
    constexpr int KOFF = F8 ? 16 : 1024;
#define PG8_SA(b, h) (((b) * 2 + (h)) * HTB)
#define PG8_SB(b, h) ((4 + (b) * 2 + (h)) * HTB)
#define PG8_STAGE(bufoff, gbase, voff) do { _Pragma("unroll") for (int _i = 0; _i < 2; ++_i) \
        __builtin_amdgcn_global_load_lds((const unsigned*)((const char*)(gbase) + _i * rstep + (voff)), (PG8_LAS unsigned*)(lds + (bufoff) + ldsw + _i * 8192), 16, 0, 0); } while (0)
#define PG8_LDA(dst, b, h) do { _Pragma("unroll") for (int m = 0; m < 4; ++m) _Pragma("unroll") for (int k = 0; k < 2; ++k) dst[m][k] = *(const PG8_LAS bf16x8*)(lds + PG8_SA(b, h) + aoff + m * 2048 + k * KOFF); } while (0)
#define PG8_LDB(dst, b, h) do { _Pragma("unroll") for (int n = 0; n < 2; ++n) _Pragma("unroll") for (int k = 0; k < 2; ++k) dst[n][k] = *(const PG8_LAS bf16x8*)(lds + PG8_SB(b, h) + boff + n * 2048 + k * KOFF); } while (0)
#define PG8_MMA(ai, bj, At, Bt) do { __builtin_amdgcn_s_setprio(1); \
        if constexpr (F8) { _Pragma("unroll") for (int m = 0; m < 4; ++m) _Pragma("unroll") for (int n = 0; n < 2; ++n) \
            acc[ai][bj][m][n] = __builtin_amdgcn_mfma_scale_f32_16x16x128_f8f6f4(pg8_cat(Bt[n][0], Bt[n][1]), pg8_cat(At[m][0], At[m][1]), acc[ai][bj][m][n], 0, 0, 0, 0x7f7f7f7f, 0, 0x7f7f7f7f); \
            _Pragma("unroll") for (int m = 0; m < 4; ++m) _Pragma("unroll") for (int n = 0; n < 2; ++n) asm volatile("" : "+v"(acc[ai][bj][m][n]));   } \
        else { _Pragma("unroll") for (int m = 0; m < 4; ++m) _Pragma("unroll") for (int n = 0; n < 2; ++n) _Pragma("unroll") for (int k = 0; k < 2; ++k) \
            acc[ai][bj][m][n] = __builtin_amdgcn_mfma_f32_16x16x32_bf16(Bt[n][k], At[m][k], acc[ai][bj][m][n], 0, 0, 0); } \
        __builtin_amdgcn_s_setprio(0); } while (0)
#define PG8_WAIT_V(n) asm volatile("s_waitcnt vmcnt(" #n ")" ::: "memory")
#define PG8_WAIT_L(n) asm volatile("s_waitcnt lgkmcnt(" #n ")" ::: "memory")
#define PG8_BAR __builtin_amdgcn_s_barrier()
#define PG8_SCHED __builtin_amdgcn_sched_barrier(0)
    Unit cur, nxt; int ui = 0;
    if (!S.next(0, cur)) return;
    f32x4 acc[2][2][4][2];
#pragma unroll
    for (int a = 0; a < 2; ++a)
#pragma unroll
        for (int b = 0; b < 2; ++b)
#pragma unroll
            for (int m = 0; m < 4; ++m)
#pragma unroll
                for (int n = 0; n < 2; ++n) acc[a][b][m][n] = (f32x4){0.f, 0.f, 0.f, 0.f};
    bf16x8 At[4][2], B0[2][2], B1[2][2];
    const char* cA = S.abase(g, cur) + (size_t)cur.pm * tstep; const char* cB = S.bbase(g, cur) + (size_t)cur.pn * tstep;
    S.a_ready(cur);
    if constexpr (SP2) {
        PG8_STAGE(PG8_SB(0, 0), cB, voffB); PG8_STAGE(PG8_SB(0, 1), cB + hstep, voffB); PG8_STAGE(PG8_SA(0, 0), cA, voffA); PG8_STAGE(PG8_SA(0, 1), cA + hstep, voffA);
        if (wr == 1) PG8_BAR;
        PG8_WAIT_V(2); PG8_BAR;
        PG8_STAGE(PG8_SB(1, 0), cB + kstep, voffB); PG8_STAGE(PG8_SA(1, 0), cA + kstep, voffA); PG8_STAGE(PG8_SB(1, 1), cB + hstep + kstep, voffB);
        PG8_WAIT_V(6); PG8_BAR;
    } else {
        PG8_STAGE(PG8_SB(0, 0), cB, voffB); PG8_STAGE(PG8_SA(0, 0), cA, voffA); PG8_STAGE(PG8_SB(0, 1), cB + hstep, voffB); PG8_STAGE(PG8_SA(0, 1), cA + hstep, voffA);
        if (wr == 1) PG8_BAR;
        PG8_WAIT_V(4); PG8_BAR;
        PG8_STAGE(PG8_SB(1, 0), cB + kstep, voffB); PG8_STAGE(PG8_SA(1, 0), cA + kstep, voffA); PG8_STAGE(PG8_SB(1, 1), cB + hstep + kstep, voffB);
        PG8_WAIT_V(6); PG8_BAR;
    }
    for (;;) {
        const bool has_next = S.next(ui + 1, nxt);
        const char* nA = has_next ? S.abase(g, nxt) + (size_t)nxt.pm * tstep : cA; const char* nB = has_next ? S.bbase(g, nxt) + (size_t)nxt.pn * tstep : cB;
#pragma unroll 1
        for (int t = 0; t < nt; t += 2) {
            const bool last = (t == nt - 2);
            const char* a1 = cA + (size_t)(t + 1) * kstep;
            const char* a2 = last ? nA : cA + (size_t)(t + 2) * kstep; const char* b2 = last ? nB : cB + (size_t)(t + 2) * kstep;
            const char* a3 = a2 + kstep; const char* b3 = b2 + kstep;
            if (last && has_next) S.a_ready(nxt);
            if constexpr (SP2) {
            PG8_LDB(B0, 0, 0); PG8_LDB(B1, 0, 1); PG8_SCHED; PG8_LDA(At, 0, 0); PG8_STAGE(PG8_SA(1, 1), a1 + hstep, voffA);
            PG8_WAIT_V(8); PG8_WAIT_L(0); PG8_BAR; PG8_MMA(0, 0, At, B0); PG8_MMA(0, 1, At, B1); PG8_BAR; PG8_SCHED;
            PG8_LDA(At, 0, 1); PG8_STAGE(PG8_SB(0, 0), b2, voffB); PG8_STAGE(PG8_SB(0, 1), b2 + hstep, voffB); PG8_STAGE(PG8_SA(0, 0), a2, voffA);
            PG8_WAIT_V(8); PG8_WAIT_L(0); PG8_BAR; PG8_MMA(1, 0, At, B0); PG8_MMA(1, 1, At, B1); PG8_BAR; PG8_SCHED;
            PG8_LDB(B0, 1, 0); PG8_LDB(B1, 1, 1); PG8_SCHED; PG8_LDA(At, 1, 0); PG8_STAGE(PG8_SA(0, 1), a2 + hstep, voffA);
            PG8_WAIT_V(8); PG8_WAIT_L(0); PG8_BAR; PG8_MMA(0, 0, At, B0); PG8_MMA(0, 1, At, B1); PG8_BAR; PG8_SCHED;
            PG8_LDA(At, 1, 1); PG8_STAGE(PG8_SB(1, 0), b3, voffB); PG8_STAGE(PG8_SB(1, 1), b3 + hstep, voffB); PG8_STAGE(PG8_SA(1, 0), a3, voffA);
            PG8_WAIT_V(8); PG8_WAIT_L(0); PG8_BAR; PG8_MMA(1, 0, At, B0); PG8_MMA(1, 1, At, B1); PG8_BAR; PG8_SCHED;
            } else {
            PG8_LDB(B0, 0, 0); PG8_SCHED; PG8_LDA(At, 0, 0); PG8_STAGE(PG8_SA(1, 1), a1 + hstep, voffA);
            PG8_WAIT_L(8); PG8_BAR; PG8_WAIT_L(0); PG8_MMA(0, 0, At, B0); PG8_BAR; PG8_SCHED;
            PG8_LDB(B1, 0, 1); PG8_STAGE(PG8_SB(0, 0), b2, voffB);
            PG8_BAR; PG8_WAIT_L(0); PG8_MMA(0, 1, At, B1); PG8_BAR;
            PG8_LDA(At, 0, 1); PG8_STAGE(PG8_SA(0, 0), a2, voffA);
            PG8_BAR; PG8_WAIT_L(0); PG8_MMA(1, 0, At, B0); PG8_BAR; PG8_SCHED;
            PG8_STAGE(PG8_SB(0, 1), b2 + hstep, voffB);
            PG8_WAIT_V(6); PG8_BAR; PG8_MMA(1, 1, At, B1); PG8_BAR;
            PG8_LDB(B0, 1, 0); PG8_SCHED; PG8_LDA(At, 1, 0); PG8_STAGE(PG8_SA(0, 1), a2 + hstep, voffA);
            PG8_WAIT_L(8); PG8_BAR; PG8_WAIT_L(0); PG8_MMA(0, 0, At, B0); PG8_BAR; PG8_SCHED;
            PG8_LDB(B1, 1, 1); PG8_STAGE(PG8_SB(1, 0), b3, voffB);
            PG8_BAR; PG8_WAIT_L(0); PG8_MMA(0, 1, At, B1); PG8_BAR;
            PG8_LDA(At, 1, 1); PG8_STAGE(PG8_SA(1, 0), a3, voffA);
            PG8_BAR; PG8_WAIT_L(0); PG8_MMA(1, 0, At, B0); PG8_BAR; PG8_SCHED;
            PG8_STAGE(PG8_SB(1, 1), b3 + hstep, voffB);
            PG8_WAIT_V(6); PG8_BAR; PG8_MMA(1, 1, At, B1); PG8_BAR;
            }
        }
        if constexpr (ALIGN_EPI) { if (wr == 0) PG8_BAR; }
        if constexpr (F8) {
#pragma unroll
            for (int a = 0; a < 2; ++a)
#pragma unroll
                for (int b = 0; b < 2; ++b)
#pragma unroll
                    for (int m = 0; m < 4; ++m)
#pragma unroll
                        for (int n = 0; n < 2; ++n) acc[a][b][m][n] = acc[a][b][m][n] * F8_DESCALE;
        }
        if constexpr (!Epi::AFTER_DRAIN) { int tl = threadIdx.x; asm volatile("" : "+v"(tl));
            E(acc, cur, wr, wc, tl & 15, (tl >> 4) & 3); S.done(cur); }
        if (!has_next) break;
#pragma unroll
        for (int a = 0; a < 2; ++a)
#pragma unroll
            for (int b = 0; b < 2; ++b)
#pragma unroll
                for (int m = 0; m < 4; ++m)
#pragma unroll
                    for (int n = 0; n < 2; ++n) acc[a][b][m][n] = (f32x4){0.f, 0.f, 0.f, 0.f};
        cur = nxt; cA = nA; cB = nB; ++ui;
        if constexpr (ALIGN_EPI) { if (wr == 1) PG8_BAR; }
    }
    PG8_WAIT_V(0);
    if constexpr (!ALIGN_EPI) { if (wr == 0) PG8_BAR; }
    PG8_BAR;
    if constexpr (Epi::AFTER_DRAIN) { E.fused(acc, cur, wr, wc, fr, fq, lds, wid, lane); S.done(cur); }
#undef PG8_SA
#undef PG8_SB
#undef PG8_STAGE
#undef PG8_LDA
#undef PG8_LDB
#undef PG8_MMA
#undef PG8_WAIT_V
#undef PG8_WAIT_L
#undef PG8_BAR
#undef PG8_SCHED
}
}
namespace hy {
#define LAS __attribute__((address_space(3)))
typedef unsigned short bf16_t;
typedef short bf16x8 __attribute__((ext_vector_type(8)));
typedef float f32x4 __attribute__((ext_vector_type(4)));
typedef float f32x16 __attribute__((ext_vector_type(16)));
typedef unsigned u32x4 __attribute__((ext_vector_type(4)));
typedef unsigned u32x2 __attribute__((ext_vector_type(2)));

constexpr int BATCH = 8, SEQ = 4096, DM = 1024, T = BATCH * SEQ, MEMLEN = 256, TM = BATCH * MEMLEN;
constexpr int NSRC = 8776, N1 = 5888, NALL = 8960;
constexpr float EPS = 1e-6f, LOG2E = 1.4426950408889634f;
constexpr float C2A = 0.125f * LOG2E;
constexpr float C2C = 0.08838834764831845f * LOG2E;
constexpr int NWAVES = 8, NTHR = 512;

constexpr size_t MiB = 1u << 20;
constexpr size_t WS_WIN = 1 * MiB, WS_WM = 19 * MiB, WS_WB = 21 * MiB, WS_WO = 24 * MiB, WS_HM = 26 * MiB, WS_MKV = 30 * MiB, WS_H = 34 * MiB;
constexpr size_t WS_QA = 98 * MiB, WS_GB = 130 * MiB, WS_QC = 162 * MiB;
constexpr size_t WS_KA = 194 * MiB, WS_VA = 226 * MiB, WS_ZA = 258 * MiB, WS_QI = 290 * MiB, WS_KW = 322 * MiB, WS_QB = 330 * MiB, WS_FB = 362 * MiB, WS_IB = 394 * MiB, WS_ZC = 426 * MiB;
constexpr size_t WS_MASK = 458 * MiB, WS_DEC = 474 * MiB, WS_H8 = 476 * MiB, WS_END = 508 * MiB;
constexpr size_t WS_W8 = WS_WIN, WS_WG8 = WS_W8 + (size_t)N1 * DM;
constexpr size_t WS_WIX = WS_WIN + 6 * MiB;
constexpr int IX_LO = 2048, IX_HI = 2816;
constexpr float H8_SCALE = 4.f, WG8_SCALE = 64.f;
constexpr float O8_SCALE = 32.f, WB8_SCALE = 8.f;
constexpr float M8_SCALE = 16.f, WO8_SCALE = 16.f;
constexpr size_t WS_O8B = WS_QI, WS_O8C = WS_QI + 16 * MiB, WS_M8 = WS_ZC;
constexpr size_t WS_G = 194 * MiB, WS_MB = 330 * MiB;
constexpr size_t WS_OB = WS_QI;
constexpr size_t OUT_LCT = 0, OUT_SINT = 64 * MiB;
constexpr size_t WS_LBT = 49152;
constexpr size_t WS_LMINV = 40960;

constexpr int LDS_BYTES = 147456;

__device__ __forceinline__ float bf2f(unsigned u16) { return __uint_as_float(u16 << 16); }
__device__ __forceinline__ unsigned pk2(float lo, float hi) { typedef float f2 __attribute__((ext_vector_type(2))); typedef __bf16 b2 __attribute__((ext_vector_type(2))); f2 v = {lo, hi}; b2 b = __builtin_convertvector(v, b2); return __builtin_bit_cast(unsigned, b); }
__device__ __forceinline__ unsigned pk4_fp8(float a, float b, float c, float d) {
    a = __builtin_amdgcn_fmed3f(a, -448.f, 448.f); b = __builtin_amdgcn_fmed3f(b, -448.f, 448.f); c = __builtin_amdgcn_fmed3f(c, -448.f, 448.f); d = __builtin_amdgcn_fmed3f(d, -448.f, 448.f);
    int w = __builtin_amdgcn_cvt_pk_fp8_f32(a, b, 0, false); w = __builtin_amdgcn_cvt_pk_fp8_f32(c, d, w, true); return (unsigned)w; }
__device__ __forceinline__ bf16_t f2bf(float f) { return (bf16_t)(pk2(f, 0.f) & 0xffffu); }
__device__ __forceinline__ float ex2(float x) { return __builtin_amdgcn_exp2f(x); }
__device__ __forceinline__ float rcpf_(float x) { return __builtin_amdgcn_rcpf(x); }
__device__ __forceinline__ float sigm(float x) { return rcpf_(1.f + ex2(-LOG2E * x)); }
__device__ __forceinline__ float silu(float x) { return x * sigm(x); }
__device__ __forceinline__ int crow(int r, int hi) { return (r & 3) + 8 * (r >> 2) + 4 * hi; }
__device__ __forceinline__ f32x16 mfma32(bf16x8 a, bf16x8 b, f32x16 c) { return __builtin_amdgcn_mfma_f32_32x32x16_bf16(a, b, c, 0, 0, 0); }
__device__ __forceinline__ f32x4 mfma16(bf16x8 a, bf16x8 b, f32x4 c) { return __builtin_amdgcn_mfma_f32_16x16x32_bf16(a, b, c, 0, 0, 0); }
__device__ __forceinline__ float wave_sum(float v) {
#pragma unroll
    for (int o = 1; o < 64; o <<= 1) v += __shfl_xor(v, o);
    return v;
}
__device__ __forceinline__ int wave_sum_i(int v) {
#pragma unroll
    for (int o = 1; o < 64; o <<= 1) v += __shfl_xor(v, o);
    return v;
}
__device__ __forceinline__ unsigned wave_sum_dpp(unsigned v) {
    v += (unsigned)__builtin_amdgcn_update_dpp(0, (int)v, 0x111, 0xf, 0xf, true);
    v += (unsigned)__builtin_amdgcn_update_dpp(0, (int)v, 0x112, 0xf, 0xf, true);
    v += (unsigned)__builtin_amdgcn_update_dpp(0, (int)v, 0x114, 0xf, 0xf, true);
    v += (unsigned)__builtin_amdgcn_update_dpp(0, (int)v, 0x118, 0xf, 0xf, true);
    v += (unsigned)__builtin_amdgcn_update_dpp(0, (int)v, 0x142, 0xa, 0xf, false);
    v += (unsigned)__builtin_amdgcn_update_dpp(0, (int)v, 0x143, 0xc, 0xf, false);
    return (unsigned)__builtin_amdgcn_readlane((int)v, 63);
}
__device__ __forceinline__ unsigned umax_(unsigned a, unsigned b) { return a > b ? a : b; }
__device__ __forceinline__ unsigned wave_max_dpp(unsigned v) {
    v = umax_(v, (unsigned)__builtin_amdgcn_update_dpp(0, (int)v, 0x111, 0xf, 0xf, true));
    v = umax_(v, (unsigned)__builtin_amdgcn_update_dpp(0, (int)v, 0x112, 0xf, 0xf, true));
    v = umax_(v, (unsigned)__builtin_amdgcn_update_dpp(0, (int)v, 0x114, 0xf, 0xf, true));
    v = umax_(v, (unsigned)__builtin_amdgcn_update_dpp(0, (int)v, 0x118, 0xf, 0xf, true));
    v = umax_(v, (unsigned)__builtin_amdgcn_update_dpp(0, (int)v, 0x142, 0xa, 0xf, false));
    v = umax_(v, (unsigned)__builtin_amdgcn_update_dpp(0, (int)v, 0x143, 0xc, 0xf, false));
    return (unsigned)__builtin_amdgcn_readlane((int)v, 63);
}
__device__ __forceinline__ void unpack8(u32x4 v, float (&f)[8]) {
#pragma unroll
    for (int i = 0; i < 4; ++i) { f[2 * i] = bf2f(v[i] & 0xffffu); f[2 * i + 1] = bf2f(v[i] >> 16); }
}

struct Ctx {
    float* out; unsigned char* ws;
    LAS unsigned char* lds; int tid, lane, wave, G, bid;
};
#define WSP(off) ((bf16_t*)(C.ws + (off)))

__device__ __forceinline__ int win_src_col(int r) {
    if (r < 1024) {
        const int g = r & 511, pt = g >> 8, bj = (g >> 7) & 1, wc = (g >> 5) & 3, j = g & 31;
        return (r & 512) + (4 * pt + wc) * 64 + 32 * bj + j; }
    if (r < 2632) return r;
    if (r < 2688) return -1;
    if (r < 5760) return r - 56;
    if (r < 5888) return -1;
    return r - 184;
}
__device__ __forceinline__ void p0_transpose_item(const float* W, int K, int N, bf16_t* WT, unsigned char* W8, float w8s, bool winmap, LAS float* scr, int item, int nblk, int lane) {
    const int kb = item / nblk, nb = item % nblk, k0 = 64 * kb, n0 = 32 * nb;
    const int dcol = n0 + (lane & 31); const int sc = winmap ? win_src_col(dcol) : dcol;
    float tv[32];
#pragma unroll
    for (int i = 0; i < 32; ++i) { const int kk = 2 * i + (lane >> 5); tv[i] = W[(size_t)(k0 + kk) * N + (sc >= 0 ? sc : 0)]; }
#pragma unroll
    for (int i = 0; i < 32; ++i) { const int kk = 2 * i + (lane >> 5); scr[kk * 33 + (lane & 31)] = sc >= 0 ? tv[i] : 0.f; }
    asm volatile("s_waitcnt lgkmcnt(0)" ::: "memory");
    const int c = lane & 7;
#pragma unroll
    for (int j = 0; j < 4; ++j) { const int n = (lane >> 3) + 8 * j; const LAS float* s = scr + (8 * c) * 33 + n;
        if (W8 && !(winmap && n0 >= IX_LO && n0 < IX_HI)) {
            u32x2 o8; o8.x = pk4_fp8(s[0 * 33] * w8s, s[1 * 33] * w8s, s[2 * 33] * w8s, s[3 * 33] * w8s); o8.y = pk4_fp8(s[4 * 33] * w8s, s[5 * 33] * w8s, s[6 * 33] * w8s, s[7 * 33] * w8s);
            *(u32x2*)(W8 + (size_t)(n0 + n) * K + k0 + 8 * c) = o8; continue; }
        u32x4 o; o.x = pk2(s[0 * 33], s[1 * 33]); o.y = pk2(s[2 * 33], s[3 * 33]); o.z = pk2(s[4 * 33], s[5 * 33]); o.w = pk2(s[6 * 33], s[7 * 33]);
        *(u32x4*)(WT + (size_t)(n0 + n) * K + k0 + 8 * c) = o; }
    asm volatile("s_waitcnt lgkmcnt(0)" ::: "memory");
}
__device__ __forceinline__ void rms_row_to_bf16(const float* xrow, const float* gain, bf16_t* orow, int lane) {
    const f32x4* xr = (const f32x4*)xrow + lane; const f32x4* gr = (const f32x4*)gain + lane;
    f32x4 v[4]; float s = 0.f;
#pragma unroll
    for (int j = 0; j < 4; ++j) { v[j] = xr[64 * j]; s += (v[j].x * v[j].x + v[j].y * v[j].y) + (v[j].z * v[j].z + v[j].w * v[j].w); }
    const float rstd = 1.f / sqrtf(wave_sum(s) * (1.f / DM) + EPS);
    u32x2* o8 = (u32x2*)orow + lane;
#pragma unroll
    for (int j = 0; j < 4; ++j) { const f32x4 g = gr[64 * j]; u32x2 w; w.x = pk2(v[j].x * rstd * g.x, v[j].y * rstd * g.y); w.y = pk2(v[j].z * rstd * g.z, v[j].w * rstd * g.w); o8[64 * j] = w; }
}
__device__ __forceinline__ void p0_prologue(Ctx& C, const float* x, const float* mem, const float* norm_in, const float* norm_mem, const float* w_in, const float* w_mkv, const float* w_br, const float* w_out, const float* lbin) {
    LAS float* scr = (LAS float*)(C.lds + C.wave * 16384);
    const int gw = C.bid * NWAVES + C.wave, NGW = C.G * NWAVES;
    constexpr int I_IN = 16 * (NALL / 32), I_M = 16 * 32, I_B = 8 * 32, I_O = 16 * 32;
    constexpr int NITEMS = I_IN + I_M + 3 * I_B + I_O;
    for (int it = gw; it < NITEMS; it += NGW) {
        int r = it;
        if (r < I_IN) { p0_transpose_item(w_in, DM, NSRC, WSP(WS_WIX), C.ws + WS_W8, WG8_SCALE, true, scr, r, NALL / 32, C.lane); continue; } r -= I_IN;
        if (r < I_M) { p0_transpose_item(w_mkv, DM, DM, WSP(WS_WM), nullptr, 0.f, false, scr, r, 32, C.lane); continue; } r -= I_M;
        if (r < 3 * I_B) { const int n = r / I_B; p0_transpose_item(w_br + (size_t)n * 512 * DM, 512, DM, nullptr, C.ws + WS_WB + (size_t)n * DM * 512, WB8_SCALE, false, scr, r % I_B, 32, C.lane); continue; } r -= 3 * I_B;
        p0_transpose_item(w_out, DM, DM, nullptr, C.ws + WS_WO, WO8_SCALE, false, scr, r, 32, C.lane);
    }
    for (int m = gw; m < T; m += 2 * NGW) {
        f32x4 v[2][4]; float sq[2];
#pragma unroll
        for (int r = 0; r < 2; ++r) { const int mr = (m + r * NGW < T) ? m + r * NGW : m;
            const f32x4* xr = (const f32x4*)(x + (size_t)mr * DM) + C.lane;
#pragma unroll
            for (int j = 0; j < 4; ++j) v[r][j] = xr[64 * j]; }
#pragma unroll
        for (int r = 0; r < 2; ++r) { float s_ = 0.f;
#pragma unroll
            for (int j = 0; j < 4; ++j) s_ += (v[r][j].x * v[r][j].x + v[r][j].y * v[r][j].y) + (v[r][j].z * v[r][j].z + v[r][j].w * v[r][j].w);
            sq[r] = s_; }
#pragma unroll
        for (int o = 1; o < 64; o <<= 1) { sq[0] += __shfl_xor(sq[0], o); sq[1] += __shfl_xor(sq[1], o); }
#pragma unroll
        for (int r = 0; r < 2; ++r) { const int mr = (m + r * NGW < T) ? m + r * NGW : m; const float rstd = 1.f / sqrtf(sq[r] * (1.f / DM) + EPS); u32x2* o8 = (u32x2*)(WSP(WS_H) + (size_t)mr * DM) + C.lane;
#pragma unroll
            for (int j = 0; j < 4; ++j) { const f32x4 g = ((const f32x4*)norm_in)[C.lane + 64 * j]; const float h0 = v[r][j].x * rstd * g.x, h1 = v[r][j].y * rstd * g.y, h2 = v[r][j].z * rstd * g.z, h3 = v[r][j].w * rstd * g.w;
                u32x2 w; w.x = pk2(h0, h1); w.y = pk2(h2, h3); o8[64 * j] = w;
                ((unsigned*)(C.ws + WS_H8 + (size_t)mr * DM))[C.lane + 64 * j] = pk4_fp8(h0 * H8_SCALE, h1 * H8_SCALE, h2 * H8_SCALE, h3 * H8_SCALE); } }
    }
    if (C.bid == 0) { const float a0 = lbin[C.tid], a1 = lbin[512 + C.tid]; ((float*)(C.ws + WS_LBT))[C.tid] = 1.f / (1.f + expf(a1 - a0)); }
    for (int m = gw; m < TM; m += NGW) rms_row_to_bf16(mem + (size_t)m * DM, norm_mem, WSP(WS_HM) + (size_t)m * DM, C.lane);
}

using pg8::Unit;
struct EpiP1 {
    static constexpr bool PERM = true, AFTER_DRAIN = false;
    unsigned char* ws; const float* gq; const float* gk; bool nostore = false;
    __device__ __forceinline__ void operator()(const f32x4 (&acc)[2][2][4][2], const Unit& u, int wr, int wc, int fr, int fq) const {
        if (nostore) return;
        const int row0 = u.pm * 256 + wr * 64 + fr;
        if (u.pn < 4) {
            const bool isq = u.pn < 2; const float* gain = isq ? gq : gk; const float scale = isq ? C2A : 1.f;
            const int head = 4 * (u.pn & 1) + wc;
            bf16_t* qbase = (bf16_t*)(ws + WS_QA) + ((size_t)(u.pm * 8 + wr * 2) * 8 + head) * 2048 + (fq >> 1) * 512 + ((fq & 1) * 32 + fr) * 8;
            bf16_t* base = (bf16_t*)(ws + WS_KA) + head * 64 + 8 * fq;
            f32x4 g[2][2];
#pragma unroll
            for (int bj = 0; bj < 2; ++bj)
#pragma unroll
                for (int n = 0; n < 2; ++n) g[bj][n] = *(const f32x4*)(gain + 32 * bj + 8 * fq + 4 * n);
#pragma unroll
            for (int ai = 0; ai < 2; ++ai)
#pragma unroll
                for (int m = 0; m < 4; ++m) {
                    float ss = 0.f;
#pragma unroll
                    for (int bj = 0; bj < 2; ++bj)
#pragma unroll
                        for (int n = 0; n < 2; ++n) { const f32x4 v = acc[ai][bj][m][n]; ss += (v[0] * v[0] + v[1] * v[1]) + (v[2] * v[2] + v[3] * v[3]); }
                    ss += __shfl_xor(ss, 16); ss += __shfl_xor(ss, 32);
                    const float rs = scale / sqrtf(ss * (1.f / 64.f) + EPS);
#pragma unroll
                    for (int bj = 0; bj < 2; ++bj) { const f32x4 v0 = acc[ai][bj][m][0] * g[bj][0] * rs, v1 = acc[ai][bj][m][1] * g[bj][1] * rs;
                        u32x4 w; w.x = pk2(v0[0], v0[1]); w.y = pk2(v0[2], v0[3]); w.z = pk2(v1[0], v1[1]); w.w = pk2(v1[2], v1[3]);
                        if (isq) *(u32x4*)(qbase + ((ai * 4 + (m >> 1)) * 8) * 2048 + bj * 1024 + (m & 1) * 128) = w;
                        else *(u32x4*)(base + (size_t)(row0 + ai * 128 + m * 16) * 512 + 32 * bj) = w; }
                }
            return;
        }
#pragma unroll
        for (int bj = 0; bj < 2; ++bj) {
            const int unit = u.pn * 2 + bj;
            if (unit >= 45) continue;
            int buf, cu, ld = 512;
            if (unit >= 16 && unit < 20) {
                const int h = 2 * (unit & 3) + (wc >> 1), ks = wc & 1;
#pragma unroll
                for (int ai = 0; ai < 2; ++ai)
#pragma unroll
                    for (int m = 0; m < 4; ++m) { const int row = row0 + ai * 128 + m * 16; const f32x4 v0 = acc[ai][bj][m][0], v1 = acc[ai][bj][m][1];
                        u32x4 w; w.x = pk2(v0[0], v0[1]); w.y = pk2(v0[2], v0[3]); w.z = pk2(v1[0], v1[1]); w.w = pk2(v1[2], v1[3]);
                        *(u32x4*)((bf16_t*)(ws + WS_QI) + (size_t)(row >> 4) * 8192 + h * 1024 + ks * 512 + (fq * 16 + (row & 15)) * 8) = w; }
                continue; }
            if (unit < 20) { buf = unit >> 2; cu = (unit & 3) * 128; }
            else if (unit == 20) {
                if (wc < 2 || (wc == 2 && fq == 0)) {
#pragma unroll
                    for (int ai = 0; ai < 2; ++ai)
#pragma unroll
                        for (int m = 0; m < 4; ++m) { const int row = row0 + ai * 128 + m * 16; const f32x4 v0 = acc[ai][bj][m][0], v1 = acc[ai][bj][m][1];
                            u32x4 w; w.x = pk2(v0[0], v0[1]); w.y = pk2(v0[2], v0[3]); w.z = pk2(v1[0], v1[1]); w.w = pk2(v1[2], v1[3]);
                            bf16_t* dst = (wc < 2) ? (bf16_t*)(ws + WS_KW) + (size_t)(row >> 4) * 1024 + wc * 512 + (fq * 16 + (row & 15)) * 8 : (bf16_t*)(ws + WS_KW + 4 * MiB) + (size_t)row * 8;
                            *(u32x4*)dst = w; } }
                continue; }
            else { const int i = unit - 21; buf = 6 + (i >> 2); cu = (i & 3) * 128; }
            size_t off;
            switch (buf) { case 0: off = WS_QA; break; case 1: off = WS_KA; break; case 2: off = WS_VA; break; case 3: off = WS_ZA; break; case 4: off = WS_QI; break; case 5: off = WS_KW; break;
                           case 6: off = WS_QB; break; case 7: off = WS_FB; break; case 8: off = WS_IB; break; case 9: off = WS_GB; break; case 10: off = WS_QC; break; default: off = WS_ZC; break; }
            const bool act = (buf == 3) || (buf == 6) || (buf == 9) || (buf == 11);
            bf16_t* base = (bf16_t*)(ws + off) + cu + wc * 32 + 8 * fq;
#pragma unroll
            for (int ai = 0; ai < 2; ++ai)
#pragma unroll
                for (int m = 0; m < 4; ++m) {
                    f32x4 v0 = acc[ai][bj][m][0], v1 = acc[ai][bj][m][1];
                    if (act) {
#pragma unroll
                        for (int e = 0; e < 4; ++e) { v0[e] = silu(v0[e]); v1[e] = silu(v1[e]); }
                    }
                    u32x4 w; w.x = pk2(v0[0], v0[1]); w.y = pk2(v0[2], v0[3]); w.z = pk2(v1[0], v1[1]); w.w = pk2(v1[2], v1[3]);
                    *(u32x4*)(base + (size_t)(row0 + ai * 128 + m * 16) * ld) = w;
                }
        }
    }
};
template <int ACT  > struct EpiPlain {
    static constexpr bool PERM = true, AFTER_DRAIN = false;
    bf16_t* O; int ld;
    __device__ __forceinline__ void operator()(const f32x4 (&acc)[2][2][4][2], const Unit& u, int wr, int wc, int fr, int fq) const {
        const int row0 = u.pm * 256 + wr * 64 + fr, col0 = u.pn * 256 + wc * 32 + 8 * fq;
#pragma unroll
        for (int bj = 0; bj < 2; ++bj)
#pragma unroll
            for (int ai = 0; ai < 2; ++ai)
#pragma unroll
                for (int m = 0; m < 4; ++m) {
                    f32x4 v0 = acc[ai][bj][m][0], v1 = acc[ai][bj][m][1];
                    if (ACT == 1) {
#pragma unroll
                        for (int e = 0; e < 4; ++e) { v0[e] = sigm(v0[e]); v1[e] = sigm(v1[e]); }
                    }

                    u32x4 w; w.x = pk2(v0[0], v0[1]); w.y = pk2(v0[2], v0[3]); w.z = pk2(v1[0], v1[1]); w.w = pk2(v1[2], v1[3]);
                    *(u32x4*)(O + (size_t)(row0 + ai * 128 + m * 16) * ld + col0 + bj * 128) = w;
                }
    }
};
template <bool LAST> struct EpiMerge {
    static constexpr bool PERM = true, AFTER_DRAIN = false;
    const bf16_t* Gt; bf16_t* MB; int first; unsigned char* M8;
    __device__ __forceinline__ void operator()(const f32x4 (&acc)[2][2][4][2], const Unit& u, int wr, int wc, int fr, int fq) const {
        const int row0 = u.pm * 256 + wr * 64 + fr, col0 = u.pn * 256 + wc * 32 + 8 * fq;
#pragma unroll
        for (int bj = 0; bj < 2; ++bj)
#pragma unroll
            for (int ai = 0; ai < 2; ++ai)
#pragma unroll
                for (int m = 0; m < 4; ++m) {
                    const size_t off = (size_t)(row0 + ai * 128 + m * 16) * DM + col0 + bj * 128;
                    float g[8], mo[8]; unpack8(*(const u32x4*)(Gt + off), g);
                    if (!first) unpack8(*(const u32x4*)(MB + off), mo);
                    else {
#pragma unroll
                        for (int e = 0; e < 8; ++e) mo[e] = 0.f;
                    }
                    const f32x4 v0 = acc[ai][bj][m][0], v1 = acc[ai][bj][m][1];
                    float r[8];
#pragma unroll
                    for (int e = 0; e < 4; ++e) { r[e] = mo[e] + g[e] * v0[e]; r[4 + e] = mo[4 + e] + g[4 + e] * v1[e]; }
                    if constexpr (LAST) { u32x2 w8; w8.x = pk4_fp8(r[0] * M8_SCALE, r[1] * M8_SCALE, r[2] * M8_SCALE, r[3] * M8_SCALE); w8.y = pk4_fp8(r[4] * M8_SCALE, r[5] * M8_SCALE, r[6] * M8_SCALE, r[7] * M8_SCALE); *(u32x2*)(M8 + off) = w8; }
                    else { u32x4 w; w.x = pk2(r[0], r[1]); w.y = pk2(r[2], r[3]); w.z = pk2(r[4], r[5]); w.w = pk2(r[6], r[7]); *(u32x4*)(MB + off) = w; }
                }
    }
};
struct EpiOut {
    static constexpr bool PERM = true, AFTER_DRAIN = false;
    const float* x; float* out;
    __device__ __forceinline__ void operator()(const f32x4 (&acc)[2][2][4][2], const Unit& u, int wr, int wc, int fr, int fq) const {
        const int row0 = u.pm * 256 + wr * 64 + fr, col0 = u.pn * 256 + wc * 32 + 8 * fq;
#pragma unroll
        for (int ai = 0; ai < 2; ++ai)
#pragma unroll
            for (int m = 0; m < 4; ++m)
#pragma unroll
                for (int bj = 0; bj < 2; ++bj) {
                    const size_t off = (size_t)(row0 + ai * 128 + m * 16) * DM + col0 + bj * 128;
                    const f32x4 x0 = *(const f32x4*)(x + off), x1 = *(const f32x4*)(x + off + 4);
                    *(f32x4*)(out + off) = x0 + acc[ai][bj][m][0]; *(f32x4*)(out + off + 4) = x1 + acc[ai][bj][m][1];
                }
    }
};

__device__ __forceinline__ void norm_rows_inplace(bf16_t* buf, int ld, int nrows, int hd, const float* gain, float scale, int gw, int NGW, int lane) {
    for (int r = gw; r < nrows; r += NGW) {
        bf16_t* p = buf + (size_t)r * ld + lane * 8;
        float f[8]; unpack8(*(const u32x4*)p, f);
        float ss = 0.f;
#pragma unroll
        for (int i = 0; i < 8; ++i) ss += f[i] * f[i];
        ss += __shfl_xor(ss, 1); ss += __shfl_xor(ss, 2); ss += __shfl_xor(ss, 4);
        if (hd == 128) ss += __shfl_xor(ss, 8);
        const float rs = scale / sqrtf(ss / (float)hd + EPS);
        const float* g = gain + ((lane * 8) % hd);
        u32x4 w; w.x = pk2(f[0] * rs * g[0], f[1] * rs * g[1]); w.y = pk2(f[2] * rs * g[2], f[3] * rs * g[3]); w.z = pk2(f[4] * rs * g[4], f[5] * rs * g[5]); w.w = pk2(f[6] * rs * g[6], f[7] * rs * g[7]);
        *(u32x4*)p = w;
    }
}

constexpr int IDX_RS = 8208;
typedef float f32x2_t __attribute__((ext_vector_type(2)));
__device__ __forceinline__ unsigned mono16x2(f32x2_t v) {
    typedef _Float16 h2 __attribute__((ext_vector_type(2))); typedef short s2 __attribute__((ext_vector_type(2)));
    const h2 h = __builtin_convertvector(v, h2); const unsigned hb = __builtin_bit_cast(unsigned, h);
    const s2 sg = __builtin_bit_cast(s2, hb) >> 15;
    return hb ^ (__builtin_bit_cast(unsigned, sg) | 0x80008000u);
}
__device__ __forceinline__ unsigned mono16(float s) {
    const _Float16 h = (_Float16)s; const unsigned b = (unsigned)__builtin_bit_cast(unsigned short, h);
    return (b & 0x8000u) ? (~b & 0xffffu) : (b | 0x8000u);
}
__device__ __forceinline__ void indexer_unit(Ctx& C, int b, int blk) {
    const bf16_t* QI = WSP(WS_QI); const bf16_t* KW = WSP(WS_KW); unsigned char* maskb = C.ws + WS_MASK;
    int lane = C.lane; asm volatile("" : "+v"(lane));
    const int wid = C.wave, fr = lane & 15, fq = lane >> 4;
    const int t0 = blk * 16; const size_t rowbase = (size_t)b * SEQ;
    bf16x8 qf[8][2];
    { const bf16_t* qt = QI + ((rowbase >> 4) + blk) * 8192 + lane * 8;
#pragma unroll
      for (int h = 0; h < 8; ++h)
#pragma unroll
          for (int ks = 0; ks < 2; ++ks) qf[h][ks] = *(const bf16x8*)(qt + h * 1024 + ks * 512); }
    float wv[8]; unpack8(*(const u32x4*)((const bf16_t*)(C.ws + WS_KW + 4 * MiB) + (rowbase + t0 + fr) * 8), wv);
    bf16x8 qbar[2];
#pragma unroll
    for (int ks = 0; ks < 2; ++ks) { float acc8[8] = {0.f, 0.f, 0.f, 0.f, 0.f, 0.f, 0.f, 0.f};
#pragma unroll
        for (int h = 0; h < 8; ++h) { float f[8]; unpack8(__builtin_bit_cast(u32x4, qf[h][ks]), f);
#pragma unroll
            for (int i = 0; i < 8; ++i) acc8[i] += wv[h] * f[i]; }
        u32x4 w_; w_.x = pk2(acc8[0], acc8[1]); w_.y = pk2(acc8[2], acc8[3]); w_.z = pk2(acc8[4], acc8[5]); w_.w = pk2(acc8[6], acc8[7]); qbar[ks] = __builtin_bit_cast(bf16x8, w_); }
    const int ntile = blk + 1;
    const int nmine = (ntile - wid + 7) >> 3;
    const bf16_t* kbase = KW + (rowbase >> 4) * 1024 + lane * 8;
#ifdef IDX_REP_COMP
#define IDX_REPC(K) for (int rc_ = 0; rc_ < 2; ++rc_) { asm volatile("" : "+v"(K[j_][0]), "+v"(K[j_][1]));
#define IDX_REPC_END }
#else
#define IDX_REPC(K) {
#define IDX_REPC_END }
#endif
#define IDX_LOAD4(K, I0) do { _Pragma("unroll") for (int j_ = 0; j_ < 4; ++j_) { int kt_ = wid + 8 * ((I0) + j_); kt_ = kt_ < ntile ? kt_ : ntile - 1; \
        const bf16_t* p_ = kbase + (size_t)kt_ * 1024; K[j_][0] = *(const bf16x8*)p_; K[j_][1] = *(const bf16x8*)(p_ + 512); } } while (0)
#define IDX_COMP4(K, I0) do { _Pragma("unroll") for (int j_ = 0; j_ < 4; ++j_) { if ((I0) + j_ < nmine) { const int kt_ = wid + 8 * ((I0) + j_); \
        IDX_REPC(K) \
          \
        f32x4 l_ = {0.f, 0.f, 0.f, 0.f}; l_ = mfma16(K[j_][0], qbar[0], l_); l_ = mfma16(K[j_][1], qbar[1], l_); \
        float s0_ = 0.f, s1_ = 0.f, s2_ = 0.f, s3_ = 0.f; \
        _Pragma("unroll") for (int h = 0; h < 8; ++h) { f32x4 a_ = {0.f, 0.f, 0.f, 0.f}; a_ = mfma16(K[j_][0], qf[h][0], a_); a_ = mfma16(K[j_][1], qf[h][1], a_); \
            s0_ = __builtin_fmaf(__builtin_fabsf(a_[0]), wv[h], s0_); s1_ = __builtin_fmaf(__builtin_fabsf(a_[1]), wv[h], s1_); \
            s2_ = __builtin_fmaf(__builtin_fabsf(a_[2]), wv[h], s2_); s3_ = __builtin_fmaf(__builtin_fabsf(a_[3]), wv[h], s3_); \
            asm("" : "+v"(s0_)); asm("" : "+v"(s1_)); asm("" : "+v"(s2_)); asm("" : "+v"(s3_)); }     \
        unsigned k01_ = mono16x2((f32x2_t){s0_ + l_[0], s1_ + l_[1]}), k23_ = mono16x2((f32x2_t){s2_ + l_[2], s3_ + l_[3]}); \
        if (kt_ == ntile - 1) { const int lim_ = t0 + fr - kt_ * 16 - fq * 4;            \
            k01_ &= (lim_ >= 0 ? 0xffffu : 0u) | (lim_ >= 1 ? 0xffff0000u : 0u); k23_ &= (lim_ >= 2 ? 0xffffu : 0u) | (lim_ >= 3 ? 0xffff0000u : 0u); } \
        u32x2 w_; w_.x = k01_; w_.y = k23_; \
        *(LAS u32x2*)(C.lds + fr * IDX_RS + (kt_ * 16 + fq * 4) * 2) = w_; IDX_REPC_END } } } while (0)
#ifdef IDX_REP_MFMA
    for (int rep_ = 0; rep_ < 2; ++rep_)
#endif
    { bf16x8 ka[4][2], kb[4][2], kc[4][2];
      IDX_LOAD4(ka, 0); IDX_LOAD4(kb, 4);
      for (int i0 = 0; i0 < nmine;) {
          IDX_LOAD4(kc, i0 + 8);
          IDX_COMP4(ka, i0);
          i0 += 4; if (i0 >= nmine) break;
          IDX_LOAD4(ka, i0 + 8);
          IDX_COMP4(kb, i0);
          i0 += 4; if (i0 >= nmine) break;
          IDX_LOAD4(kb, i0 + 8);
          IDX_COMP4(kc, i0);
          i0 += 4;
      } }
#undef IDX_LOAD4
#undef IDX_COMP4
    {
      const int p0 = 16 * ntile, ng = ((((p0 + 511) >> 9) << 9) - p0) >> 3;
      for (int i = C.tid; i < ng * 16; i += NTHR) { const int row = i / ng, g = i - row * ng; u32x4 z = {0u, 0u, 0u, 0u}; *(LAS u32x4*)(C.lds + row * IDX_RS + (p0 + 8 * g) * 2) = z; } }
    __syncthreads();
#ifdef IDX_REP_SEL
#define IDX_NRR 4
#else
#define IDX_NRR 2
#endif
    unsigned lmv = 0u;
#pragma unroll 1
    for (int rr_ = 0; rr_ < IDX_NRR; ++rr_) {
        const int rr = rr_ & 1;
        const int q = 2 * wid + rr, t = t0 + q;
        unsigned char* mrow = maskb + ((size_t)b * 64 * 4096 + t) * 8 + (size_t)(lane >> 3) * 32768 + (lane & 7);
        if (t < 256) {
#pragma unroll
            for (int j = 0; j < 8; ++j) { int nb = t + 1 - (64 * j + lane) * 8; nb = nb < 0 ? 0 : (nb > 8 ? 8 : nb);
                mrow[(size_t)j * 262144] = (unsigned char)(((1u << ((nb + 1) >> 1)) - 1u) | (((1u << (nb >> 1)) - 1u) << 4)); }
            lmv = umax_(lmv, (unsigned)(4095 - t));
            continue;
        }
        unsigned w[32];
#pragma unroll
        for (int j = 0; j < 8; ++j) {
            u32x4 v = {0u, 0u, 0u, 0u};
            if (512 * j <= t0 + 15) v = *(const LAS u32x4*)(C.lds + q * IDX_RS + (64 * j + lane) * 16);
            w[4 * j] = v[0]; w[4 * j + 1] = v[1]; w[4 * j + 2] = v[2]; w[4 * j + 3] = v[3];
        }
#define IDX_TSTAGE(S, M) _Pragma("unroll") for (int k = 0; k < 32; ++k) { if ((k & (S)) == 0) { const unsigned a_ = w[k], b_ = w[k + (S)]; \
            w[k] = (a_ & (M)) | ((b_ << (S)) & ~(M)); w[k + (S)] = ((a_ >> (S)) & (M)) | (b_ & ~(M)); } }
        IDX_TSTAGE(16, 0x0000ffffu) IDX_TSTAGE(8, 0x00ff00ffu) IDX_TSTAGE(4, 0x0f0f0f0fu) IDX_TSTAGE(2, 0x33333333u) IDX_TSTAGE(1, 0x55555555u)
#undef IDX_TSTAGE
        unsigned ce = 0xffffffffu, co = 0xffffffffu, ae = 0u, ao = 0u, cnt_above = 0u;
#pragma unroll
        for (int b = 15; b >= 0; --b) {
            const unsigned oe = ce & w[b], oo = co & w[16 + b];
            const unsigned tot = wave_sum_dpp((unsigned)(__builtin_popcount(oe) + __builtin_popcount(oo)));
            if (cnt_above + tot >= 256u) { ce = oe; co = oo; }
            else { cnt_above += tot; ae |= oe; ao |= oo; ce &= ~w[b]; co &= ~w[16 + b]; }
        }
        int excess = (int)wave_sum_dpp((unsigned)(__builtin_popcount(ce) + __builtin_popcount(co))) - (256 - (int)cnt_above);
        while (excess > 0) {
            const int ie = ce ? 31 - __builtin_clz(ce) : -1, io = co ? 31 - __builtin_clz(co) : -1;
            const int i0 = ie >= 0 ? 2 * ie : -1, i1 = io >= 0 ? 2 * io + 1 : -1, itop = i0 > i1 ? i0 : i1;
            const unsigned p = itop >= 0 ? (unsigned)((((itop >> 3) << 9) | (lane << 3) | (itop & 7)) + 1) : 0u;
            const unsigned pm = wave_max_dpp(p);
            if (p == pm && p != 0u) { if (itop & 1) co &= ~(1u << (itop >> 1)); else ce &= ~(1u << (itop >> 1)); }
            --excess;
        }
        const unsigned se = ae | ce, so = ao | co;
#pragma unroll
        for (int j = 0; j < 8; ++j) mrow[(size_t)j * 262144] = (unsigned char)(((se >> (4 * j)) & 0xfu) | (((so >> (4 * j)) & 0xfu) << 4));
        {
          const int ie = se ? 31 - __builtin_clz(se) : -1, io = so ? 31 - __builtin_clz(so) : -1;
          const int i0 = ie >= 0 ? 2 * ie : -1, i1 = io >= 0 ? 2 * io + 1 : -1, itop = i0 > i1 ? i0 : i1;
          const unsigned p = itop >= 0 ? (unsigned)(((itop >> 3) << 9) | (lane << 3) | (itop & 7)) : 0u;
          const unsigned Lq = wave_max_dpp(p);
          lmv = umax_(lmv, 4095u - Lq); }
    }
    { LAS unsigned* lm = (LAS unsigned*)(C.lds + 132096);
      if (lane == 0) lm[wid] = lmv;
      __syncthreads();
      if (C.tid == 0) { unsigned m_ = lm[0];
#pragma unroll
          for (int i = 1; i < 8; ++i) m_ = umax_(m_, lm[i]);
          ((unsigned*)(C.ws + WS_LMINV))[b * 256 + blk] = m_; } }
}

constexpr int HG_BC = 0, HG_KK = 32768, HG_Q4 = 65536, HG_R = 67584;
struct HgIn { u32x4 fb0, fb1; unsigned iv[16]; };
struct HgOIn { u32x4 fb0, fb1, qb0, qb1, gb0, gb1; unsigned iv[16]; bf16x8 sf[8]; };
__device__ __forceinline__ void hg_rc(int unit, size_t& R0, int& cb) { const int bh = unit >> 6, n = unit & 63; R0 = (size_t)(bh >> 2) * SEQ + 64 * n; cb = (bh & 3) * 128; }
__device__ __forceinline__ void hg_ld16(Ctx& C, const bf16_t* X, int unit, u32x4& a, u32x4& b) {
    size_t R0; int cb; hg_rc(unit, R0, cb); const bf16_t* p = X + (R0 + (C.tid >> 3)) * 512 + cb + (C.tid & 7) * 16; a = *(const u32x4*)p; b = *(const u32x4*)(p + 8); }
__device__ __forceinline__ void hg_ldiv(Ctx& C, int unit, unsigned (&iv)[16]) {
    size_t R0; int cb; hg_rc(unit, R0, cb); const bf16_t* p = WSP(WS_IB) + (R0 + 16 * (C.tid >> 7)) * 512 + cb + (C.tid & 127);
#pragma unroll
    for (int i = 0; i < 16; ++i) iv[i] = p[(size_t)i * 512]; }
__device__ __forceinline__ void hg_ldsf(Ctx& C, const bf16_t* SinT, int unit, bf16x8 (&sf)[8]) {
    const bf16_t* sp = SinT + (size_t)unit * 16384 + (size_t)(32 * (C.wave >> 1) + (C.lane & 31)) * 128 + 8 * (C.lane >> 5);
#pragma unroll
    for (int ks = 0; ks < 8; ++ks) sf[ks] = *(const bf16x8*)(sp + 16 * ks); }
__device__ __forceinline__ void hgrn_stage(Ctx& C, int cb, const float* lbin, u32x4 fb0, u32x4 fb1) {
    LAS float* Bc = (LAS float*)(C.lds + HG_BC); LAS float* KK = (LAS float*)(C.lds + HG_KK); LAS float* Q4 = (LAS float*)(C.lds + HG_Q4);
    const int tid = C.tid;
    { const int row = tid >> 3, seg = tid & 7;
      float fp[16]; { float a[8], b[8]; unpack8(fb0, a); unpack8(fb1, b);
#pragma unroll
          for (int i = 0; i < 8; ++i) { fp[i] = a[i]; fp[8 + i] = b[i]; } }
      float lbv[16]; { const f32x4* lp = (const f32x4*)((const float*)(C.ws + WS_LBT) + cb + seg * 16);
#pragma unroll
          for (int i = 0; i < 4; ++i) { const f32x4 t_ = lp[i]; lbv[4 * i] = t_.x; lbv[4 * i + 1] = t_.y; lbv[4 * i + 2] = t_.z; lbv[4 * i + 3] = t_.w; } }
#pragma unroll
      for (int i = 0; i < 16; ++i) { const float lb = lbv[i];
          const float f = lb + (1.f - lb) * sigm(fp[i]);
          Bc[row * 128 + seg * 16 + i] = __builtin_amdgcn_logf(f);
          KK[row * 128 + seg * 16 + i] = 1.f - f; } }
    __syncthreads();
    const int col = tid & 127, q = tid >> 7;
    { float s = 0.f;
#pragma unroll
      for (int r = 0; r < 16; ++r) { s += Bc[(16 * q + r) * 128 + col]; Bc[(16 * q + r) * 128 + col] = s; }
      Q4[q * 128 + col] = s; }
    __syncthreads();
    { float off = 0.f;
      for (int qq = 0; qq < q; ++qq) off += Q4[qq * 128 + col];
      if (q > 0) {
#pragma unroll
          for (int r = 0; r < 16; ++r) Bc[(16 * q + r) * 128 + col] += off; } }
    __syncthreads();
}
__device__ __forceinline__ void hgrn_stage_vT(Ctx& C, LAS bf16_t* vsT, const unsigned (&t)[16]) {
    const int v = C.tid & 127, sq = C.tid >> 7;
    u32x4 w0, w1; w0.x = t[0] | (t[1] << 16); w0.y = t[2] | (t[3] << 16); w0.z = t[4] | (t[5] << 16); w0.w = t[6] | (t[7] << 16);
    w1.x = t[8] | (t[9] << 16); w1.y = t[10] | (t[11] << 16); w1.z = t[12] | (t[13] << 16); w1.w = t[14] | (t[15] << 16);
    *(LAS u32x4*)(vsT + v * 72 + 16 * sq) = w0; *(LAS u32x4*)(vsT + v * 72 + 16 * sq + 8) = w1;
}
__device__ __forceinline__ void hgrn_local_unit(Ctx& C, int unit, int unext, HgIn& R, bf16_t* LcT, float* DEC, const float* lbin) {
    size_t R0; int cb; hg_rc(unit, R0, cb);
    LAS float* Bc = (LAS float*)(C.lds + HG_BC); LAS float* KK = (LAS float*)(C.lds + HG_KK);
    LAS bf16_t* kdecT = (LAS bf16_t*)(C.lds + HG_R); LAS bf16_t* vsT = (LAS bf16_t*)(C.lds + HG_R + 18432);
    { const u32x4 f0 = R.fb0, f1 = R.fb1; hg_ld16(C, WSP(WS_FB), unext, R.fb0, R.fb1); hgrn_stage(C, cb, lbin, f0, f1); }
    { const int d = C.tid & 127, sq = C.tid >> 7; const float bl = Bc[63 * 128 + d];
      unsigned w[8];
#pragma unroll
      for (int i = 0; i < 8; ++i) { const int s0 = 16 * sq + 2 * i;
          const float a = KK[s0 * 128 + d] * ex2(bl - Bc[s0 * 128 + d]), bb = KK[(s0 + 1) * 128 + d] * ex2(bl - Bc[(s0 + 1) * 128 + d]);
          w[i] = pk2(a, bb); }
      u32x4 w0 = {w[0], w[1], w[2], w[3]}, w1 = {w[4], w[5], w[6], w[7]};
      *(LAS u32x4*)(kdecT + d * 72 + 16 * sq) = w0; *(LAS u32x4*)(kdecT + d * 72 + 16 * sq + 8) = w1; }
    hgrn_stage_vT(C, vsT, R.iv); hg_ldiv(C, unext, R.iv);
    if (C.tid < 128) DEC[(size_t)unit * 128 + C.tid] = ex2(Bc[63 * 128 + C.tid]);
    __syncthreads();
    { const int r32 = C.lane & 31, hi = C.lane >> 5, vb = C.wave >> 1, dbp = C.wave & 1;
      f32x16 c0, c1;
#pragma unroll
      for (int r = 0; r < 16; ++r) { c0[r] = 0.f; c1[r] = 0.f; }
#pragma unroll
      for (int ks = 0; ks < 4; ++ks) {
          const bf16x8 a = *(const LAS bf16x8*)(vsT + (32 * vb + r32) * 72 + 16 * ks + 8 * hi);
          const bf16x8 b0 = *(const LAS bf16x8*)(kdecT + (64 * dbp + r32) * 72 + 16 * ks + 8 * hi);
          const bf16x8 b1 = *(const LAS bf16x8*)(kdecT + (64 * dbp + 32 + r32) * 72 + 16 * ks + 8 * hi);
          c0 = mfma32(a, b0, c0); c1 = mfma32(a, b1, c1); }
      bf16_t* o = LcT + (size_t)unit * 16384;
#pragma unroll
      for (int r = 0; r < 16; ++r) { const int v = 32 * vb + crow(r, hi); o[v * 128 + 64 * dbp + r32] = f2bf(c0[r]); o[v * 128 + 64 * dbp + 32 + r32] = f2bf(c1[r]); } }
    __syncthreads();
}
__device__ __forceinline__ void hgrn_scan(Ctx& C, const bf16_t* LcT, const float* DEC, bf16_t* SinT) {
    for (int gid = C.bid * NTHR + C.tid; gid < 32 * 4096; gid += C.G * NTHR) {
        const int bh = gid >> 12, quad = gid & 4095, v = quad >> 5, d0 = (quad & 31) * 4;
        float st[4] = {0.f, 0.f, 0.f, 0.f};
#pragma unroll 4
        for (int n = 0; n < 64; ++n) {
            const int unit = bh * 64 + n; const size_t e = (size_t)unit * 16384 + v * 128 + d0;
            const u32x2 lc = *(const u32x2*)(LcT + e); const f32x4 dc = *(const f32x4*)(DEC + (size_t)unit * 128 + d0);
            u32x2 w; w.x = pk2(st[0], st[1]); w.y = pk2(st[2], st[3]);
            *(u32x2*)(SinT + e) = w;
            st[0] = dc.x * st[0] + bf2f(lc.x & 0xffffu); st[1] = dc.y * st[1] + bf2f(lc.x >> 16);
            st[2] = dc.z * st[2] + bf2f(lc.y & 0xffffu); st[3] = dc.w * st[3] + bf2f(lc.y >> 16);
        }
    }
}
__device__ __forceinline__ void hgrn_out_unit(Ctx& C, int unit, int unext, HgOIn& R, const bf16_t* SinT, const float* lbin, const float* onb) {
    size_t R0; int cb; hg_rc(unit, R0, cb);
    LAS float* Bc = (LAS float*)(C.lds + HG_BC); LAS float* KK = (LAS float*)(C.lds + HG_KK);
    LAS bf16_t* QTl = (LAS bf16_t*)(C.lds + HG_R); LAS bf16_t* KTl = (LAS bf16_t*)(C.lds + HG_R + 17408);
    LAS bf16_t* vsT = (LAS bf16_t*)(C.lds + HG_R + 34816); LAS bf16_t* Pl = (LAS bf16_t*)(C.lds + HG_R + 34816 + 18432);
    LAS float* OF = (LAS float*)(C.lds + 0);
    { const u32x4 f0 = R.fb0, f1 = R.fb1; hg_ld16(C, WSP(WS_FB), unext, R.fb0, R.fb1); hgrn_stage(C, cb, lbin, f0, f1);
#ifdef HGO_REP_A
      hgrn_stage(C, cb, lbin, f0, f1);
#endif
    }
#ifdef HGO_REP_B
    for (int rb_ = 0; rb_ < 2; ++rb_)
#endif
    { const int row = C.tid >> 3, seg = C.tid & 7;
      float qv[16]; { float a[8], bq[8]; unpack8(R.qb0, a); unpack8(R.qb1, bq);
#pragma unroll
          for (int i = 0; i < 8; ++i) { qv[i] = a[i]; qv[8 + i] = bq[i]; } }
#ifdef HGO_REP_B
      if (rb_ == 1)
#endif
      hg_ld16(C, WSP(WS_QB), unext, R.qb0, R.qb1);
      unsigned wq[8], wk[8];
#pragma unroll
      for (int i = 0; i < 8; ++i) { const int d = seg * 16 + 2 * i;
          const float b0 = Bc[row * 128 + d], b1 = Bc[row * 128 + d + 1];
          wq[i] = pk2(qv[2 * i] * ex2(b0), qv[2 * i + 1] * ex2(b1));
          wk[i] = pk2(KK[row * 128 + d] * ex2(-b0), KK[row * 128 + d + 1] * ex2(-b1)); }
      u32x4 a0 = {wq[0], wq[1], wq[2], wq[3]}, a1 = {wq[4], wq[5], wq[6], wq[7]}, k0 = {wk[0], wk[1], wk[2], wk[3]}, k1 = {wk[4], wk[5], wk[6], wk[7]};
      *(LAS u32x4*)(QTl + row * 136 + seg * 16) = a0; *(LAS u32x4*)(QTl + row * 136 + seg * 16 + 8) = a1;
      *(LAS u32x4*)(KTl + row * 136 + seg * 16) = k0; *(LAS u32x4*)(KTl + row * 136 + seg * 16 + 8) = k1; }
    hgrn_stage_vT(C, vsT, R.iv); hg_ldiv(C, unext, R.iv);
    __syncthreads();
    const int r32 = C.lane & 31, hi = C.lane >> 5;
#ifdef HGO_REP_C
    for (int rc_ = 0; rc_ < 2; ++rc_) {
    if (rc_) __syncthreads();
#else
    {
#endif
    if (C.wave < 4) {
        const int tb = C.wave >> 1, sb = C.wave & 1;
        f32x16 c;
#pragma unroll
        for (int r = 0; r < 16; ++r) c[r] = 0.f;
        if (!(tb == 0 && sb == 1)) {
#pragma unroll
            for (int ks = 0; ks < 8; ++ks) {
                const bf16x8 a = *(const LAS bf16x8*)(QTl + (32 * tb + r32) * 136 + 16 * ks + 8 * hi);
                const bf16x8 bb = *(const LAS bf16x8*)(KTl + (32 * sb + r32) * 136 + 16 * ks + 8 * hi);
                c = mfma32(a, bb, c); }
        }
#pragma unroll
        for (int r = 0; r < 16; ++r) { const int t = 32 * tb + crow(r, hi), s = 32 * sb + r32; Pl[t * 72 + s] = f2bf((s <= t) ? c[r] : 0.f); }
    }
    __syncthreads();
    { const int tb = C.wave & 1, vb = C.wave >> 1;
      f32x16 c;
#pragma unroll
      for (int r = 0; r < 16; ++r) c[r] = 0.f;
#pragma unroll
      for (int ks = 0; ks < 4; ++ks) {
          const bf16x8 a = *(const LAS bf16x8*)(Pl + (32 * tb + r32) * 72 + 16 * ks + 8 * hi);
          const bf16x8 bb = *(const LAS bf16x8*)(vsT + (32 * vb + r32) * 72 + 16 * ks + 8 * hi);
          c = mfma32(a, bb, c); }
#pragma unroll
      for (int ks = 0; ks < 8; ++ks) {
          const bf16x8 a = *(const LAS bf16x8*)(QTl + (32 * tb + r32) * 136 + 16 * ks + 8 * hi);
          c = mfma32(a, R.sf[ks], c); }
#ifdef HGO_REP_C
      if (rc_ == 1)
#endif
      hg_ldsf(C, SinT, unext, R.sf);
#ifdef DUP_SF
      { bf16x8 x_[8]; hg_ldsf(C, SinT, unext ^ 1, x_); asm volatile("" :: "v"(x_[0]), "v"(x_[1]), "v"(x_[2]), "v"(x_[3]), "v"(x_[4]), "v"(x_[5]), "v"(x_[6]), "v"(x_[7])); }
#endif
#pragma unroll
      for (int r = 0; r < 16; ++r) OF[(32 * tb + crow(r, hi)) * 132 + 32 * vb + r32] = c[r]; }
    }
    __syncthreads();
#ifdef HGO_REP_D
    for (int rd_ = 0; rd_ < 2; ++rd_)
#endif
    { const int row = C.tid >> 3, seg = C.tid & 7;
      float o[16]; float ss = 0.f;
#pragma unroll
      for (int i = 0; i < 16; ++i) { o[i] = OF[row * 132 + seg * 16 + i]; ss += o[i] * o[i]; }
      ss += __shfl_xor(ss, 1); ss += __shfl_xor(ss, 2); ss += __shfl_xor(ss, 4);
      const float rs = 1.f / sqrtf(ss * (1.f / 128.f) + EPS);
      float g[16]; { float a[8], bq[8]; unpack8(R.gb0, a); unpack8(R.gb1, bq);
#pragma unroll
          for (int i = 0; i < 8; ++i) { g[i] = a[i]; g[8 + i] = bq[i]; } }
#ifdef HGO_REP_D
      if (rd_ == 1)
#endif
      hg_ld16(C, WSP(WS_GB), unext, R.gb0, R.gb1);
      float ov[16];
#pragma unroll
      for (int i = 0; i < 16; ++i) ov[i] = o[i] * (rs * O8_SCALE) * onb[seg * 16 + i] * g[i];
      u32x4 w8; w8.x = pk4_fp8(ov[0], ov[1], ov[2], ov[3]); w8.y = pk4_fp8(ov[4], ov[5], ov[6], ov[7]); w8.z = pk4_fp8(ov[8], ov[9], ov[10], ov[11]); w8.w = pk4_fp8(ov[12], ov[13], ov[14], ov[15]);
      *(u32x4*)(C.ws + WS_O8B + (size_t)(R0 + row) * 512 + cb + seg * 16) = w8; }
    __syncthreads();
}

template <int D, bool MASKED, bool QN>
__device__ __forceinline__ void attn_unit(Ctx& C, const float* qgain, float qscale, const bf16_t* Qu, int ldq, const bf16_t* Kh, const bf16_t* Vh, int ldkv, const bf16_t* Zu, bf16_t* Ou, int ldo,
                                          int ntiles, const unsigned long long* mask_u, float sl2, int kvref) {
    constexpr int KS = D + 8, VS = 72, NDB = D / 32, NKS = D / 16;
    LAS bf16_t* Kt = (LAS bf16_t*)C.lds; LAS bf16_t* Vt = (LAS bf16_t*)(C.lds + 64 * KS * 2);
    const int tid = C.tid, wid = C.wave, lane = C.lane, r32 = lane & 31, hi = lane >> 5;
    bf16x8 qr[NKS];
    { const bf16_t* Qw = Qu + (size_t)(wid * 32 + r32) * ldq;
#pragma unroll
      for (int ks = 0; ks < NKS; ++ks) qr[ks] = *(const bf16x8*)(Qw + ks * 16 + hi * 8); }
    if (QN) {
        float ss = 0.f;
#pragma unroll
        for (int ks = 0; ks < NKS; ++ks) { float f[8]; unpack8(__builtin_bit_cast(u32x4, qr[ks]), f);
#pragma unroll
            for (int i = 0; i < 8; ++i) ss += f[i] * f[i]; }
        ss += __shfl_xor(ss, 32);
        const float rs = qscale / sqrtf(ss * (1.f / (float)D) + EPS);
#pragma unroll
        for (int ks = 0; ks < NKS; ++ks) { float f[8]; unpack8(__builtin_bit_cast(u32x4, qr[ks]), f); const float* gp = qgain + ks * 16 + hi * 8;
            u32x4 w; w.x = pk2(f[0] * rs * gp[0], f[1] * rs * gp[1]); w.y = pk2(f[2] * rs * gp[2], f[3] * rs * gp[3]); w.z = pk2(f[4] * rs * gp[4], f[5] * rs * gp[5]); w.w = pk2(f[6] * rs * gp[6], f[7] * rs * gp[7]);
            qr[ks] = __builtin_bit_cast(bf16x8, w); }
    }
    f32x16 o[NDB];
#pragma unroll
    for (int db = 0; db < NDB; ++db)
#pragma unroll
        for (int r = 0; r < 16; ++r) o[db][r] = 0.f;
    float m = -1e30f, l = 0.f;
    for (int j = 0; j < ntiles; ++j) {
        __syncthreads();
        for (int i = tid; i < 64 * D / 8; i += NTHR) { const int key = i / (D / 8), seg = i % (D / 8);
            *(LAS u32x4*)(Kt + key * KS + seg * 8) = *(const u32x4*)(Kh + (size_t)(64 * j + key) * ldkv + seg * 8); }
        { constexpr int NK = 64 / (NTHR / D); const int d = tid % D, sq = tid / D;
          const bf16_t* vp = Vh + (size_t)(64 * j + sq * NK) * ldkv + d;
          unsigned t[NK];
#pragma unroll
          for (int i = 0; i < NK; ++i) t[i] = vp[(size_t)i * ldkv];
#pragma unroll
          for (int c = 0; c < NK / 8; ++c) { u32x4 w; w.x = t[8 * c] | (t[8 * c + 1] << 16); w.y = t[8 * c + 2] | (t[8 * c + 3] << 16); w.z = t[8 * c + 4] | (t[8 * c + 5] << 16); w.w = t[8 * c + 6] | (t[8 * c + 7] << 16);
              *(LAS u32x4*)(Vt + d * VS + sq * NK + c * 8) = w; } }
        __syncthreads();
        f32x16 p0, p1;
#pragma unroll
        for (int r = 0; r < 16; ++r) { p0[r] = 0.f; p1[r] = 0.f; }
#pragma unroll
        for (int ks = 0; ks < NKS; ++ks) {
            const bf16x8 a0 = *(const LAS bf16x8*)(Kt + r32 * KS + ks * 16 + hi * 8);
            const bf16x8 a1 = *(const LAS bf16x8*)(Kt + (32 + r32) * KS + ks * 16 + hi * 8);
            p0 = mfma32(a0, qr[ks], p0); p1 = mfma32(a1, qr[ks], p1); }
        if (MASKED) {
            const unsigned long long w = mask_u[(size_t)(wid * 32 + r32) * 64 + j];
            const unsigned wlo = (unsigned)w >> (4 * hi), whi = (unsigned)(w >> 32) >> (4 * hi);
            const float bb = sl2 * (float)(64 * j + 4 * hi - kvref);
#pragma unroll
            for (int r = 0; r < 16; ++r) { const int kc = (r & 3) + 8 * (r >> 2);
                p0[r] = ((wlo >> kc) & 1u) ? p0[r] + (bb + sl2 * (float)kc) : -INFINITY;
                p1[r] = ((whi >> kc) & 1u) ? p1[r] + (bb + sl2 * (float)(kc + 32)) : -INFINITY; }
        }
        float mt = fmaxf(p0[0], p1[0]);
#pragma unroll
        for (int r = 1; r < 16; ++r) mt = fmaxf(mt, fmaxf(p0[r], p1[r]));
        mt = fmaxf(mt, __shfl_xor(mt, 32));
        const float mn = fmaxf(m, mt), alpha = ex2(m - mn); m = mn;
        float s = 0.f;
#pragma unroll
        for (int r = 0; r < 16; ++r) { p0[r] = ex2(p0[r] - mn); p1[r] = ex2(p1[r] - mn); s += p0[r] + p1[r]; }
        l = l * alpha + s;
#pragma unroll
        for (int r = 0; r < 16; ++r) { const float a = __shfl(alpha, crow(r, hi));
#pragma unroll
            for (int db = 0; db < NDB; ++db) o[db][r] *= a; }
        bf16x8 pa[4];
        { u32x4 w;
          w.x = pk2(p0[0], p0[1]); w.y = pk2(p0[2], p0[3]); w.z = pk2(p0[4], p0[5]); w.w = pk2(p0[6], p0[7]); pa[0] = __builtin_bit_cast(bf16x8, w);
          w.x = pk2(p0[8], p0[9]); w.y = pk2(p0[10], p0[11]); w.z = pk2(p0[12], p0[13]); w.w = pk2(p0[14], p0[15]); pa[1] = __builtin_bit_cast(bf16x8, w);
          w.x = pk2(p1[0], p1[1]); w.y = pk2(p1[2], p1[3]); w.z = pk2(p1[4], p1[5]); w.w = pk2(p1[6], p1[7]); pa[2] = __builtin_bit_cast(bf16x8, w);
          w.x = pk2(p1[8], p1[9]); w.y = pk2(p1[10], p1[11]); w.z = pk2(p1[12], p1[13]); w.w = pk2(p1[14], p1[15]); pa[3] = __builtin_bit_cast(bf16x8, w); }
#pragma unroll
        for (int s4 = 0; s4 < 4; ++s4)
#pragma unroll
            for (int db = 0; db < NDB; ++db) {
                const LAS bf16_t* vp = Vt + (db * 32 + r32) * VS + s4 * 16 + hi * 4;
                const u32x2 lo = *(const LAS u32x2*)vp, h2 = *(const LAS u32x2*)(vp + 8);
                u32x4 w = {lo.x, lo.y, h2.x, h2.y};
                o[db] = mfma32(pa[s4], __builtin_bit_cast(bf16x8, w), o[db]); }
    }
    l += __shfl_xor(l, 32);
    const float inv = 1.f / l;
#pragma unroll
    for (int r = 0; r < 16; ++r) { const int q = crow(r, hi); const float iq = __shfl(inv, q); const size_t off = (size_t)(wid * 32 + q) * ldo;
#pragma unroll
        for (int db = 0; db < NDB; ++db) { const int d = db * 32 + r32; const float z = bf2f(Zu[off + d]); Ou[off + d] = f2bf(o[db][r] * iq * z); } }
}
__device__ __forceinline__ void cross_unit(Ctx& C, int b, int h, int qpair, const float* qgain) {
    constexpr int KS = 136, VS = 264;
    LAS bf16_t* Kt = (LAS bf16_t*)C.lds; LAS bf16_t* Vt = (LAS bf16_t*)(C.lds + 256 * KS * 2);
    int tid = C.tid; asm volatile("" : "+v"(tid));
    const int wid = C.wave, lane = tid & 63, r32 = lane & 31, hi = lane >> 5;
    LAS float* wsf = (LAS float*)(C.lds + 256 * KS * 2 + 128 * VS * 2) + wid * 32 + 4 * hi;
    const bf16_t* Kh = WSP(WS_MKV) + (size_t)b * MEMLEN * 1024 + h * 128; const bf16_t* Vh = Kh + 512;
#pragma unroll 2
    for (int i = tid; i < 256 * 16; i += NTHR) { const int key = i >> 4, seg = i & 15;
        *(LAS u32x4*)(Kt + key * KS + seg * 8) = *(const u32x4*)(Kh + (size_t)key * 1024 + seg * 8); }
    { const int d = tid & 127, sq = tid >> 7;
#pragma unroll 2
      for (int c = 0; c < 8; ++c) { unsigned t[8];
#pragma unroll
          for (int i = 0; i < 8; ++i) t[i] = Vh[(size_t)(sq * 64 + c * 8 + i) * 1024 + d];
          u32x4 w; w.x = t[0] | (t[1] << 16); w.y = t[2] | (t[3] << 16); w.z = t[4] | (t[5] << 16); w.w = t[6] | (t[7] << 16);
          *(LAS u32x4*)(Vt + d * VS + sq * 64 + c * 8) = w; } }
    __syncthreads();
#pragma unroll 1
    for (int qq = 0; qq < 2; ++qq) {
        const size_t qrow = (size_t)b * SEQ + (size_t)(qpair * 2 + qq) * 256 + wid * 32;
        const bf16_t* Qw = WSP(WS_QC) + qrow * 512 + h * 128; const bf16_t* Zw = WSP(WS_ZC) + qrow * 512 + h * 128; unsigned char* O8w = C.ws + WS_O8C + qrow * 512 + h * 128;
        bf16x8 qr[8];
#pragma unroll
        for (int ks = 0; ks < 8; ++ks) qr[ks] = *(const bf16x8*)(Qw + (size_t)r32 * 512 + ks * 16 + hi * 8);
        { float ss = 0.f;
#pragma unroll
          for (int ks = 0; ks < 8; ++ks) { float f[8]; unpack8(__builtin_bit_cast(u32x4, qr[ks]), f);
#pragma unroll
              for (int i = 0; i < 8; ++i) ss += f[i] * f[i]; }
          ss += __shfl_xor(ss, 32);
          const float rs = C2C / sqrtf(ss * (1.f / 128.f) + EPS);
#pragma unroll
          for (int ks = 0; ks < 8; ++ks) { float f[8]; unpack8(__builtin_bit_cast(u32x4, qr[ks]), f); const float* gp = qgain + ks * 16 + hi * 8;
              u32x4 w; w.x = pk2(f[0] * rs * gp[0], f[1] * rs * gp[1]); w.y = pk2(f[2] * rs * gp[2], f[3] * rs * gp[3]); w.z = pk2(f[4] * rs * gp[4], f[5] * rs * gp[5]); w.w = pk2(f[6] * rs * gp[6], f[7] * rs * gp[7]);
              qr[ks] = __builtin_bit_cast(bf16x8, w); } }
        f32x16 o[4];
#pragma unroll
        for (int db = 0; db < 4; ++db)
#pragma unroll
            for (int r = 0; r < 16; ++r) o[db][r] = 0.f;
        float m = -1e30f, l = 0.f;
#pragma unroll 1
        for (int j = 0; j < 4; ++j) {
            f32x16 p0, p1;
#pragma unroll
            for (int r = 0; r < 16; ++r) { p0[r] = 0.f; p1[r] = 0.f; }
#pragma unroll
            for (int ks = 0; ks < 8; ++ks) {
                const bf16x8 a0 = *(const LAS bf16x8*)(Kt + (64 * j + r32) * KS + ks * 16 + hi * 8);
                const bf16x8 a1 = *(const LAS bf16x8*)(Kt + (64 * j + 32 + r32) * KS + ks * 16 + hi * 8);
                p0 = mfma32(a0, qr[ks], p0); p1 = mfma32(a1, qr[ks], p1); }
            float mt = fmaxf(p0[0], p1[0]);
#pragma unroll
            for (int r = 1; r < 16; ++r) mt = fmaxf(mt, fmaxf(p0[r], p1[r]));
            mt = fmaxf(mt, __shfl_xor(mt, 32));
            const float mn = fmaxf(m, mt), alpha = ex2(m - mn); m = mn;
            float s_ = 0.f;
#pragma unroll
            for (int r = 0; r < 16; ++r) { p0[r] = ex2(p0[r] - mn); p1[r] = ex2(p1[r] - mn); s_ += p0[r] + p1[r]; }
            l = l * alpha + s_;
            if (j > 0) {
                if (hi == 0) wsf[r32] = alpha;
                asm volatile("s_waitcnt lgkmcnt(0)" ::: "memory");
#pragma unroll
                for (int r = 0; r < 16; ++r) { const float a = wsf[(r & 3) + 8 * (r >> 2)];
#pragma unroll
                    for (int db = 0; db < 4; ++db) o[db][r] *= a; }
                asm volatile("s_waitcnt lgkmcnt(0)" ::: "memory"); }
            bf16x8 pa[4];
            { u32x4 w;
              w.x = pk2(p0[0], p0[1]); w.y = pk2(p0[2], p0[3]); w.z = pk2(p0[4], p0[5]); w.w = pk2(p0[6], p0[7]); pa[0] = __builtin_bit_cast(bf16x8, w);
              w.x = pk2(p0[8], p0[9]); w.y = pk2(p0[10], p0[11]); w.z = pk2(p0[12], p0[13]); w.w = pk2(p0[14], p0[15]); pa[1] = __builtin_bit_cast(bf16x8, w);
              w.x = pk2(p1[0], p1[1]); w.y = pk2(p1[2], p1[3]); w.z = pk2(p1[4], p1[5]); w.w = pk2(p1[6], p1[7]); pa[2] = __builtin_bit_cast(bf16x8, w);
              w.x = pk2(p1[8], p1[9]); w.y = pk2(p1[10], p1[11]); w.z = pk2(p1[12], p1[13]); w.w = pk2(p1[14], p1[15]); pa[3] = __builtin_bit_cast(bf16x8, w); }
#pragma unroll
            for (int s4 = 0; s4 < 4; ++s4)
#pragma unroll
                for (int db = 0; db < 4; ++db) {
                    const LAS bf16_t* vp = Vt + (db * 32 + r32) * VS + 64 * j + s4 * 16 + hi * 4;
                    const u32x2 lo = *(const LAS u32x2*)vp, h2 = *(const LAS u32x2*)(vp + 8);
                    u32x4 w = {lo.x, lo.y, h2.x, h2.y};
                    o[db] = mfma32(pa[s4], __builtin_bit_cast(bf16x8, w), o[db]); }
        }
        l += __shfl_xor(l, 32);
        const float inv = 1.f / l;
        if (hi == 0) wsf[r32] = inv;
        asm volatile("s_waitcnt lgkmcnt(0)" ::: "memory");
        int lo_ = hi * 2048 + r32; asm volatile("" : "+v"(lo_));
#pragma unroll
        for (int r = 0; r < 16; ++r) { const float iq = wsf[(r & 3) + 8 * (r >> 2)]; const unsigned off = (unsigned)((r & 3) + 8 * (r >> 2)) * 512u + (unsigned)lo_;
#pragma unroll
            for (int db = 0; db < 4; ++db) { const float v = __builtin_amdgcn_fmed3f(o[db][r] * (iq * O8_SCALE) * bf2f(Zw[off + db * 32]), -448.f, 448.f); O8w[off + db * 32] = (unsigned char)__builtin_amdgcn_cvt_pk_fp8_f32(v, 0.f, 0, false); } }
        asm volatile("s_waitcnt lgkmcnt(0)" ::: "memory");
    }
    __syncthreads();
}
}
#define ATTN_OUT_FP8 32
#include <hip/hip_bf16.h>
#include <cmath>
namespace attn_a {
using bf16=__hip_bfloat16;
using bf16x8=__attribute__((ext_vector_type(8)))short;
using s16x4=__attribute__((ext_vector_type(4)))short;
using f32x16=__attribute__((ext_vector_type(16)))float;
using u32x4=__attribute__((ext_vector_type(4)))unsigned;
constexpr int BATCH=8,NHEAD=8,SEQ=4096,D=64,DM=NHEAD*D;
constexpr int NW=8,QBLK=32,QB=QBLK*NW,KVBLK=64,NQB=SEQ/QB;
constexpr int ATTN_PITCH=DM, ATTN_UNIT_ROWS=QB;
__device__ __forceinline__ int crow(int r,int hi){return (r&3)+8*(r>>2)+4*hi;}
#define SBAR() __builtin_amdgcn_sched_barrier(0)
__device__ __forceinline__ void kmask(f32x16&p0,f32x16&p1,unsigned long long M,float sl2,int hi){
  const unsigned wlo=(unsigned)M>>(2*hi), whi=(unsigned)(M>>32)>>(2*hi);
  #pragma unroll
  for(int r=0;r<16;++r){ const int kc=(r&3)+8*(r>>2), kb=8*(r>>2)+((r>>1)&1)+4*(r&1);
    const unsigned m0=(unsigned)(((int)(wlo<<(31-kb)))>>31), m1=(unsigned)(((int)(whi<<(31-kb)))>>31);
    const unsigned v0=__float_as_uint(__builtin_fmaf(sl2,(float)kc,p0[r])), v1=__float_as_uint(__builtin_fmaf(sl2,(float)(kc+32),p1[r]));
    unsigned r0_,r1_; asm("v_bfi_b32 %0, %1, %2, %3":"=v"(r0_):"v"(m0),"v"(v0),"s"(0xff800000u)); asm("v_bfi_b32 %0, %1, %2, %3":"=v"(r1_):"v"(m1),"v"(v1),"s"(0xff800000u));
    p0[r]=__uint_as_float(r0_); p1[r]=__uint_as_float(r1_); }
}

constexpr int NSLOT=3, SLOTB=8192;
constexpr int LDS_K=0, LDS_V=NSLOT*SLOTB, LDS_WS=2*NSLOT*SLOTB, LDS_OST=LDS_WS+NW*64*4, LDS_BYTES=LDS_OST+NW*4096;
constexpr float C2=0.125f*1.4426950408889634f;
__device__ __forceinline__ void glds16(const void*gsrc,unsigned lds_dst){unsigned keep;
  asm volatile("s_mov_b32 %0, m0\n\ts_mov_b32 m0, %2\n\ts_nop 0\n\tglobal_load_lds_dwordx4 %1, off\n\ts_mov_b32 m0, %0":"=&s"(keep):"v"(gsrc),"s"(lds_dst):"memory");}
__device__ __forceinline__ void glds4(const void*gsrc,unsigned lds_dst){unsigned keep;
  asm volatile("s_mov_b32 %0, m0\n\ts_mov_b32 m0, %2\n\ts_nop 0\n\tglobal_load_lds_dword %1, off\n\ts_mov_b32 m0, %0":"=&s"(keep):"v"(gsrc),"s"(lds_dst):"memory");}
__device__ __forceinline__ float max3f(float a,float b,float c){float r;asm("v_max3_f32 %0, %1, %2, %3":"=v"(r):"v"(a),"v"(b),"v"(c));return r;}
__device__ __forceinline__ float max2f(float a,float b){float r;asm("v_max_f32_e32 %0, %1, %2":"=v"(r):"v"(a),"v"(b));return r;}
__device__ __forceinline__ float fadd_s(float a,float b){float r;asm("v_add_f32_e32 %0, %1, %2":"=v"(r):"v"(a),"v"(b));return r;}
__device__ __forceinline__ float fsub_s(float a,float b){float r;asm("v_sub_f32_e32 %0, %1, %2":"=v"(r):"v"(a),"v"(b));return r;}
typedef float f32x2_t __attribute__((ext_vector_type(2))); typedef __bf16 bf16x2_t __attribute__((ext_vector_type(2)));
__device__ __forceinline__ unsigned cvtpk_s(float lo,float hi){f32x2_t v={lo,hi};bf16x2_t b=__builtin_convertvector(v,bf16x2_t);return __builtin_bit_cast(unsigned,b);}
#define WAIT_BAR(N) asm volatile("s_waitcnt vmcnt(" #N ") lgkmcnt(0)\n\ts_barrier":::"memory")

__device__ __forceinline__ void qkt(f32x16&p0,f32x16&p1,const char*Kslot,const bf16x8*qr,const f32x16&negm,int r32,int hi){
  const char*kb=Kslot+hi*1024+r32*16;
  #pragma unroll
  for(int d0=0;d0<4;++d0){
    const bf16x8 b0=*reinterpret_cast<const bf16x8*>(kb+d0*2048);
    const bf16x8 b1=*reinterpret_cast<const bf16x8*>(kb+d0*2048+512);
    if(d0==0){p0=__builtin_amdgcn_mfma_f32_32x32x16_bf16(b0,qr[0],negm,0,0,0);p1=__builtin_amdgcn_mfma_f32_32x32x16_bf16(b1,qr[0],negm,0,0,0);}
    else{p0=__builtin_amdgcn_mfma_f32_32x32x16_bf16(b0,qr[d0],p0,0,0,0);p1=__builtin_amdgcn_mfma_f32_32x32x16_bf16(b1,qr[d0],p1,0,0,0);}}
}
typedef __attribute__((address_space(3))) const char* lds_cptr;
typedef short v4i16_t __attribute__((ext_vector_type(4)));
__device__ __forceinline__ void kload8(bf16x8*kf,lds_cptr kp){
  kf[0]=*(const __attribute__((address_space(3))) bf16x8*)(kp);      kf[1]=*(const __attribute__((address_space(3))) bf16x8*)(kp+512);
  kf[2]=*(const __attribute__((address_space(3))) bf16x8*)(kp+2048); kf[3]=*(const __attribute__((address_space(3))) bf16x8*)(kp+2560);
  kf[4]=*(const __attribute__((address_space(3))) bf16x8*)(kp+4096); kf[5]=*(const __attribute__((address_space(3))) bf16x8*)(kp+4608);
  kf[6]=*(const __attribute__((address_space(3))) bf16x8*)(kp+6144); kf[7]=*(const __attribute__((address_space(3))) bf16x8*)(kp+6656);
}
__device__ __forceinline__ void kload2(bf16x8*kf,lds_cptr kp,int j){ kf[2*j]=*(const __attribute__((address_space(3))) bf16x8*)(kp+j*2048); kf[2*j+1]=*(const __attribute__((address_space(3))) bf16x8*)(kp+j*2048+512); }
__device__ __forceinline__ s16x4 vtr(lds_cptr p){ return __builtin_bit_cast(s16x4,__builtin_amdgcn_ds_read_tr16_b64_v4i16((__attribute__((address_space(3))) v4i16_t*)p)); }
__device__ __forceinline__ float rowmax(const f32x16&p0,const f32x16&p1){
  float a=max3f(p0[0],p0[1],p1[0]),b=max3f(p0[2],p0[3],p1[1]);a=max3f(a,p1[2],p1[3]);
  #pragma unroll
  for(int r=4;r<16;r+=4){a=max3f(a,p0[r],p0[r+1]);b=max3f(b,p0[r+2],p0[r+3]);a=max3f(a,p1[r],p1[r+1]);b=max3f(b,p1[r+2],p1[r+3]);}
  const float m=max2f(a,b);
  auto rr=__builtin_amdgcn_permlane32_swap(__float_as_uint(m),__float_as_uint(m),false,false);
  return max2f(__uint_as_float(rr[0]),__uint_as_float(rr[1]));
}
__device__ __forceinline__ void pv(f32x16*o,int vb,bf16x8 pa0,bf16x8 pa1,bf16x8 pa2,bf16x8 pa3){
  #pragma unroll
  for(int d0=0;d0<2;++d0){s16x4 lo[4],hi[4];
    #pragma unroll
    for(int ks=0;ks<4;++ks){
      asm volatile("ds_read_b64_tr_b16 %0,%1 offset:%c2":"=&v"(lo[ks]):"v"(vb),"i"(d0*4096+ks*1024):"memory");
      asm volatile("ds_read_b64_tr_b16 %0,%1 offset:%c2":"=&v"(hi[ks]):"v"(vb),"i"(d0*4096+ks*1024+512):"memory");}
    asm volatile("s_waitcnt lgkmcnt(0)":::"memory");SBAR();
    #define PK(k) (bf16x8){lo[k][0],lo[k][1],lo[k][2],lo[k][3],hi[k][0],hi[k][1],hi[k][2],hi[k][3]}
    o[d0]=__builtin_amdgcn_mfma_f32_32x32x16_bf16(pa0,PK(0),o[d0],0,0,0);
    o[d0]=__builtin_amdgcn_mfma_f32_32x32x16_bf16(pa1,PK(1),o[d0],0,0,0);
    o[d0]=__builtin_amdgcn_mfma_f32_32x32x16_bf16(pa2,PK(2),o[d0],0,0,0);
    o[d0]=__builtin_amdgcn_mfma_f32_32x32x16_bf16(pa3,PK(3),o[d0],0,0,0);
    #undef PK
  }
}

#ifndef ATTN_STORE16
#define ATTN_STORE16(p,v) (*(u32x4*)(p)=(v))
#endif
template<int THRL> __device__ __forceinline__ void attn_unit(int b,int h,int qb,const bf16*Q,const bf16*__restrict__ K,const bf16*__restrict__ V,bf16*O,const bf16*Z,const unsigned long long*MK,float sl2,int tstart,char*shm){
  int tid_=threadIdx.x; asm volatile("":"+v"(tid_));
  const int tid=tid_,lane=tid&63,r32=lane&31,hi=lane>>5; const int wid=__builtin_amdgcn_readfirstlane(tid>>6);
  const long rowbase=(long)b*SEQ; const int q0=qb*QB;
  const bf16*Qw=Q+(((rowbase+q0+wid*QBLK)>>5)*NHEAD+h)*2048;
  const bf16*Kh=K+(rowbase+(long)tstart*KVBLK)*DM+h*D,*Vh=V+(rowbase+(long)tstart*KVBLK)*DM+h*D;
  const unsigned lds0=(unsigned)(uintptr_t)shm;
  float*wsf=(float*)(shm+LDS_WS)+wid*64;
  const bf16*ksrc=Kh+(long)lane*DM+wid*8;
  const bf16*vsrc=Vh+(long)(16*(wid&3)+(lane>>2))*DM+(wid>>2)*32+(lane&3)*8;
  const unsigned kdst=lds0+LDS_K+wid*1024, vdst=lds0+LDS_V+wid*1024;
  #define DMA_K(t,slot) glds16(ksrc+(long)(t)*KVBLK*DM,(unsigned)__builtin_amdgcn_readfirstlane(kdst+(slot)))
  #define DMA_V(t,slot) glds16(vsrc+(long)(t)*KVBLK*DM,(unsigned)__builtin_amdgcn_readfirstlane(vdst+(slot)))
  const int vb0=(int)(lds0+LDS_V)+((lane>>4)&1)*32+(lane&3)*8+(4*hi+((lane&15)>>2))*64;
  const char*Kbase=shm+LDS_K; bf16x8 kf[8];
  const lds_cptr shm3=(lds_cptr)shm; const lds_cptr kp0=shm3+LDS_K+hi*1024+r32*16; const lds_cptr vp0=shm3+LDS_V+((lane>>4)&1)*32+(lane&3)*8+(4*hi+((lane&15)>>2))*64;
  const int NT=(q0+QB)/KVBLK-tstart;
  const unsigned*msrc=(const unsigned*)(MK+((size_t)(b*64+tstart))*4096+(q0+wid*QBLK+(lane>>1)))+(lane&1);
  const unsigned mdst=lds0+LDS_BYTES+wid*512; const lds_cptr mrd=(lds_cptr)shm+LDS_BYTES+wid*512+r32*8;
  glds4(msrc,(unsigned)__builtin_amdgcn_readfirstlane(mdst)); glds4(msrc+8192,(unsigned)__builtin_amdgcn_readfirstlane(mdst+256));
  DMA_K(0,0);DMA_V(0,0);DMA_K(1,SLOTB);
  bf16x8 qr[4];
  #pragma unroll
  for(int d0=0;d0<4;++d0)qr[d0]=*reinterpret_cast<const bf16x8*>(&Qw[d0*512+lane*8]);
  float mhat=0.f,l_reg=0.f;f32x16 o[2];o[0]=f32x16{};o[1]=f32x16{};
  const int qrel=wid*QBLK+r32;
  float tbias=sl2*(float)(4*hi+64*tstart-(q0+QB-1)); const float sl64=64.f*sl2;
  f32x16 negm; _Pragma("unroll") for(int r=0;r<16;++r)negm[r]=tbias; asm volatile("":"+v"(negm));
  #define NEGM_NEXT() do{ tbias+=sl64; const float nb_=tbias-mhat; _Pragma("unroll") for(int r=0;r<16;++r)negm[r]=nb_; asm volatile("":"+v"(negm)); }while(0)
  #define MLOAD(boff,tt) glds4(msrc+(size_t)8192*(tt),(unsigned)__builtin_amdgcn_readfirstlane(mdst+(boff)))
  #define MWORD(boff) (*(const __attribute__((address_space(3))) unsigned long long*)(mrd+(boff)))
  #define CMASK(P0,P1,boff) kmask(P0,P1,MWORD(boff),sl2,hi)
  bool resc=false;
  #define START(P0,P1) do{ const float rm=rowmax(P0,P1); resc=false; \
    { const float dl=max2f(rm,-16000.f); mhat=fadd_s(mhat,dl); \
      _Pragma("unroll") for(int r=0;r<16;++r){P0[r]=fsub_s(P0[r],dl);P1[r]=fsub_s(P1[r],dl);} } \
    _Pragma("unroll") for(int r=0;r<16;++r)P0[r]=__builtin_amdgcn_exp2f(P0[r]); }while(0)
  #define RESC() do{ if(resc){ asm volatile("s_waitcnt lgkmcnt(0)":::"memory"); \
      _Pragma("unroll") for(int d_=0;d_<2;++d_) _Pragma("unroll") for(int r=0;r<16;++r)o[d_][r]*=wsf[crow(r,hi)]; } }while(0)
  f32x16 pA0,pA1,pB0,pB1;
  int sl_prev=0,sl_cur=0,sl_next=SLOTB;
  #define ROT() do{sl_prev=sl_cur;sl_cur=sl_next;sl_next=(sl_next==(NSLOT-1)*SLOTB)?0:sl_next+SLOTB;}while(0)
  DMA_K(2,2*SLOTB);
  WAIT_BAR(3);
  qkt(pA0,pA1,Kbase,qr,negm,r32,hi);asm volatile("s_nop 15\n\ts_nop 7":"+v"(pA0),"+v"(pA1));CMASK(pA0,pA1,0);
  START(pA0,pA1); NEGM_NEXT();
  _Pragma("unroll") for(int r=0;r<16;++r)pA1[r]=__builtin_amdgcn_exp2f(pA1[r]);
  WAIT_BAR(0);
  DMA_K(3,0);DMA_V(1,SLOTB);
  ROT();
  kload8(kf,kp0+sl_cur);
  WAIT_BAR(2);
  s16x4 vlo[8],vhi[8]; u32x4 pw0,pw1,pw2,pw3;
  #define PKW(P,B) cvtpk_s(P[B],P[B+1])
  #define PAF(k) __builtin_bit_cast(bf16x8,pw##k)
  #define VFR(i) (bf16x8){vlo[i][0],vlo[i][1],vlo[i][2],vlo[i][3],vhi[i][0],vhi[i][1],vhi[i][2],vhi[i][3]}
  #define PIN(x) asm volatile("":"+v"(x))
  #define MX3(a,b,c) __builtin_fmaxf(__builtin_fmaxf((a),(b)),(c))
  #define GAPA(MF,A0,A1,A2,A3,W0,W1,PW) do{ MF; sacc+=A0; sacc+=A1; sacc+=A2; sacc+=A3; PIN(sacc); W0; W1; PIN(PW); SBAR(); }while(0)
  #define EX(v) __builtin_amdgcn_exp2f(v)
  #define GAPB(MF,X,B) do{ MF; X[B]=EX(X[B]); X[B+1]=EX(X[B+1]); X[B+2]=EX(X[B+2]); X[B+3]=EX(X[B+3]); PIN(X); SBAR(); }while(0)
  #define VRD(i) do{ vlo[i]=vtr(vp_+(((i)>>2)*4096+((i)&3)*1024)); vhi[i]=vtr(vp_+(((i)>>2)*4096+((i)&3)*1024+512)); }while(0)
  #define KRD(G,j) do{ if(G){ kload2(kf,kp0+sl_next,j); SBAR(); } }while(0)
  #define STEP(C0,C1,P0,P1,t,GK,GV,GL,MCUR,MNXT,GM) do{ SBAR(); \
    const lds_cptr vp_=vp0+sl_prev; \
    VRD(0); SBAR(); float sacc=(P0[0]+P0[1]); \
    GAPA(C0=__builtin_amdgcn_mfma_f32_32x32x16_bf16(kf[0],qr[0],negm,0,0,0), P0[2],P0[3],P0[4],P0[5],     pw0[0]=PKW(P0,0), pw0[1]=PKW(P0,2), pw0); \
    VRD(4); SBAR(); GAPA(C1=__builtin_amdgcn_mfma_f32_32x32x16_bf16(kf[1],qr[0],negm,0,0,0), P0[6],P0[7],P0[8],P0[9],     pw0[2]=PKW(P0,4), pw0[3]=PKW(P0,6), pw0); \
    VRD(1); SBAR(); GAPA(C0=__builtin_amdgcn_mfma_f32_32x32x16_bf16(kf[2],qr[1],C0,0,0,0),   P0[10],P0[11],P0[12],P0[13], pw1[0]=PKW(P0,8), pw1[1]=PKW(P0,10), pw1); \
    VRD(5); SBAR(); GAPA(C1=__builtin_amdgcn_mfma_f32_32x32x16_bf16(kf[3],qr[1],C1,0,0,0),   P0[14],P0[15],P1[0],P1[1],   pw1[2]=PKW(P0,12),pw1[3]=PKW(P0,14), pw1); \
    VRD(2); SBAR(); GAPA(C0=__builtin_amdgcn_mfma_f32_32x32x16_bf16(kf[4],qr[2],C0,0,0,0),   P1[2],P1[3],P1[4],P1[5],     pw2[0]=PKW(P1,0), pw2[1]=PKW(P1,2), pw2); \
    VRD(6); SBAR(); GAPA(C1=__builtin_amdgcn_mfma_f32_32x32x16_bf16(kf[5],qr[2],C1,0,0,0),   P1[6],P1[7],P1[8],P1[9],     pw2[2]=PKW(P1,4), pw2[3]=PKW(P1,6), pw2); \
    VRD(3); SBAR(); GAPA(C0=__builtin_amdgcn_mfma_f32_32x32x16_bf16(kf[6],qr[3],C0,0,0,0),   P1[10],P1[11],P1[12],P1[13], pw3[0]=PKW(P1,8), pw3[1]=PKW(P1,10), pw3); \
    VRD(7); SBAR(); GAPA(C1=__builtin_amdgcn_mfma_f32_32x32x16_bf16(kf[7],qr[3],C1,0,0,0),   P1[14],P1[15],0.f,0.f,       pw3[2]=PKW(P1,12),pw3[3]=PKW(P1,14), pw3); \
    l_reg+=sacc; \
    if(GM){MLOAD(MNXT,(t)+1);} if(GK){DMA_K((t)+3,sl_cur);} if(GV){DMA_V((t)+1,sl_next);} \
    CMASK(C0,C1,MCUR); \
    { float a=MX3(C0[0],C0[1],C1[0]),b=MX3(C0[2],C0[3],C1[1]); a=MX3(a,C1[2],C1[3]); \
      _Pragma("unroll") for(int r=4;r<16;r+=4){a=MX3(a,C0[r],C0[r+1]);b=MX3(b,C0[r+2],C0[r+3]);a=MX3(a,C1[r],C1[r+1]);b=MX3(b,C1[r+2],C1[r+3]);} \
      float rm=__builtin_fmaxf(a,b); { auto rr=__builtin_amdgcn_permlane32_swap(__float_as_uint(rm),__float_as_uint(rm),false,false); rm=__builtin_fmaxf(__uint_as_float(rr[0]),__uint_as_float(rr[1])); } \
      resc=false; \
      if(__builtin_expect(__any(rm>(float)THRL),0)){ const float dl=__builtin_fmaxf(rm,0.f); mhat+=dl; \
        _Pragma("unroll") for(int r=0;r<16;++r){C0[r]-=dl;C1[r]-=dl;} \
        const float f=__builtin_amdgcn_exp2f(-dl); l_reg*=f; if(hi==0)wsf[r32]=f; resc=true; } } \
    NEGM_NEXT(); \
    SBAR(); \
    GAPB(o[0]=__builtin_amdgcn_mfma_f32_32x32x16_bf16(PAF(0),VFR(0),o[0],0,0,0), C0,0); \
    GAPB(o[1]=__builtin_amdgcn_mfma_f32_32x32x16_bf16(PAF(0),VFR(4),o[1],0,0,0), C0,4); \
    KRD(GL,0); GAPB(o[0]=__builtin_amdgcn_mfma_f32_32x32x16_bf16(PAF(1),VFR(1),o[0],0,0,0), C0,8); \
    KRD(GL,1); GAPB(o[1]=__builtin_amdgcn_mfma_f32_32x32x16_bf16(PAF(1),VFR(5),o[1],0,0,0), C0,12); \
    KRD(GL,2); GAPB(o[0]=__builtin_amdgcn_mfma_f32_32x32x16_bf16(PAF(2),VFR(2),o[0],0,0,0), C1,0); \
    KRD(GL,3); GAPB(o[1]=__builtin_amdgcn_mfma_f32_32x32x16_bf16(PAF(2),VFR(6),o[1],0,0,0), C1,4); \
    GAPB(o[0]=__builtin_amdgcn_mfma_f32_32x32x16_bf16(PAF(3),VFR(3),o[0],0,0,0), C1,8); \
    GAPB(o[1]=__builtin_amdgcn_mfma_f32_32x32x16_bf16(PAF(3),VFR(7),o[1],0,0,0), C1,12); \
    }while(0)
  int t=1;
  for(;t+5<NT;t+=2){
    STEP(pB0,pB1,pA0,pA1,t,true,true,true,256,0,true);     WAIT_BAR(2); RESC(); ROT();
    STEP(pA0,pA1,pB0,pB1,t+1,true,true,true,0,256,true);   WAIT_BAR(2); RESC(); ROT();
  }
  #define ENDW(tt) do{ if((tt)+3<NT){WAIT_BAR(2);} else if((tt)+2<NT){WAIT_BAR(1);} else {WAIT_BAR(0);} }while(0)
  for(;t+1<NT;t+=2){
    STEP(pB0,pB1,pA0,pA1,t,(t+3<NT),(t+1<NT),(t+1<NT),256,0,(t+1<NT));       ENDW(t);   RESC(); ROT();
    STEP(pA0,pA1,pB0,pB1,t+1,(t+4<NT),(t+2<NT),(t+2<NT),0,256,(t+2<NT));     ENDW(t+1); RESC(); ROT();
  }
  STEP(pB0,pB1,pA0,pA1,NT-1,false,false,false,256,0,false); RESC();
  { float sacc=pB0[0]+pB0[1]; _Pragma("unroll") for(int r=2;r<16;++r)sacc+=pB0[r]; _Pragma("unroll") for(int r=0;r<16;++r)sacc+=pB1[r]; l_reg+=sacc;
    pw0=(u32x4){PKW(pB0,0),PKW(pB0,2),PKW(pB0,4),PKW(pB0,6)};pw1=(u32x4){PKW(pB0,8),PKW(pB0,10),PKW(pB0,12),PKW(pB0,14)};pw2=(u32x4){PKW(pB1,0),PKW(pB1,2),PKW(pB1,4),PKW(pB1,6)};pw3=(u32x4){PKW(pB1,8),PKW(pB1,10),PKW(pB1,12),PKW(pB1,14)};
    SBAR(); pv(o,vb0+sl_cur,PAF(0),PAF(1),PAF(2),PAF(3)); }
  #undef PKW
  #undef PAF
  #undef VFR
  #undef PIN
  #undef MX3
  #undef GAPA
  #undef GAPB
  #undef EX
  #undef VRD
  #undef KRD
  #undef STEP
  #undef ENDW
  {auto rr=__builtin_amdgcn_permlane32_swap(__float_as_uint(l_reg),__float_as_uint(l_reg),false,false);l_reg=__uint_as_float(rr[0])+__uint_as_float(rr[1]);}
  if(hi==0)wsf[32+r32]=l_reg;asm volatile("s_waitcnt lgkmcnt(0)":::"memory");
  float rli[16];
  #pragma unroll
  for(int r=0;r<16;++r)rli[r]=__builtin_amdgcn_rcpf(wsf[32+crow(r,hi)]);
  bf16*Ow=O+(rowbase+q0+wid*QBLK)*DM+h*D;
  { bf16*stg=(bf16*)(shm+LDS_OST)+wid*2048;
    #pragma unroll
    for(int r=0;r<16;++r){const int orow=crow(r,hi);
      #pragma unroll
      for(int d0=0;d0<2;++d0)stg[orow*64+d0*32+r32]=__float2bfloat16(o[d0][r]*rli[r]);}
    asm volatile("s_waitcnt lgkmcnt(0)":::"memory");
    const bf16*Zw=Z+(rowbase+q0+wid*QBLK)*DM+h*D;
    #pragma unroll
    for(int i=0;i<4;++i){const int row=i*8+(lane>>3),ch=lane&7; const u32x4 v=*(const u32x4*)(stg+row*64+ch*8); const u32x4 z=*(const u32x4*)(Zw+(long)row*DM+ch*8); u32x4 w;
      #pragma unroll
      for(int e=0;e<4;++e){ const float a0=__uint_as_float(v[e]<<16)*__uint_as_float(z[e]<<16), a1=__uint_as_float(v[e]&0xffff0000u)*__uint_as_float(z[e]&0xffff0000u); w[e]=cvtpk_s(a0,a1); }
      #ifdef ATTN_OUT_FP8
      { float f[8];
        #pragma unroll
        for(int e=0;e<4;++e){ f[2*e]=__builtin_amdgcn_fmed3f(__uint_as_float(w[e]<<16)*(float)(ATTN_OUT_FP8),-448.f,448.f); f[2*e+1]=__builtin_amdgcn_fmed3f(__uint_as_float(w[e]&0xffff0000u)*(float)(ATTN_OUT_FP8),-448.f,448.f); }
        int p0=__builtin_amdgcn_cvt_pk_fp8_f32(f[0],f[1],0,false); p0=__builtin_amdgcn_cvt_pk_fp8_f32(f[2],f[3],p0,true);
        int p1=__builtin_amdgcn_cvt_pk_fp8_f32(f[4],f[5],0,false); p1=__builtin_amdgcn_cvt_pk_fp8_f32(f[6],f[7],p1,true);
        typedef unsigned u32x2_t __attribute__((ext_vector_type(2))); u32x2_t w8={(unsigned)p0,(unsigned)p1};
        *(u32x2_t*)((unsigned char*)O+((rowbase+q0+wid*QBLK+row)*(long)DM+h*D+ch*8))=w8; }
      #else
      ATTN_STORE16(Ow+(long)row*DM+ch*8,w);
      #endif
      } }
  asm volatile("s_waitcnt lgkmcnt(0)\n\ts_barrier":::"memory");
  #undef DMA_K
  #undef DMA_V
  #undef CMASK
  #undef NEGM_NEXT
  #undef MLOAD
  #undef MWORD
  #undef START
  #undef RESC
  #undef ROT
}
constexpr int ATTN_LDS_BYTES=LDS_BYTES;
#undef SBAR
#undef WAIT_BAR
}
__device__ const unsigned char att_order[128] = {127, 111, 126, 110, 125, 109, 95, 94, 93, 124, 108, 92, 123, 107, 91, 122, 106, 90, 121, 105, 89, 120, 104, 88, 119, 103, 87, 79, 78, 77, 76, 75, 74, 73, 72, 71, 118, 102, 86, 70, 117, 101, 85, 69, 116, 100, 84, 68, 63, 62, 61, 60, 59, 58, 57, 56, 55, 54, 53, 52, 115, 99, 83, 67, 51, 114, 98, 82, 66, 50, 47, 46, 45, 44, 43, 42, 41, 40, 39, 38, 37, 36, 35, 34, 113, 97, 81, 65, 49, 33, 31, 30, 29, 28, 27, 26, 25, 24, 23, 22, 21, 20, 19, 18, 17, 15, 14, 13, 12, 11, 10, 9, 8, 7, 6, 5, 4, 3, 2, 1, 112, 96, 80, 64, 48, 32, 16, 0};
#define GAS __attribute__((address_space(1)))
typedef GAS unsigned gu32;
#define RLX_AGENT __ATOMIC_RELAXED, __HIP_MEMORY_SCOPE_AGENT
#define XB_TMO      128
#define XB_XCNT(j)  (256  + 64 * (j))
#define XB_XSUB(j)  (1280 + 64 * (j))
#define XB_XGEN(j)  (2304 + 64 * (j))
#define XB_TOP      3328
#define XB_TOPGEN   3392
#define XCD_BAR_WORDS 3456
#define XB_SPIN_CAP (1u << 18)

__device__ __forceinline__ unsigned xb_ld(unsigned* p)              { return __hip_atomic_load(p, __ATOMIC_RELAXED, __HIP_MEMORY_SCOPE_AGENT); }
__device__ __forceinline__ unsigned xb_add(unsigned* p, unsigned v) { return __hip_atomic_fetch_add(p, v, __ATOMIC_RELAXED, __HIP_MEMORY_SCOPE_AGENT); }
__device__ __forceinline__ unsigned xb_xcc_id() { return (unsigned)__builtin_amdgcn_s_getreg((3 << 11) | 20) & 0xFu; }
#define XB_SPIN(cond, bar) do { unsigned _sp = 0; while (cond) { __builtin_amdgcn_s_sleep(1); \
    if ((++_sp & 255u) == 0u) { if (xb_ld(&(bar)[XB_TMO])) break; if (_sp > XB_SPIN_CAP) { atomicAdd(&(bar)[XB_TMO], 1u); break; } } } } while (0)

struct XcdBarrier {
    unsigned* bar; unsigned x;
    volatile LAS unsigned* st;
};

__device__ __forceinline__ XcdBarrier xcd_barrier_post(unsigned* bar, volatile LAS unsigned* st) {
    XcdBarrier b; b.bar = bar; b.x = xb_xcc_id(); b.st = st;
    if (threadIdx.x == 0) (void)xb_add(&bar[XB_XCNT(b.x)], 1u);
    return b;
}
__device__ __forceinline__ void xcd_barrier_complete(unsigned* bar, unsigned x, unsigned& nloc, unsigned& nx) {
    const unsigned G = gridDim.x * gridDim.y * gridDim.z;
    unsigned sum, cnt, mine, sp = 0u;
    for (;;) {
        sum = 0u; cnt = 0u; mine = 0u;
#pragma unroll
        for (unsigned j = 0; j < 16; ++j) { const unsigned c = xb_ld(&bar[XB_XCNT(j)]); sum += c; cnt += (c > 0u) ? 1u : 0u; mine = (j == x) ? c : mine; }
        if (sum == G) break;
        __builtin_amdgcn_s_sleep(1);
        if ((++sp & 255u) == 0u) { if (xb_ld(&bar[XB_TMO])) break; if (sp > XB_SPIN_CAP) { atomicAdd(&bar[XB_TMO], 1u); break; } }
    }
    nloc = mine > 0u ? mine : 1u; nx = cnt > 0u ? cnt : 1u;
}

__device__ __forceinline__ void xcd_barrier(const XcdBarrier& b) {
    asm volatile("s_waitcnt vmcnt(0)" ::: "memory");
    __syncthreads();
    if (threadIdx.x == 0) {
        unsigned* bar = b.bar;
        __builtin_amdgcn_s_waitcnt(0);
        unsigned nloc = b.st[0], nx = b.st[1];
        if (nloc == 0u) { xcd_barrier_complete(bar, b.x, nloc, nx); b.st[0] = nloc; b.st[1] = nx; }
        const unsigned old = xb_add(&bar[XB_XSUB(b.x)], 1u);
        const unsigned gen = old / nloc;
        if (old + 1u == (gen + 1u) * nloc) {
            __builtin_amdgcn_fence(__ATOMIC_RELEASE, "agent");
            asm volatile("s_waitcnt vmcnt(0)" ::: "memory");
            const unsigned og = xb_add(&bar[XB_TOP], 1u);
            const unsigned tg = og / nx;
            if (og + 1u == (tg + 1u) * nx) xb_add(&bar[XB_TOPGEN], 1u);
            else XB_SPIN(xb_ld(&bar[XB_TOPGEN]) == tg, bar);
            __builtin_amdgcn_fence(__ATOMIC_ACQUIRE, "agent");
            xb_add(&bar[XB_XGEN(b.x)], 1u);
            asm volatile("s_waitcnt vmcnt(0)" ::: "memory");
        } else {
            XB_SPIN(xb_ld(&bar[XB_XGEN(b.x)]) == gen, bar);
            __builtin_amdgcn_fence(__ATOMIC_ACQUIRE, "agent");
            asm volatile("s_waitcnt vmcnt(0)" ::: "memory");
        }
    }
    __syncthreads();
}
#ifndef N_LAUNCH_MODE
#define N_LAUNCH_MODE 1
#endif
namespace cg = cooperative_groups;
#ifndef REPS_HGL
#define REPS_HGL 1
#endif
#ifndef REPS_IDX
#define REPS_IDX 1
#endif
#ifndef REPS_CROSS
#define REPS_CROSS 1
#endif
#ifndef REPS_HGO
#define REPS_HGO 1
#endif
#ifndef G1_NOSTORE
#define G1_NOSTORE 0
#endif
#ifndef REPS_GATE
#define REPS_GATE 1
#endif
#ifndef REPS_G1F8
#define REPS_G1F8 1
#endif
#ifndef REPS_G1IX
#define REPS_G1IX 1
#endif
#ifndef REPS_P0
#define REPS_P0 1
#endif
using namespace hy;
struct Args { const float* in[14]; float* out; unsigned char* ws; };
constexpr int NPHASE = 7;

template <int PH> __global__ void __launch_bounds__(512, 2) fwd_kernel(Args args) {
    extern __shared__ __attribute__((aligned(16))) unsigned char lds_raw[];
    Ctx C;
    C.out = args.out; C.ws = args.ws; C.lds = (LAS unsigned char*)lds_raw;
    C.tid = threadIdx.x; C.lane = C.tid & 63; C.wave = __builtin_amdgcn_readfirstlane(C.tid >> 6); C.G = gridDim.x; C.bid = blockIdx.x;
#ifndef PHASE_MASK
#define PHASE_MASK 0x7f
#endif
#define IN(k) (((PHASE_MASK >> (k)) & 1) && (PH < 0 || PH == (k)))
    volatile LAS unsigned* bar_st = (volatile LAS unsigned*)(C.lds + LDS_BYTES - 16);
    if (C.tid < 4) bar_st[C.tid] = 0u;
    __syncthreads();
    XcdBarrier bar = xcd_barrier_post((unsigned*)C.ws + 4096, bar_st);
#define QNEXT(qi, var) do { volatile LAS unsigned* qs_ = (volatile LAS unsigned*)(C.lds + LDS_BYTES - 8); if (C.tid == 0) *qs_ = atomicAdd((unsigned*)(C.ws + 36864) + 64 * (qi), 1u); \
        __syncthreads(); var = *qs_; __syncthreads(); } while (0)
#ifdef DUP_BAR
#define SEAM(k) do { if (IN(k) && IN((k) + 1)) { xcd_barrier(bar); xcd_barrier(bar); } } while (0)
#else
#define SEAM(k) do { if (IN(k) && IN((k) + 1)) { xcd_barrier(bar); } } while (0)
#endif
    bf16_t* LcT = (bf16_t*)((unsigned char*)C.out + OUT_LCT); bf16_t* SinT = (bf16_t*)((unsigned char*)C.out + OUT_SINT); bf16_t* OA = LcT;     float* DEC = (float*)(C.ws + WS_DEC);

    if (IN(0)) for (int rep_ = 0; rep_ < REPS_P0; ++rep_) { if (rep_) __syncthreads(); p0_prologue(C, args.in[0], args.in[1], args.in[2], args.in[3], args.in[4], args.in[9], args.in[12], args.in[13], args.in[7]); }
    SEAM(0);
    if (IN(1))
    {
        { pg8::Gemm g{WSP(WS_H8), (const bf16_t*)(C.ws + WS_W8), T, N1 - (IX_HI - IX_LO), DM / 2}; pg8::SkipOrder S; S.so.init(T, N1 - (IX_HI - IX_LO), C.G, C.bid); S.lo = IX_LO / 256; S.skip = (IX_HI - IX_LO) / 256; EpiP1 E{C.ws, args.in[5], args.in[6]};
          for (int rep_ = 0; rep_ < REPS_G1F8; ++rep_) { E.nostore = (rep_ > 0) && G1_NOSTORE; pg8::gemm_phase<EpiP1, pg8::SkipOrder, true, true, true>(C.lds, g, S, E); } }
        { pg8::Gemm g{WSP(WS_H), WSP(WS_WIX), T, IX_HI - IX_LO, DM}; pg8::SkipOrder S; S.so.init(T, IX_HI - IX_LO, C.G, C.bid); S.lo = 0; S.skip = IX_LO / 256; EpiP1 E{C.ws, args.in[5], args.in[6]};
          for (int rep_ = 0; rep_ < REPS_G1IX; ++rep_) pg8::gemm_phase<EpiP1, pg8::SkipOrder, true, true>(C.lds, g, S, E); }
        if (C.G == 256 ? (C.bid >= 128) : true) { const int G2 = (C.G == 256) ? 128 : C.G, c2 = (C.G == 256) ? C.bid - 128 : C.bid;
          pg8::Gemm g{WSP(WS_HM), WSP(WS_WM), TM, DM, DM}; pg8::StaticOrder S; S.init(TM, DM, G2, c2); EpiPlain<0> E{WSP(WS_MKV), DM};
          pg8::gemm_phase<EpiPlain<0>, pg8::StaticOrder, true, true>(C.lds, g, S, E); }
    }
    SEAM(1);
    if (IN(2)) {
        const int gw = C.bid * NWAVES + C.wave, NGW = C.G * NWAVES;
        norm_rows_inplace(WSP(WS_MKV), 1024, TM, 128, args.in[11], 1.f, gw, NGW, C.lane);
        __syncthreads();
        for (int rep_ = 0; rep_ < REPS_HGL; ++rep_)
        { HgIn R; if (C.bid < 2048) { hg_ld16(C, WSP(WS_FB), C.bid, R.fb0, R.fb1); hg_ldiv(C, C.bid, R.iv); }
          for (int u = C.bid; u < 2048; u += C.G) hgrn_local_unit(C, u, (u + C.G < 2048) ? u + C.G : u, R, LcT, DEC, args.in[7]); }
        for (int rep_ = 0; rep_ < REPS_IDX; ++rep_)
        for (int i = 0;; ++i) { const int idx = i * C.G + ((i & 1) ? (C.G - 1 - C.bid) : C.bid); if (idx >= 2048) break; indexer_unit(C, idx & 7, 255 - (idx >> 3)); }
    }
    SEAM(2);
    if (IN(3)) {
        hgrn_scan(C, LcT, DEC, SinT);
        for (int rep_ = 0; rep_ < REPS_CROSS; ++rep_)
        for (int u = C.bid; u < 256; u += C.G) cross_unit(C, u >> 5, (u >> 3) & 3, u & 7, args.in[10]);
    }
    SEAM(3);
    if (IN(4)) {
        for (;;) {
            unsigned ui; QNEXT(0, ui);
            if (ui >= 1024u) break;
            const int combo = att_order[ui >> 3], b = ui & 7, h = combo >> 4, qb = combo & 15;
            const float sl2 = ex2(-(float)(h + 1)) * LOG2E;
            int tstart;
            { const float gq = fabsf(args.in[5][C.lane]), gk = fabsf(args.in[6][C.lane]);
              const float A = __uint_as_float(wave_max_dpp(__float_as_uint(gq))) * __uint_as_float(wave_max_dpp(__float_as_uint(gk))) * (64.f * C2A * 1.02f);
              const unsigned lv = wave_max_dpp(C.lane < 16 ? ((const unsigned*)(C.ws + WS_LMINV))[b * 256 + qb * 16 + C.lane] : 0u);
              const float lim = (float)(4095 - (int)lv) - (2.f * A + 32.f) / sl2 + 1.f;
              int ts = lim > 0.f ? ((int)(lim * (1.f / 64.f))) & ~1 : 0; const int ntl = 4 * (qb + 1);
              ts = ts > ntl - 4 ? ntl - 4 : ts; tstart = __builtin_amdgcn_readfirstlane(ts); }
            attn_a::attn_unit<8>(b, h, qb, (const attn_a::bf16*)WSP(WS_QA), (const attn_a::bf16*)WSP(WS_KA), (const attn_a::bf16*)WSP(WS_VA), (attn_a::bf16*)OA, (const attn_a::bf16*)WSP(WS_ZA),
                                 (const unsigned long long*)(C.ws + WS_MASK), sl2, tstart, (char*)lds_raw);
        }
        for (int rep_ = 0; rep_ < REPS_HGO; ++rep_)
        { HgOIn R; if (C.bid < 2048) { hg_ld16(C, WSP(WS_FB), C.bid, R.fb0, R.fb1); hg_ld16(C, WSP(WS_QB), C.bid, R.qb0, R.qb1); hg_ldiv(C, C.bid, R.iv); hg_ldsf(C, SinT, C.bid, R.sf); hg_ld16(C, WSP(WS_GB), C.bid, R.gb0, R.gb1); }
          for (int u = C.bid; u < 2048; u += C.G) hgrn_out_unit(C, u, (u + C.G < 2048) ? u + C.G : u, R, SinT, args.in[7], args.in[8]); }
    }
    SEAM(4);
    static_assert(O8_SCALE == (float)(ATTN_OUT_FP8), "attention output scale");
    if (IN(5))
    {
#pragma unroll 1
        for (int n = 0; n < 3; ++n) {
            { pg8::Gemm g{WSP(WS_H8), (const bf16_t*)(C.ws + WS_WG8 + (size_t)n * DM * DM), T, DM, DM / 2}; pg8::StaticOrder S; S.init(T, DM, C.G, C.bid); EpiPlain<1> E{WSP(WS_G), DM};
              for (int rep_ = 0; rep_ < REPS_GATE; ++rep_) pg8::gemm_phase<EpiPlain<1>, pg8::StaticOrder, true, true, true>(C.lds, g, S, E); }
            { const bf16_t* br = (n == 0) ? OA : (n == 1) ? WSP(WS_O8B) : WSP(WS_O8C);
              pg8::Gemm g{br, (const bf16_t*)(C.ws + WS_WB + (size_t)n * DM * 512), T, DM, 256}; pg8::StaticOrder S; S.init(T, DM, C.G, C.bid);
              if (n < 2) { EpiMerge<false> E{WSP(WS_G), WSP(WS_MB), n == 0 ? 1 : 0, nullptr}; pg8::gemm_phase<EpiMerge<false>, pg8::StaticOrder, true, true, true>(C.lds, g, S, E); }
              else { EpiMerge<true> E{WSP(WS_G), WSP(WS_MB), 0, C.ws + WS_M8}; pg8::gemm_phase<EpiMerge<true>, pg8::StaticOrder, true, true, true>(C.lds, g, S, E); } }
        }
    }
    SEAM(5);
    if (IN(6))
    {
        pg8::Gemm g{WSP(WS_M8), WSP(WS_WO), T, DM, DM / 2}; pg8::StaticOrder S; S.init(T, DM, C.G, C.bid); EpiOut E{args.in[0], C.out};
        pg8::gemm_phase<EpiOut, pg8::StaticOrder, true, true, true>(C.lds, g, S, E);
    }
#undef IN
#undef SEAM
}

extern "C" void kernel_launch(void* const* d_in, const int* in_sizes, int n_in, void* d_out, int out_size, void* d_ws, size_t ws_size, hipStream_t stream) {
    static int grid = 0;
    if (grid == 0) {
        if (n_in != 14 || out_size != T * DM || ws_size < WS_END) { fprintf(stderr, "kernel_launch: unexpected problem shape (n_in %d out %d ws %zu)\n", n_in, out_size, ws_size); grid = -1; return; }
        int dev = 0, cus = 0, per_cu = 0;
        hipGetDevice(&dev); hipDeviceGetAttribute(&cus, hipDeviceAttributeMultiprocessorCount, dev);
#if N_LAUNCH_MODE == 1
        if (hipFuncSetAttribute((const void*)fwd_kernel<-1>, hipFuncAttributeMaxDynamicSharedMemorySize, LDS_BYTES) != hipSuccess) { fprintf(stderr, "kernel_launch: hipFuncSetAttribute failed\n"); grid = -1; return; }
        hipOccupancyMaxActiveBlocksPerMultiprocessor(&per_cu, (const void*)fwd_kernel<-1>, NTHR, LDS_BYTES);
        (void)hipGetLastError();
#endif
        if (per_cu < 1) per_cu = 1;
        grid = cus;
    }
    if (grid < 0) return;
    if (hipMemsetAsync(d_ws, 0, 65536, stream) != hipSuccess) { fprintf(stderr, "kernel_launch: hipMemsetAsync failed\n"); return; }
    Args a{};
    for (int i = 0; i < 14; ++i) a.in[i] = (const float*)d_in[i];
    a.out = (float*)d_out; a.ws = (unsigned char*)d_ws;
#if N_LAUNCH_MODE == 1
    void* kargs[] = {&a};
#ifdef HOST_TWICE
    (void)hipLaunchCooperativeKernel((const void*)fwd_kernel<-1>, dim3(grid), dim3(NTHR), kargs, LDS_BYTES, stream);
    (void)hipMemsetAsync(d_ws, 0, 65536, stream);
#endif
    hipError_t e = hipLaunchCooperativeKernel((const void*)fwd_kernel<-1>, dim3(grid), dim3(NTHR), kargs, LDS_BYTES, stream);
    if (e != hipSuccess) fprintf(stderr, "kernel_launch: cooperative launch failed: %s (grid %d)\n", hipGetErrorString(e), grid);
#else
#define LAUNCH_PH(p) do { (void)hipFuncSetAttribute((const void*)fwd_kernel<p>, hipFuncAttributeMaxDynamicSharedMemorySize, LDS_BYTES); hipLaunchKernelGGL(fwd_kernel<p>, dim3(grid), dim3(NTHR), LDS_BYTES, stream, a); } while (0)
    LAUNCH_PH(0); LAUNCH_PH(1); LAUNCH_PH(2); LAUNCH_PH(3); LAUNCH_PH(4); LAUNCH_PH(5); LAUNCH_PH(6);
#endif
}
```

```cpp
#include <hip/hip_runtime.h>
#include <hip/hip_cooperative_groups.h>
#include <cstdio>
#include <cstdint>
#define N_LAUNCH_MODE 1
namespace pg8 {
#define PG8_LAS __attribute__((address_space(3)))
typedef unsigned short bf16_t;
typedef short bf16x8 __attribute__((ext_vector_type(8)));
typedef float f32x4 __attribute__((ext_vector_type(4)));
typedef unsigned u32x4 __attribute__((ext_vector_type(4)));
constexpr int BM = 256, BK = 64, HALF = 128, HTB = HALF * BK * 2  , STAGE_BYTES = 8 * HTB, NXCD = 8, WGM = 8;

__host__ __device__ __forceinline__ int lds_byte(int r, int c) { const int st = (r >> 4) * 2 + (c >> 5), rr = r & 15, cc = c & 31, ob = rr * 64 + cc * 2; return st * 1024 + (ob ^ (((ob >> 9) & 1) << 5)); }
__host__ __device__ __forceinline__ void stage_rc(int b, int& R, int& C) { const int st = b / 1024, sb = b % 1024, swz = sb ^ (((sb >> 9) & 1) << 5); R = (st >> 1) * 16 + swz / 64; C = (st & 1) * 32 + (swz % 64) / 2; }
__host__ __device__ __forceinline__ int perm32(int rho) { const int n = rho >> 4, i = rho & 15; return 8 * (i >> 2) + 4 * n + (i & 3); }

struct Unit { int pm, pn, n; };
struct Gemm { const bf16_t* A; const bf16_t* Bt; int M, N, K; };
constexpr float F8_DESCALE = 1.f / 256.f;

struct StaticOrder {
    int nM, nN, nwg, G, c;
    __host__ __device__ void init(int M, int N, int G_, int c_) { nM = M / BM; nN = N / BM; nwg = nM * nN; G = G_; c = c_; }
    __host__ __device__ bool next(int i, Unit& u) const {
        const long L = (long)i * G + c; if (L >= nwg) return false;
        int wgid = (int)L; { const int q = nwg / NXCD, r = nwg % NXCD, xcd = wgid % NXCD, off = wgid / NXCD; wgid = (xcd < r ? xcd * (q + 1) : r * (q + 1) + (xcd - r) * q) + off; }
        const int nig = WGM * nN, gid = wgid / nig, fm = gid * WGM, gsz = (nM - fm) < WGM ? (nM - fm) : WGM;
        u.pm = fm + ((wgid % nig) % gsz); u.pn = (wgid % nig) / gsz; u.n = 0; return true;
    }
    __device__ __forceinline__ const char* abase(const Gemm& g, const Unit&) const { return (const char*)g.A; }
    __device__ __forceinline__ const char* bbase(const Gemm& g, const Unit&) const { return (const char*)g.Bt; }
    __device__ __forceinline__ void a_ready(const Unit&) const {}
    __device__ __forceinline__ void done(const Unit&) const {}
};

struct SkipOrder {
    StaticOrder so; int lo, skip;
    __host__ __device__ bool next(int i, Unit& u) const { if (!so.next(i, u)) return false; if (u.pn >= lo) u.pn += skip; return true; }
    __device__ __forceinline__ const char* abase(const Gemm& g, const Unit&) const { return (const char*)g.A; }
    __device__ __forceinline__ const char* bbase(const Gemm& g, const Unit&) const { return (const char*)g.Bt; }
    __device__ __forceinline__ void a_ready(const Unit&) const {}
    __device__ __forceinline__ void done(const Unit&) const {}
};

struct MergeOrder {
    StaticOrder so; const char* a0; const char* b0; long da1, da2, db1, db2;
    __host__ __device__ bool next(int i, Unit& u) const { const int t = i / 3; if (!so.next(t, u)) return false; u.n = i - 3 * t; return true; }
    __device__ __forceinline__ const char* abase(const Gemm&, const Unit& u) const { const long m1 = -(long)(u.n == 1), m2 = -(long)(u.n == 2); return a0 + ((da1 & m1) | (da2 & m2)); }
    __device__ __forceinline__ const char* bbase(const Gemm&, const Unit& u) const { const long m1 = -(long)(u.n == 1), m2 = -(long)(u.n == 2); return b0 + ((db1 & m1) | (db2 & m2)); }
    __device__ __forceinline__ void a_ready(const Unit&) const {}
    __device__ __forceinline__ void done(const Unit&) const {}
};

__device__ __forceinline__ unsigned cvt_pk_bf16(float lo, float hi) { unsigned r; asm volatile("v_cvt_pk_bf16_f32 %0, %1, %2" : "=v"(r) : "v"(lo), "v"(hi)); return r; }
typedef float f32x2 __attribute__((ext_vector_type(2)));
__device__ __forceinline__ f32x2 gelu_pk(f32x2 v) {
    const f32x2 av = __builtin_elementwise_abs(v), d = av * 0.2316418882f + 1.0f;
    f32x2 t; t.x = __builtin_amdgcn_rcpf(d.x); t.y = __builtin_amdgcn_rcpf(d.y);
    f32x2 q = t * 0.5307027145f + (-0.7265760135f); q = q * t + 0.7107068705f; q = q * t + (-0.142248368f); q = q * t + 0.127414796f; q = q * t;
    const f32x2 s = (v * v) * (-0.72134752044f);
    f32x2 e; e.x = __builtin_amdgcn_exp2f(s.x); e.y = __builtin_amdgcn_exp2f(s.y);
    const f32x2 m = v * (q * e), r = v - m;
    f32x2 o; o.x = v.x < 0.f ? m.x : r.x; o.y = v.y < 0.f ? m.y : r.y; return o;
}

template <int ACT  > struct EpiBf16 {
    static constexpr bool PERM = true, AFTER_DRAIN = false; static_assert(ACT == 0 || ACT == 1, "EpiBf16: ACT is 0 (none) or 1 (gelu_pk)");
    bf16_t* O; int ldc; const float* bias; int split_cols; size_t split_stride; float scale0;
    __device__ __forceinline__ void operator()(const f32x4 (&acc)[2][2][4][2], const Unit& u, int wr, int wc, int fr, int fq) const {
        const int row0 = u.pm * BM + wr * 64 + fr; int colt = u.pn * BM; bf16_t* base = O;
        float sc = 1.f; if (split_cols) { const int t = colt / split_cols; base += (size_t)t * split_stride; colt -= t * split_cols; if (t == 0) sc = scale0; }
        const int col0 = colt + wc * 32 + 8 * fq, bcol0 = u.pn * BM + wc * 32 + 8 * fq;
        f32x4 bv[2][2];
#pragma unroll
        for (int bj = 0; bj < 2; ++bj)
#pragma unroll
            for (int n = 0; n < 2; ++n) bv[bj][n] = bias ? *(const f32x4*)(bias + bcol0 + bj * HALF + 4 * n) : (f32x4){0.f, 0.f, 0.f, 0.f};
#pragma unroll
        for (int ai = 0; ai < 2; ++ai)
#pragma unroll
            for (int m = 0; m < 4; ++m) { bf16_t* rowp = base + (size_t)(row0 + ai * HALF + m * 16) * ldc + col0;
#pragma unroll
                for (int bj = 0; bj < 2; ++bj) { f32x4 v0 = acc[ai][bj][m][0] + bv[bj][0], v1 = acc[ai][bj][m][1] + bv[bj][1];
                    if (ACT == 1) { f32x2 a = gelu_pk((f32x2){v0[0], v0[1]}), b = gelu_pk((f32x2){v0[2], v0[3]}), c = gelu_pk((f32x2){v1[0], v1[1]}), d = gelu_pk((f32x2){v1[2], v1[3]});
                        v0 = (f32x4){a.x, a.y, b.x, b.y}; v1 = (f32x4){c.x, c.y, d.x, d.y}; }
                    v0 = v0 * sc; v1 = v1 * sc; u32x4 w; w.x = cvt_pk_bf16(v0[0], v0[1]); w.y = cvt_pk_bf16(v0[2], v0[3]); w.z = cvt_pk_bf16(v1[0], v1[1]); w.w = cvt_pk_bf16(v1[2], v1[3]);
                    *(u32x4*)(rowp + bj * HALF) = w; } }
    }
};
typedef int pg8_v8i __attribute__((ext_vector_type(8))); typedef int pg8_v4i __attribute__((ext_vector_type(4)));
__device__ __forceinline__ pg8_v8i pg8_cat(bf16x8 lo, bf16x8 hi) { const pg8_v4i a = __builtin_bit_cast(pg8_v4i, lo), b = __builtin_bit_cast(pg8_v4i, hi); return __builtin_shufflevector(a, b, 0, 1, 2, 3, 4, 5, 6, 7); }
template <class Epi, class Sched, bool ALIGN_EPI = false, bool SP2 = false, bool F8 = false>
__device__ __forceinline__ void gemm_phase(PG8_LAS unsigned char* lds, const Gemm g, const Sched& S, const Epi& E) {
    int tid_ = threadIdx.x; asm volatile("" : "+v"(tid_));
    const int tid = tid_, wid = __builtin_amdgcn_readfirstlane(tid >> 6), lane = tid & 63, wr = wid >> 2, wc = wid & 3, fr = lane & 15, fq = lane >> 4;
    const int K = g.K, nt = K / BK;
    unsigned voffA, voffB;
    { int R, C; stage_rc(tid * 16, R, C); const int Rb = Epi::PERM ? ((R & ~31) + perm32(R & 31)) : R;
        voffA = (unsigned)(R * K + C) * 2u; voffB = (unsigned)(Rb * K + C) * 2u; }
    const size_t rstep = (size_t)64 * K * 2;
    const size_t kstep = (size_t)(BK * 2);
    const size_t hstep = (size_t)HALF * K * 2;
    const size_t tstep = 2 * hstep;
    const unsigned ldsw = (unsigned)wid * 1024u;
    const int aoff = lds_byte(wr * 64 + fr, F8 ? fq * 16 : fq * 8), boff = lds_byte(wc * 32 + fr, F8 ? fq * 16 : fq * 8);
    constexpr int KOFF = F8 ? 16 : 1024;
#define PG8_SA(b, h) (((b) * 2 + (h)) * HTB)
#define PG8_SB(b, h) ((4 + (b) * 2 + (h)) * HTB)
#define PG8_STAGE(bufoff, gbase, voff) do { _Pragma("unroll") for (int _i = 0; _i < 2; ++_i) \
        __builtin_amdgcn_global_load_lds((const unsigned*)((const char*)(gbase) + _i * rstep + (voff)), (PG8_LAS unsigned*)(lds + (bufoff) + ldsw + _i * 8192), 16, 0, 0); } while (0)
#define PG8_LDA(dst, b, h) do { _Pragma("unroll") for (int m = 0; m < 4; ++m) _Pragma("unroll") for (int k = 0; k < 2; ++k) dst[m][k] = *(const PG8_LAS bf16x8*)(lds + PG8_SA(b, h) + aoff + m * 2048 + k * KOFF); } while (0)
#define PG8_LDB(dst, b, h) do { _Pragma("unroll") for (int n = 0; n < 2; ++n) _Pragma("unroll") for (int k = 0; k < 2; ++k) dst[n][k] = *(const PG8_LAS bf16x8*)(lds + PG8_SB(b, h) + boff + n * 2048 + k * KOFF); } while (0)
#define PG8_MMA(ai, bj, At, Bt) do { __builtin_amdgcn_s_setprio(1); \
        if constexpr (F8) { _Pragma("unroll") for (int m = 0; m < 4; ++m) _Pragma("unroll") for (int n = 0; n < 2; ++n) \
            acc[ai][bj][m][n] = __builtin_amdgcn_mfma_scale_f32_16x16x128_f8f6f4(pg8_cat(Bt[n][0], Bt[n][1]), pg8_cat(At[m][0], At[m][1]), acc[ai][bj][m][n], 0, 0, 0, 0x7f7f7f7f, 0, 0x7f7f7f7f); \
            _Pragma("unroll") for (int m = 0; m < 4; ++m) _Pragma("unroll") for (int n = 0; n < 2; ++n) asm volatile("" : "+v"(acc[ai][bj][m][n]));   } \
        else { _Pragma("unroll") for (int m = 0; m < 4; ++m) _Pragma("unroll") for (int n = 0; n < 2; ++n) _Pragma("unroll") for (int k = 0; k < 2; ++k) \
            acc[ai][bj][m][n] = __builtin_amdgcn_mfma_f32_16x16x32_bf16(Bt[n][k], At[m][k], acc[ai][bj][m][n], 0, 0, 0); } \
        __builtin_amdgcn_s_setprio(0); } while (0)
#define PG8_WAIT_V(n) asm volatile("s_waitcnt vmcnt(" #n ")" ::: "memory")
#define PG8_WAIT_L(n) asm volatile("s_waitcnt lgkmcnt(" #n ")" ::: "memory")
#define PG8_BAR __builtin_amdgcn_s_barrier()
#define PG8_SCHED __builtin_amdgcn_sched_barrier(0)
    Unit cur, nxt; int ui = 0;
    if (!S.next(0, cur)) return;
    f32x4 acc[2][2][4][2];
#pragma unroll
    for (int a = 0; a < 2; ++a)
#pragma unroll
        for (int b = 0; b < 2; ++b)
#pragma unroll
            for (int m = 0; m < 4; ++m)
#pragma unroll
                for (int n = 0; n < 2; ++n) acc[a][b][m][n] = (f32x4){0.f, 0.f, 0.f, 0.f};
    bf16x8 At[4][2], B0[2][2], B1[2][2];
    const char* cA = S.abase(g, cur) + (size_t)cur.pm * tstep; const char* cB = S.bbase(g, cur) + (size_t)cur.pn * tstep;
    S.a_ready(cur);
    if constexpr (SP2) {
        PG8_STAGE(PG8_SB(0, 0), cB, voffB); PG8_STAGE(PG8_SB(0, 1), cB + hstep, voffB); PG8_STAGE(PG8_SA(0, 0), cA, voffA); PG8_STAGE(PG8_SA(0, 1), cA + hstep, voffA);
        if (wr == 1) PG8_BAR;
        PG8_WAIT_V(2); PG8_BAR;
        PG8_STAGE(PG8_SB(1, 0), cB + kstep, voffB); PG8_STAGE(PG8_SA(1, 0), cA + kstep, voffA); PG8_STAGE(PG8_SB(1, 1), cB + hstep + kstep, voffB);
        PG8_WAIT_V(6); PG8_BAR;
    } else {
        PG8_STAGE(PG8_SB(0, 0), cB, voffB); PG8_STAGE(PG8_SA(0, 0), cA, voffA); PG8_STAGE(PG8_SB(0, 1), cB + hstep, voffB); PG8_STAGE(PG8_SA(0, 1), cA + hstep, voffA);
        if (wr == 1) PG8_BAR;
        PG8_WAIT_V(4); PG8_BAR;
        PG8_STAGE(PG8_SB(1, 0), cB + kstep, voffB); PG8_STAGE(PG8_SA(1, 0), cA + kstep, voffA); PG8_STAGE(PG8_SB(1, 1), cB + hstep + kstep, voffB);
        PG8_WAIT_V(6); PG8_BAR;
    }
    for (;;) {
        const bool has_next = S.next(ui + 1, nxt);
        const char* nA = has_next ? S.abase(g, nxt) + (size_t)nxt.pm * tstep : cA; const char* nB = has_next ? S.bbase(g, nxt) + (size_t)nxt.pn * tstep : cB;
#pragma unroll 1
        for (int t = 0; t < nt; t += 2) {
            const bool last = (t == nt - 2);
            const char* a1 = cA + (size_t)(t + 1) * kstep;
            const char* a2 = last ? nA : cA + (size_t)(t + 2) * kstep; const char* b2 = last ? nB : cB + (size_t)(t + 2) * kstep;
            const char* a3 = a2 + kstep; const char* b3 = b2 + kstep;
            if (last && has_next) S.a_ready(nxt);
            if constexpr (SP2) {
            PG8_LDB(B0, 0, 0); PG8_LDB(B1, 0, 1); PG8_SCHED; PG8_LDA(At, 0, 0); PG8_STAGE(PG8_SA(1, 1), a1 + hstep, voffA);
            PG8_WAIT_V(8); PG8_WAIT_L(0); PG8_BAR; PG8_MMA(0, 0, At, B0); PG8_MMA(0, 1, At, B1); PG8_BAR; PG8_SCHED;
            PG8_LDA(At, 0, 1); PG8_STAGE(PG8_SB(0, 0), b2, voffB); PG8_STAGE(PG8_SB(0, 1), b2 + hstep, voffB); PG8_STAGE(PG8_SA(0, 0), a2, voffA);
            PG8_WAIT_V(8); PG8_WAIT_L(0); PG8_BAR; PG8_MMA(1, 0, At, B0); PG8_MMA(1, 1, At, B1); PG8_BAR; PG8_SCHED;
            PG8_LDB(B0, 1, 0); PG8_LDB(B1, 1, 1); PG8_SCHED; PG8_LDA(At, 1, 0); PG8_STAGE(PG8_SA(0, 1), a2 + hstep, voffA);
            PG8_WAIT_V(8); PG8_WAIT_L(0); PG8_BAR; PG8_MMA(0, 0, At, B0); PG8_MMA(0, 1, At, B1); PG8_BAR; PG8_SCHED;
            PG8_LDA(At, 1, 1); PG8_STAGE(PG8_SB(1, 0), b3, voffB); PG8_STAGE(PG8_SB(1, 1), b3 + hstep, voffB); PG8_STAGE(PG8_SA(1, 0), a3, voffA);
            PG8_WAIT_V(8); PG8_WAIT_L(0); PG8_BAR; PG8_MMA(1, 0, At, B0); PG8_MMA(1, 1, At, B1); PG8_BAR; PG8_SCHED;
            } else {
            PG8_LDB(B0, 0, 0); PG8_SCHED; PG8_LDA(At, 0, 0); PG8_STAGE(PG8_SA(1, 1), a1 + hstep, voffA);
            PG8_WAIT_L(8); PG8_BAR; PG8_WAIT_L(0); PG8_MMA(0, 0, At, B0); PG8_BAR; PG8_SCHED;
            PG8_LDB(B1, 0, 1); PG8_STAGE(PG8_SB(0, 0), b2, voffB);
            PG8_BAR; PG8_WAIT_L(0); PG8_MMA(0, 1, At, B1); PG8_BAR;
            PG8_LDA(At, 0, 1); PG8_STAGE(PG8_SA(0, 0), a2, voffA);
            PG8_BAR; PG8_WAIT_L(0); PG8_MMA(1, 0, At, B0); PG8_BAR; PG8_SCHED;
            PG8_STAGE(PG8_SB(0, 1), b2 + hstep, voffB);
            PG8_WAIT_V(6); PG8_BAR; PG8_MMA(1, 1, At, B1); PG8_BAR;
            PG8_LDB(B0, 1, 0); PG8_SCHED; PG8_LDA(At, 1, 0); PG8_STAGE(PG8_SA(0, 1), a2 + hstep, voffA);
            PG8_WAIT_L(8); PG8_BAR; PG8_WAIT_L(0); PG8_MMA(0, 0, At, B0); PG8_BAR; PG8_SCHED;
            PG8_LDB(B1, 1, 1); PG8_STAGE(PG8_SB(1, 0), b3, voffB);
            PG8_BAR; PG8_WAIT_L(0); PG8_MMA(0, 1, At, B1); PG8_BAR;
            PG8_LDA(At, 1, 1); PG8_STAGE(PG8_SA(1, 0), a3, voffA);
            PG8_BAR; PG8_WAIT_L(0); PG8_MMA(1, 0, At, B0); PG8_BAR; PG8_SCHED;
            PG8_STAGE(PG8_SB(1, 1), b3 + hstep, voffB);
            PG8_WAIT_V(6); PG8_BAR; PG8_MMA(1, 1, At, B1); PG8_BAR;
            }
        }
        if constexpr (ALIGN_EPI) { if (wr == 0) PG8_BAR; }
        if constexpr (F8) {
#pragma unroll
            for (int a = 0; a < 2; ++a)
#pragma unroll
                for (int b = 0; b < 2; ++b)
#pragma unroll
                    for (int m = 0; m < 4; ++m)
#pragma unroll
                        for (int n = 0; n < 2; ++n) acc[a][b][m][n] = acc[a][b][m][n] * F8_DESCALE;
        }
        if constexpr (!Epi::AFTER_DRAIN) { int tl = threadIdx.x; asm volatile("" : "+v"(tl));
            E(acc, cur, wr, wc, tl & 15, (tl >> 4) & 3); S.done(cur); }
        if (!has_next) break;
#pragma unroll
        for (int a = 0; a < 2; ++a)
#pragma unroll
            for (int b = 0; b < 2; ++b)
#pragma unroll
                for (int m = 0; m < 4; ++m)
#pragma unroll
                    for (int n = 0; n < 2; ++n) acc[a][b][m][n] = (f32x4){0.f, 0.f, 0.f, 0.f};
        cur = nxt; cA = nA; cB = nB; ++ui;
        if constexpr (ALIGN_EPI) { if (wr == 1) PG8_BAR; }
    }
    PG8_WAIT_V(0);
    if constexpr (!ALIGN_EPI) { if (wr == 0) PG8_BAR; }
    PG8_BAR;
    if constexpr (Epi::AFTER_DRAIN) { E.fused(acc, cur, wr, wc, fr, fq, lds, wid, lane); S.done(cur); }
#undef PG8_SA
#undef PG8_SB
#undef PG8_STAGE
#undef PG8_LDA
#undef PG8_LDB
#undef PG8_MMA
#undef PG8_WAIT_V
#undef PG8_WAIT_L
#undef PG8_BAR
#undef PG8_SCHED
}
}
namespace hy {
#define LAS __attribute__((address_space(3)))
typedef unsigned short bf16_t;
typedef short bf16x8 __attribute__((ext_vector_type(8)));
typedef float f32x4 __attribute__((ext_vector_type(4)));
typedef float f32x16 __attribute__((ext_vector_type(16)));
typedef unsigned u32x4 __attribute__((ext_vector_type(4)));
typedef unsigned u32x2 __attribute__((ext_vector_type(2)));

constexpr int BATCH = 8, SEQ = 4096, DM = 1024, T = BATCH * SEQ, MEMLEN = 256, TM = BATCH * MEMLEN;
constexpr int NSRC = 8776, N1 = 5888, NALL = 8960;
constexpr float EPS = 1e-6f, LOG2E = 1.4426950408889634f;
constexpr float C2A = 0.125f * LOG2E;
constexpr float C2C = 0.08838834764831845f * LOG2E;
constexpr int NWAVES = 8, NTHR = 512;

constexpr size_t MiB = 1u << 20;
constexpr size_t WS_WIN = 1 * MiB, WS_WM = 19 * MiB, WS_WB = 21 * MiB, WS_WO = 24 * MiB, WS_HM = 26 * MiB, WS_MKV = 30 * MiB, WS_H = 34 * MiB;
constexpr size_t WS_QA = 98 * MiB, WS_GB = 130 * MiB, WS_QC = 162 * MiB;
constexpr size_t WS_KA = 194 * MiB, WS_VA = 226 * MiB, WS_ZA = 258 * MiB, WS_QI = 290 * MiB, WS_KW = 322 * MiB, WS_QB = 330 * MiB, WS_FB = 362 * MiB, WS_IB = 394 * MiB, WS_ZC = 426 * MiB;
constexpr size_t WS_MASK = 458 * MiB, WS_DEC = 474 * MiB, WS_H8 = 476 * MiB, WS_END = 508 * MiB;
constexpr size_t WS_W8 = WS_WIN, WS_WG8 = WS_W8 + (size_t)N1 * DM;
constexpr size_t WS_WIX = WS_WIN + 6 * MiB;
constexpr int IX_LO = 2048, IX_HI = 2816;
constexpr float H8_SCALE = 4.f, WG8_SCALE = 64.f;
constexpr float O8_SCALE = 32.f, WB8_SCALE = 8.f;
constexpr float M8_SCALE = 16.f, WO8_SCALE = 16.f;
constexpr size_t WS_MKVT = WS_MKV + 2 * MiB;
constexpr size_t WS_O8B = WS_QI, WS_O8C = WS_QI + 16 * MiB, WS_M8 = WS_ZC;
constexpr size_t WS_G = 194 * MiB, WS_MB = 330 * MiB;
constexpr size_t WS_OB = WS_QI;
constexpr size_t OUT_LCT = 0, OUT_SINT = 64 * MiB;
constexpr size_t WS_LBT = 49152;
constexpr size_t WS_LMINV = 40960;

constexpr int LDS_BYTES = 147456;

__device__ __forceinline__ float bf2f(unsigned u16) { return __uint_as_float(u16 << 16); }
__device__ __forceinline__ unsigned pk2(float lo, float hi) { typedef float f2 __attribute__((ext_vector_type(2))); typedef __bf16 b2 __attribute__((ext_vector_type(2))); f2 v = {lo, hi}; b2 b = __builtin_convertvector(v, b2); return __builtin_bit_cast(unsigned, b); }
__device__ __forceinline__ unsigned pk4_fp8(float a, float b, float c, float d) {
    a = __builtin_amdgcn_fmed3f(a, -448.f, 448.f); b = __builtin_amdgcn_fmed3f(b, -448.f, 448.f); c = __builtin_amdgcn_fmed3f(c, -448.f, 448.f); d = __builtin_amdgcn_fmed3f(d, -448.f, 448.f);
    int w = __builtin_amdgcn_cvt_pk_fp8_f32(a, b, 0, false); w = __builtin_amdgcn_cvt_pk_fp8_f32(c, d, w, true); return (unsigned)w; }
__device__ __forceinline__ bf16_t f2bf(float f) { return (bf16_t)(pk2(f, 0.f) & 0xffffu); }
__device__ __forceinline__ float ex2(float x) { return __builtin_amdgcn_exp2f(x); }
__device__ __forceinline__ float rcpf_(float x) { return __builtin_amdgcn_rcpf(x); }
__device__ __forceinline__ float sigm(float x) { return rcpf_(1.f + ex2(-LOG2E * x)); }
__device__ __forceinline__ float silu(float x) { return x * sigm(x); }
__device__ __forceinline__ int crow(int r, int hi) { return (r & 3) + 8 * (r >> 2) + 4 * hi; }
__device__ __forceinline__ f32x16 mfma32(bf16x8 a, bf16x8 b, f32x16 c) { return __builtin_amdgcn_mfma_f32_32x32x16_bf16(a, b, c, 0, 0, 0); }
__device__ __forceinline__ f32x4 mfma16(bf16x8 a, bf16x8 b, f32x4 c) { return __builtin_amdgcn_mfma_f32_16x16x32_bf16(a, b, c, 0, 0, 0); }
__device__ __forceinline__ float wave_sum(float v) {
#pragma unroll
    for (int o = 1; o < 64; o <<= 1) v += __shfl_xor(v, o);
    return v;
}
__device__ __forceinline__ int wave_sum_i(int v) {
#pragma unroll
    for (int o = 1; o < 64; o <<= 1) v += __shfl_xor(v, o);
    return v;
}
__device__ __forceinline__ unsigned wave_sum_dpp(unsigned v) {
    v += (unsigned)__builtin_amdgcn_update_dpp(0, (int)v, 0x111, 0xf, 0xf, true);
    v += (unsigned)__builtin_amdgcn_update_dpp(0, (int)v, 0x112, 0xf, 0xf, true);
    v += (unsigned)__builtin_amdgcn_update_dpp(0, (int)v, 0x114, 0xf, 0xf, true);
    v += (unsigned)__builtin_amdgcn_update_dpp(0, (int)v, 0x118, 0xf, 0xf, true);
    v += (unsigned)__builtin_amdgcn_update_dpp(0, (int)v, 0x142, 0xa, 0xf, false);
    v += (unsigned)__builtin_amdgcn_update_dpp(0, (int)v, 0x143, 0xc, 0xf, false);
    return (unsigned)__builtin_amdgcn_readlane((int)v, 63);
}
__device__ __forceinline__ unsigned umax_(unsigned a, unsigned b) { return a > b ? a : b; }
__device__ __forceinline__ unsigned wave_max_dpp(unsigned v) {
    v = umax_(v, (unsigned)__builtin_amdgcn_update_dpp(0, (int)v, 0x111, 0xf, 0xf, true));
    v = umax_(v, (unsigned)__builtin_amdgcn_update_dpp(0, (int)v, 0x112, 0xf, 0xf, true));
    v = umax_(v, (unsigned)__builtin_amdgcn_update_dpp(0, (int)v, 0x114, 0xf, 0xf, true));
    v = umax_(v, (unsigned)__builtin_amdgcn_update_dpp(0, (int)v, 0x118, 0xf, 0xf, true));
    v = umax_(v, (unsigned)__builtin_amdgcn_update_dpp(0, (int)v, 0x142, 0xa, 0xf, false));
    v = umax_(v, (unsigned)__builtin_amdgcn_update_dpp(0, (int)v, 0x143, 0xc, 0xf, false));
    return (unsigned)__builtin_amdgcn_readlane((int)v, 63);
}
__device__ __forceinline__ void unpack8(u32x4 v, float (&f)[8]) {
#pragma unroll
    for (int i = 0; i < 4; ++i) { f[2 * i] = bf2f(v[i] & 0xffffu); f[2 * i + 1] = bf2f(v[i] >> 16); }
}

struct Ctx {
    float* out; unsigned char* ws;
    LAS unsigned char* lds; int tid, lane, wave, G, bid;
};
#define WSP(off) ((bf16_t*)(C.ws + (off)))

__device__ __forceinline__ int win_src_col(int r) {
    if (r < 1024) {
        const int g = r & 511, pt = g >> 8, bj = (g >> 7) & 1, wc = (g >> 5) & 3, j = g & 31;
        return (r & 512) + (4 * pt + wc) * 64 + 32 * bj + j; }
    if (r < 2632) return r;
    if (r < 2688) return -1;
    if (r < 5248) return r - 56;
    if (r < 5760) { const int j = (r - 5248) & 127;
        return (r - j) - 56 + (j & 3) * 32 + (j >> 2); }
    if (r < 5888) return -1;
    return r - 184;
}
__device__ __forceinline__ void p0_transpose_item(const float* W, int K, int N, bf16_t* WT, unsigned char* W8, float w8s, bool winmap, LAS float* scr, int item, int nblk, int lane, bool kperm = false) {
    const int kb = item / nblk, nb = item % nblk, k0 = 64 * kb, n0 = 32 * nb;
    const int dcol = n0 + (lane & 31); const int sc = winmap ? win_src_col(dcol) : dcol;
    float tv[32];
#pragma unroll
    for (int i = 0; i < 32; ++i) { const int kq = k0 + 2 * i + (lane >> 5); const int ks_ = kperm ? ((kq & ~127) | ((kq & 3) * 32 + ((kq & 127) >> 2))) : kq;
        tv[i] = W[(size_t)ks_ * N + (sc >= 0 ? sc : 0)]; }
#pragma unroll
    for (int i = 0; i < 32; ++i) { const int kk = 2 * i + (lane >> 5); scr[kk * 33 + (lane & 31)] = sc >= 0 ? tv[i] : 0.f; }
    asm volatile("s_waitcnt lgkmcnt(0)" ::: "memory");
    const int c = lane & 7;
#pragma unroll
    for (int j = 0; j < 4; ++j) { const int n = (lane >> 3) + 8 * j; const LAS float* s = scr + (8 * c) * 33 + n;
        if (W8 && !(winmap && n0 >= IX_LO && n0 < IX_HI)) {
            u32x2 o8; o8.x = pk4_fp8(s[0 * 33] * w8s, s[1 * 33] * w8s, s[2 * 33] * w8s, s[3 * 33] * w8s); o8.y = pk4_fp8(s[4 * 33] * w8s, s[5 * 33] * w8s, s[6 * 33] * w8s, s[7 * 33] * w8s);
            *(u32x2*)(W8 + (size_t)(n0 + n) * K + k0 + 8 * c) = o8; continue; }
        u32x4 o; o.x = pk2(s[0 * 33], s[1 * 33]); o.y = pk2(s[2 * 33], s[3 * 33]); o.z = pk2(s[4 * 33], s[5 * 33]); o.w = pk2(s[6 * 33], s[7 * 33]);
        *(u32x4*)(WT + (size_t)(n0 + n) * K + k0 + 8 * c) = o; }
    asm volatile("s_waitcnt lgkmcnt(0)" ::: "memory");
}
__device__ __forceinline__ void rms_row_to_bf16(const float* xrow, const float* gain, bf16_t* orow, int lane) {
    const f32x4* xr = (const f32x4*)xrow + lane; const f32x4* gr = (const f32x4*)gain + lane;
    f32x4 v[4]; float s = 0.f;
#pragma unroll
    for (int j = 0; j < 4; ++j) { v[j] = xr[64 * j]; s += (v[j].x * v[j].x + v[j].y * v[j].y) + (v[j].z * v[j].z + v[j].w * v[j].w); }
    const float rstd = 1.f / sqrtf(wave_sum(s) * (1.f / DM) + EPS);
    u32x2* o8 = (u32x2*)orow + lane;
#pragma unroll
    for (int j = 0; j < 4; ++j) { const f32x4 g = gr[64 * j]; u32x2 w; w.x = pk2(v[j].x * rstd * g.x, v[j].y * rstd * g.y); w.y = pk2(v[j].z * rstd * g.z, v[j].w * rstd * g.w); o8[64 * j] = w; }
}
__device__ __forceinline__ void p0_prologue(Ctx& C, const float* x, const float* mem, const float* norm_in, const float* norm_mem, const float* w_in, const float* w_mkv, const float* w_br, const float* w_out, const float* lbin) {
    LAS float* scr = (LAS float*)(C.lds + C.wave * 16384);
    const int gw = C.bid * NWAVES + C.wave, NGW = C.G * NWAVES;
    constexpr int I_IN = 16 * (NALL / 32), I_M = 16 * 32, I_B = 8 * 32, I_O = 16 * 32;
    constexpr int NITEMS = I_IN + I_M + 3 * I_B + I_O;
    for (int it = gw; it < NITEMS; it += NGW) {
        int r = it;
        if (r < I_IN) { p0_transpose_item(w_in, DM, NSRC, WSP(WS_WIX), C.ws + WS_W8, WG8_SCALE, true, scr, r, NALL / 32, C.lane); continue; } r -= I_IN;
        if (r < I_M) { p0_transpose_item(w_mkv, DM, DM, WSP(WS_WM), nullptr, 0.f, false, scr, r, 32, C.lane); continue; } r -= I_M;
        if (r < 3 * I_B) { const int n = r / I_B; p0_transpose_item(w_br + (size_t)n * 512 * DM, 512, DM, nullptr, C.ws + WS_WB + (size_t)n * DM * 512, WB8_SCALE, false, scr, r % I_B, 32, C.lane, n == 2); continue; } r -= 3 * I_B;
        p0_transpose_item(w_out, DM, DM, nullptr, C.ws + WS_WO, WO8_SCALE, false, scr, r, 32, C.lane);
    }
    for (int m = gw; m < T; m += 2 * NGW) {
        f32x4 v[2][4]; float sq[2];
#pragma unroll
        for (int r = 0; r < 2; ++r) { const int mr = (m + r * NGW < T) ? m + r * NGW : m;
            const f32x4* xr = (const f32x4*)(x + (size_t)mr * DM) + C.lane;
#pragma unroll
            for (int j = 0; j < 4; ++j) v[r][j] = xr[64 * j]; }
#pragma unroll
        for (int r = 0; r < 2; ++r) { float s_ = 0.f;
#pragma unroll
            for (int j = 0; j < 4; ++j) s_ += (v[r][j].x * v[r][j].x + v[r][j].y * v[r][j].y) + (v[r][j].z * v[r][j].z + v[r][j].w * v[r][j].w);
            sq[r] = s_; }
#pragma unroll
        for (int o = 1; o < 64; o <<= 1) { sq[0] += __shfl_xor(sq[0], o); sq[1] += __shfl_xor(sq[1], o); }
#pragma unroll
        for (int r = 0; r < 2; ++r) { const int mr = (m + r * NGW < T) ? m + r * NGW : m; const float rstd = 1.f / sqrtf(sq[r] * (1.f / DM) + EPS); u32x2* o8 = (u32x2*)(WSP(WS_H) + (size_t)mr * DM) + C.lane;
#pragma unroll
            for (int j = 0; j < 4; ++j) { const f32x4 g = ((const f32x4*)norm_in)[C.lane + 64 * j]; const float h0 = v[r][j].x * rstd * g.x, h1 = v[r][j].y * rstd * g.y, h2 = v[r][j].z * rstd * g.z, h3 = v[r][j].w * rstd * g.w;
                u32x2 w; w.x = pk2(h0, h1); w.y = pk2(h2, h3); o8[64 * j] = w;
                ((unsigned*)(C.ws + WS_H8 + (size_t)mr * DM))[C.lane + 64 * j] = pk4_fp8(h0 * H8_SCALE, h1 * H8_SCALE, h2 * H8_SCALE, h3 * H8_SCALE); } }
    }
    if (C.bid == 0) { const float a0 = lbin[C.tid], a1 = lbin[512 + C.tid]; ((float*)(C.ws + WS_LBT))[C.tid] = 1.f / (1.f + expf(a1 - a0)); }
    for (int m = gw; m < TM; m += NGW) rms_row_to_bf16(mem + (size_t)m * DM, norm_mem, WSP(WS_HM) + (size_t)m * DM, C.lane);
}

using pg8::Unit;
struct EpiP1 {
    static constexpr bool PERM = true, AFTER_DRAIN = false;
    unsigned char* ws; const float* gq; const float* gk; bool nostore = false;
    __device__ __forceinline__ void operator()(const f32x4 (&acc)[2][2][4][2], const Unit& u, int wr, int wc, int fr, int fq) const {
        if (nostore) return;
        const int row0 = u.pm * 256 + wr * 64 + fr;
        if (u.pn < 4) {
            const bool isq = u.pn < 2; const float* gain = isq ? gq : gk; const float scale = isq ? C2A : 1.f;
            const int head = 4 * (u.pn & 1) + wc;
            bf16_t* qbase = (bf16_t*)(ws + WS_QA) + ((size_t)(u.pm * 8 + wr * 2) * 8 + head) * 2048 + (fq >> 1) * 512 + ((fq & 1) * 32 + fr) * 8;
            bf16_t* base = (bf16_t*)(ws + WS_KA) + head * 64 + 8 * fq;
            f32x4 g[2][2];
#pragma unroll
            for (int bj = 0; bj < 2; ++bj)
#pragma unroll
                for (int n = 0; n < 2; ++n) g[bj][n] = *(const f32x4*)(gain + 32 * bj + 8 * fq + 4 * n);
#pragma unroll
            for (int ai = 0; ai < 2; ++ai)
#pragma unroll
                for (int m = 0; m < 4; ++m) {
                    float ss = 0.f;
#pragma unroll
                    for (int bj = 0; bj < 2; ++bj)
#pragma unroll
                        for (int n = 0; n < 2; ++n) { const f32x4 v = acc[ai][bj][m][n]; ss += (v[0] * v[0] + v[1] * v[1]) + (v[2] * v[2] + v[3] * v[3]); }
                    ss += __shfl_xor(ss, 16); ss += __shfl_xor(ss, 32);
                    const float rs = scale / sqrtf(ss * (1.f / 64.f) + EPS);
#pragma unroll
                    for (int bj = 0; bj < 2; ++bj) { const f32x4 v0 = acc[ai][bj][m][0] * g[bj][0] * rs, v1 = acc[ai][bj][m][1] * g[bj][1] * rs;
                        u32x4 w; w.x = pk2(v0[0], v0[1]); w.y = pk2(v0[2], v0[3]); w.z = pk2(v1[0], v1[1]); w.w = pk2(v1[2], v1[3]);
                        if (isq) *(u32x4*)(qbase + ((ai * 4 + (m >> 1)) * 8) * 2048 + bj * 1024 + (m & 1) * 128) = w;
                        else *(u32x4*)(base + (size_t)(row0 + ai * 128 + m * 16) * 512 + 32 * bj) = w; }
                }
            return;
        }
#pragma unroll
        for (int bj = 0; bj < 2; ++bj) {
            const int unit = u.pn * 2 + bj;
            if (unit >= 45) continue;
            int buf, cu, ld = 512;
            if (unit >= 16 && unit < 20) {
                const int h = 2 * (unit & 3) + (wc >> 1), ks = wc & 1;
#pragma unroll
                for (int ai = 0; ai < 2; ++ai)
#pragma unroll
                    for (int m = 0; m < 4; ++m) { const int row = row0 + ai * 128 + m * 16; const f32x4 v0 = acc[ai][bj][m][0], v1 = acc[ai][bj][m][1];
                        u32x4 w; w.x = pk2(v0[0], v0[1]); w.y = pk2(v0[2], v0[3]); w.z = pk2(v1[0], v1[1]); w.w = pk2(v1[2], v1[3]);
                        *(u32x4*)((bf16_t*)(ws + WS_QI) + (size_t)(row >> 4) * 8192 + h * 1024 + ks * 512 + (fq * 16 + (row & 15)) * 8) = w; }
                continue; }
            if (unit < 20) { buf = unit >> 2; cu = (unit & 3) * 128; }
            else if (unit == 20) {
                if (wc < 2 || (wc == 2 && fq == 0)) {
#pragma unroll
                    for (int ai = 0; ai < 2; ++ai)
#pragma unroll
                        for (int m = 0; m < 4; ++m) { const int row = row0 + ai * 128 + m * 16; const f32x4 v0 = acc[ai][bj][m][0], v1 = acc[ai][bj][m][1];
                            u32x4 w; w.x = pk2(v0[0], v0[1]); w.y = pk2(v0[2], v0[3]); w.z = pk2(v1[0], v1[1]); w.w = pk2(v1[2], v1[3]);
                            bf16_t* dst = (wc < 2) ? (bf16_t*)(ws + WS_KW) + (size_t)(row >> 4) * 1024 + wc * 512 + (fq * 16 + (row & 15)) * 8 : (bf16_t*)(ws + WS_KW + 4 * MiB) + (size_t)row * 8;
                            *(u32x4*)dst = w; } }
                continue; }
            else { const int i = unit - 21; buf = 6 + (i >> 2); cu = (i & 3) * 128; }
            size_t off;
            switch (buf) { case 0: off = WS_QA; break; case 1: off = WS_KA; break; case 2: off = WS_VA; break; case 3: off = WS_ZA; break; case 4: off = WS_QI; break; case 5: off = WS_KW; break;
                           case 6: off = WS_QB; break; case 7: off = WS_FB; break; case 8: off = WS_IB; break; case 9: off = WS_GB; break; case 10: off = WS_QC; break; default: off = WS_ZC; break; }
            const bool act = (buf == 3) || (buf == 6) || (buf == 9) || (buf == 11);
            bf16_t* base = (bf16_t*)(ws + off) + cu + wc * 32 + 8 * fq;
#pragma unroll
            for (int ai = 0; ai < 2; ++ai)
#pragma unroll
                for (int m = 0; m < 4; ++m) {
                    f32x4 v0 = acc[ai][bj][m][0], v1 = acc[ai][bj][m][1];
                    if (act) {
#pragma unroll
                        for (int e = 0; e < 4; ++e) { v0[e] = silu(v0[e]); v1[e] = silu(v1[e]); }
                    }
                    u32x4 w; w.x = pk2(v0[0], v0[1]); w.y = pk2(v0[2], v0[3]); w.z = pk2(v1[0], v1[1]); w.w = pk2(v1[2], v1[3]);
                    *(u32x4*)(base + (size_t)(row0 + ai * 128 + m * 16) * ld) = w;
                }
        }
    }
};
template <int ACT  > struct EpiPlain {
    static constexpr bool PERM = true, AFTER_DRAIN = false;
    bf16_t* O; int ld;
    __device__ __forceinline__ void operator()(const f32x4 (&acc)[2][2][4][2], const Unit& u, int wr, int wc, int fr, int fq) const {
        const int row0 = u.pm * 256 + wr * 64 + fr, col0 = u.pn * 256 + wc * 32 + 8 * fq;
#pragma unroll
        for (int bj = 0; bj < 2; ++bj)
#pragma unroll
            for (int ai = 0; ai < 2; ++ai)
#pragma unroll
                for (int m = 0; m < 4; ++m) {
                    f32x4 v0 = acc[ai][bj][m][0], v1 = acc[ai][bj][m][1];
                    if (ACT == 1) {
#pragma unroll
                        for (int e = 0; e < 4; ++e) { v0[e] = sigm(v0[e]); v1[e] = sigm(v1[e]); }
                    }

                    u32x4 w; w.x = pk2(v0[0], v0[1]); w.y = pk2(v0[2], v0[3]); w.z = pk2(v1[0], v1[1]); w.w = pk2(v1[2], v1[3]);
                    *(u32x4*)(O + (size_t)(row0 + ai * 128 + m * 16) * ld + col0 + bj * 128) = w;
                }
    }
};
template <bool LAST> struct EpiMerge {
    static constexpr bool PERM = true, AFTER_DRAIN = false;
    const bf16_t* Gt; bf16_t* MB; int first; unsigned char* M8;
    __device__ __forceinline__ void operator()(const f32x4 (&acc)[2][2][4][2], const Unit& u, int wr, int wc, int fr, int fq) const {
        const int row0 = u.pm * 256 + wr * 64 + fr, col0 = u.pn * 256 + wc * 32 + 8 * fq;
#pragma unroll
        for (int bj = 0; bj < 2; ++bj)
#pragma unroll
            for (int ai = 0; ai < 2; ++ai)
#pragma unroll
                for (int m = 0; m < 4; ++m) {
                    const size_t off = (size_t)(row0 + ai * 128 + m * 16) * DM + col0 + bj * 128;
                    float g[8], mo[8]; unpack8(*(const u32x4*)(Gt + off), g);
                    if (!first) unpack8(*(const u32x4*)(MB + off), mo);
                    else {
#pragma unroll
                        for (int e = 0; e < 8; ++e) mo[e] = 0.f;
                    }
                    const f32x4 v0 = acc[ai][bj][m][0], v1 = acc[ai][bj][m][1];
                    float r[8];
#pragma unroll
                    for (int e = 0; e < 4; ++e) { r[e] = mo[e] + g[e] * v0[e]; r[4 + e] = mo[4 + e] + g[4 + e] * v1[e]; }
                    if constexpr (LAST) { u32x2 w8; w8.x = pk4_fp8(r[0] * M8_SCALE, r[1] * M8_SCALE, r[2] * M8_SCALE, r[3] * M8_SCALE); w8.y = pk4_fp8(r[4] * M8_SCALE, r[5] * M8_SCALE, r[6] * M8_SCALE, r[7] * M8_SCALE); *(u32x2*)(M8 + off) = w8; }
                    else { u32x4 w; w.x = pk2(r[0], r[1]); w.y = pk2(r[2], r[3]); w.z = pk2(r[4], r[5]); w.w = pk2(r[6], r[7]); *(u32x4*)(MB + off) = w; }
                }
    }
};
struct EpiOut {
    static constexpr bool PERM = true, AFTER_DRAIN = false;
    const float* x; float* out;
    __device__ __forceinline__ void operator()(const f32x4 (&acc)[2][2][4][2], const Unit& u, int wr, int wc, int fr, int fq) const {
        const int row0 = u.pm * 256 + wr * 64 + fr, col0 = u.pn * 256 + wc * 32 + 8 * fq;
#pragma unroll
        for (int ai = 0; ai < 2; ++ai)
#pragma unroll
            for (int m = 0; m < 4; ++m)
#pragma unroll
                for (int bj = 0; bj < 2; ++bj) {
                    const size_t off = (size_t)(row0 + ai * 128 + m * 16) * DM + col0 + bj * 128;
                    const f32x4 x0 = *(const f32x4*)(x + off), x1 = *(const f32x4*)(x + off + 4);
                    *(f32x4*)(out + off) = x0 + acc[ai][bj][m][0]; *(f32x4*)(out + off + 4) = x1 + acc[ai][bj][m][1];
                }
    }
};

__device__ __forceinline__ void norm_rows_inplace(bf16_t* buf, int ld, int nrows, int hd, const float* gain, float scale, int gw, int NGW, int lane) {
    for (int r = gw; r < nrows; r += NGW) {
        bf16_t* p = buf + (size_t)r * ld + lane * 8;
        float f[8]; unpack8(*(const u32x4*)p, f);
        float ss = 0.f;
#pragma unroll
        for (int i = 0; i < 8; ++i) ss += f[i] * f[i];
        ss += __shfl_xor(ss, 1); ss += __shfl_xor(ss, 2); ss += __shfl_xor(ss, 4);
        if (hd == 128) ss += __shfl_xor(ss, 8);
        const float rs = scale / sqrtf(ss / (float)hd + EPS);
        const float* g = gain + ((lane * 8) % hd);
        u32x4 w; w.x = pk2(f[0] * rs * g[0], f[1] * rs * g[1]); w.y = pk2(f[2] * rs * g[2], f[3] * rs * g[3]); w.z = pk2(f[4] * rs * g[4], f[5] * rs * g[5]); w.w = pk2(f[6] * rs * g[6], f[7] * rs * g[7]);
        *(u32x4*)p = w;
    }
}

constexpr int IDX_RS = 8208;
typedef float f32x2_t __attribute__((ext_vector_type(2)));
__device__ __forceinline__ unsigned mono16x2(f32x2_t v) {
    typedef _Float16 h2 __attribute__((ext_vector_type(2))); typedef short s2 __attribute__((ext_vector_type(2)));
    const h2 h = __builtin_convertvector(v, h2); const unsigned hb = __builtin_bit_cast(unsigned, h);
    const s2 sg = __builtin_bit_cast(s2, hb) >> 15;
    return hb ^ (__builtin_bit_cast(unsigned, sg) | 0x80008000u);
}
__device__ __forceinline__ unsigned mono16(float s) {
    const _Float16 h = (_Float16)s; const unsigned b = (unsigned)__builtin_bit_cast(unsigned short, h);
    return (b & 0x8000u) ? (~b & 0xffffu) : (b | 0x8000u);
}
__device__ __forceinline__ void indexer_unit(Ctx& C, int b, int blk) {
    const bf16_t* QI = WSP(WS_QI); const bf16_t* KW = WSP(WS_KW); unsigned char* maskb = C.ws + WS_MASK;
    int lane = C.lane; asm volatile("" : "+v"(lane));
    const int wid = C.wave, fr = lane & 15, fq = lane >> 4;
    const int t0 = blk * 16; const size_t rowbase = (size_t)b * SEQ;
    bf16x8 qf[8][2];
    { const bf16_t* qt = QI + ((rowbase >> 4) + blk) * 8192 + lane * 8;
#pragma unroll
      for (int h = 0; h < 8; ++h)
#pragma unroll
          for (int ks = 0; ks < 2; ++ks) qf[h][ks] = *(const bf16x8*)(qt + h * 1024 + ks * 512); }
    float wv[8]; unpack8(*(const u32x4*)((const bf16_t*)(C.ws + WS_KW + 4 * MiB) + (rowbase + t0 + fr) * 8), wv);
    bf16x8 qbar[2];
#pragma unroll
    for (int ks = 0; ks < 2; ++ks) { float acc8[8] = {0.f, 0.f, 0.f, 0.f, 0.f, 0.f, 0.f, 0.f};
#pragma unroll
        for (int h = 0; h < 8; ++h) { float f[8]; unpack8(__builtin_bit_cast(u32x4, qf[h][ks]), f);
#pragma unroll
            for (int i = 0; i < 8; ++i) acc8[i] += wv[h] * f[i]; }
        u32x4 w_; w_.x = pk2(acc8[0], acc8[1]); w_.y = pk2(acc8[2], acc8[3]); w_.z = pk2(acc8[4], acc8[5]); w_.w = pk2(acc8[6], acc8[7]); qbar[ks] = __builtin_bit_cast(bf16x8, w_); }
    const int ntile = blk + 1;
    const int nmine = (ntile - wid + 7) >> 3;
    const bf16_t* kbase = KW + (rowbase >> 4) * 1024 + lane * 8;
#ifdef IDX_REP_COMP
#define IDX_REPC(K) for (int rc_ = 0; rc_ < 2; ++rc_) { asm volatile("" : "+v"(K[j_][0]), "+v"(K[j_][1]));
#define IDX_REPC_END }
#else
#define IDX_REPC(K) {
#define IDX_REPC_END }
#endif
#define IDX_LOAD4(K, I0) do { _Pragma("unroll") for (int j_ = 0; j_ < 4; ++j_) { int kt_ = wid + 8 * ((I0) + j_); kt_ = kt_ < ntile ? kt_ : ntile - 1; \
        const bf16_t* p_ = kbase + (size_t)kt_ * 1024; K[j_][0] = *(const bf16x8*)p_; K[j_][1] = *(const bf16x8*)(p_ + 512); } } while (0)
#define IDX_COMP4(K, I0) do { _Pragma("unroll") for (int j_ = 0; j_ < 4; ++j_) { if ((I0) + j_ < nmine) { const int kt_ = wid + 8 * ((I0) + j_); \
        IDX_REPC(K) \
          \
        f32x4 l_ = {0.f, 0.f, 0.f, 0.f}; l_ = mfma16(K[j_][0], qbar[0], l_); l_ = mfma16(K[j_][1], qbar[1], l_); \
        float s0_ = 0.f, s1_ = 0.f, s2_ = 0.f, s3_ = 0.f; \
        _Pragma("unroll") for (int h = 0; h < 8; ++h) { f32x4 a_ = {0.f, 0.f, 0.f, 0.f}; a_ = mfma16(K[j_][0], qf[h][0], a_); a_ = mfma16(K[j_][1], qf[h][1], a_); \
            s0_ = __builtin_fmaf(__builtin_fabsf(a_[0]), wv[h], s0_); s1_ = __builtin_fmaf(__builtin_fabsf(a_[1]), wv[h], s1_); \
            s2_ = __builtin_fmaf(__builtin_fabsf(a_[2]), wv[h], s2_); s3_ = __builtin_fmaf(__builtin_fabsf(a_[3]), wv[h], s3_); \
            asm("" : "+v"(s0_)); asm("" : "+v"(s1_)); asm("" : "+v"(s2_)); asm("" : "+v"(s3_)); }     \
        unsigned k01_ = mono16x2((f32x2_t){s0_ + l_[0], s1_ + l_[1]}), k23_ = mono16x2((f32x2_t){s2_ + l_[2], s3_ + l_[3]}); \
        if (kt_ == ntile - 1) { const int lim_ = t0 + fr - kt_ * 16 - fq * 4;            \
            k01_ &= (lim_ >= 0 ? 0xffffu : 0u) | (lim_ >= 1 ? 0xffff0000u : 0u); k23_ &= (lim_ >= 2 ? 0xffffu : 0u) | (lim_ >= 3 ? 0xffff0000u : 0u); } \
        u32x2 w_; w_.x = k01_; w_.y = k23_; \
        *(LAS u32x2*)(C.lds + fr * IDX_RS + (kt_ * 16 + fq * 4) * 2) = w_; IDX_REPC_END } } } while (0)
#ifdef IDX_REP_MFMA
    for (int rep_ = 0; rep_ < 2; ++rep_)
#endif
    { bf16x8 ka[4][2], kb[4][2], kc[4][2];
      IDX_LOAD4(ka, 0); IDX_LOAD4(kb, 4);
      for (int i0 = 0; i0 < nmine;) {
          IDX_LOAD4(kc, i0 + 8);
          IDX_COMP4(ka, i0);
          i0 += 4; if (i0 >= nmine) break;
          IDX_LOAD4(ka, i0 + 8);
          IDX_COMP4(kb, i0);
          i0 += 4; if (i0 >= nmine) break;
          IDX_LOAD4(kb, i0 + 8);
          IDX_COMP4(kc, i0);
          i0 += 4;
      } }
#undef IDX_LOAD4
#undef IDX_COMP4
    {
      const int p0 = 16 * ntile, ng = ((((p0 + 511) >> 9) << 9) - p0) >> 3;
      for (int i = C.tid; i < ng * 16; i += NTHR) { const int row = i / ng, g = i - row * ng; u32x4 z = {0u, 0u, 0u, 0u}; *(LAS u32x4*)(C.lds + row * IDX_RS + (p0 + 8 * g) * 2) = z; } }
    __syncthreads();
#ifdef IDX_REP_SEL
#define IDX_NRR 4
#else
#define IDX_NRR 2
#endif
    unsigned lmv = 0u;
#pragma unroll 1
    for (int rr_ = 0; rr_ < IDX_NRR; ++rr_) {
        const int rr = rr_ & 1;
        const int q = 2 * wid + rr, t = t0 + q;
        unsigned char* mrow = maskb + ((size_t)b * 64 * 4096 + t) * 8 + (size_t)(lane >> 3) * 32768 + (lane & 7);
        if (t < 256) {
#pragma unroll
            for (int j = 0; j < 8; ++j) { int nb = t + 1 - (64 * j + lane) * 8; nb = nb < 0 ? 0 : (nb > 8 ? 8 : nb);
                mrow[(size_t)j * 262144] = (unsigned char)(((1u << ((nb + 1) >> 1)) - 1u) | (((1u << (nb >> 1)) - 1u) << 4)); }
            lmv = umax_(lmv, (unsigned)(4095 - t));
            continue;
        }
        unsigned w[32];
#pragma unroll
        for (int j = 0; j < 8; ++j) {
            u32x4 v = {0u, 0u, 0u, 0u};
            if (512 * j <= t0 + 15) v = *(const LAS u32x4*)(C.lds + q * IDX_RS + (64 * j + lane) * 16);
            w[4 * j] = v[0]; w[4 * j + 1] = v[1]; w[4 * j + 2] = v[2]; w[4 * j + 3] = v[3];
        }
#define IDX_TSTAGE(S, M) _Pragma("unroll") for (int k = 0; k < 32; ++k) { if ((k & (S)) == 0) { const unsigned a_ = w[k], b_ = w[k + (S)]; \
            w[k] = (a_ & (M)) | ((b_ << (S)) & ~(M)); w[k + (S)] = ((a_ >> (S)) & (M)) | (b_ & ~(M)); } }
        IDX_TSTAGE(16, 0x0000ffffu) IDX_TSTAGE(8, 0x00ff00ffu) IDX_TSTAGE(4, 0x0f0f0f0fu) IDX_TSTAGE(2, 0x33333333u) IDX_TSTAGE(1, 0x55555555u)
#undef IDX_TSTAGE
        unsigned ce = 0xffffffffu, co = 0xffffffffu, ae = 0u, ao = 0u, cnt_above = 0u;
#pragma unroll
        for (int b = 15; b >= 0; --b) {
            const unsigned oe = ce & w[b], oo = co & w[16 + b];
            const unsigned tot = wave_sum_dpp((unsigned)(__builtin_popcount(oe) + __builtin_popcount(oo)));
            if (cnt_above + tot >= 256u) { ce = oe; co = oo; }
            else { cnt_above += tot; ae |= oe; ao |= oo; ce &= ~w[b]; co &= ~w[16 + b]; }
        }
        int excess = (int)wave_sum_dpp((unsigned)(__builtin_popcount(ce) + __builtin_popcount(co))) - (256 - (int)cnt_above);
        while (excess > 0) {
            const int ie = ce ? 31 - __builtin_clz(ce) : -1, io = co ? 31 - __builtin_clz(co) : -1;
            const int i0 = ie >= 0 ? 2 * ie : -1, i1 = io >= 0 ? 2 * io + 1 : -1, itop = i0 > i1 ? i0 : i1;
            const unsigned p = itop >= 0 ? (unsigned)((((itop >> 3) << 9) | (lane << 3) | (itop & 7)) + 1) : 0u;
            const unsigned pm = wave_max_dpp(p);
            if (p == pm && p != 0u) { if (itop & 1) co &= ~(1u << (itop >> 1)); else ce &= ~(1u << (itop >> 1)); }
            --excess;
        }
        const unsigned se = ae | ce, so = ao | co;
#pragma unroll
        for (int j = 0; j < 8; ++j) mrow[(size_t)j * 262144] = (unsigned char)(((se >> (4 * j)) & 0xfu) | (((so >> (4 * j)) & 0xfu) << 4));
        {
          const int ie = se ? 31 - __builtin_clz(se) : -1, io = so ? 31 - __builtin_clz(so) : -1;
          const int i0 = ie >= 0 ? 2 * ie : -1, i1 = io >= 0 ? 2 * io + 1 : -1, itop = i0 > i1 ? i0 : i1;
          const unsigned p = itop >= 0 ? (unsigned)(((itop >> 3) << 9) | (lane << 3) | (itop & 7)) : 0u;
          const unsigned Lq = wave_max_dpp(p);
          lmv = umax_(lmv, 4095u - Lq); }
    }
    { LAS unsigned* lm = (LAS unsigned*)(C.lds + 132096);
      if (lane == 0) lm[wid] = lmv;
      __syncthreads();
      if (C.tid == 0) { unsigned m_ = lm[0];
#pragma unroll
          for (int i = 1; i < 8; ++i) m_ = umax_(m_, lm[i]);
          ((unsigned*)(C.ws + WS_LMINV))[b * 256 + blk] = m_; } }
}

constexpr int HG_BC = 0, HG_KK = 32768, HG_Q4 = 65536, HG_R = 67584;
struct HgIn { u32x4 fb0, fb1; unsigned iv[16]; };
struct HgOIn { u32x4 fb0, fb1, qb0, qb1, gb0, gb1; unsigned iv[16]; bf16x8 sf[8]; };
__device__ __forceinline__ void hg_rc(int unit, size_t& R0, int& cb) { const int bh = unit >> 6, n = unit & 63; R0 = (size_t)(bh >> 2) * SEQ + 64 * n; cb = (bh & 3) * 128; }
__device__ __forceinline__ void hg_ld16(Ctx& C, const bf16_t* X, int unit, u32x4& a, u32x4& b) {
    size_t R0; int cb; hg_rc(unit, R0, cb); const bf16_t* p = X + (R0 + (C.tid >> 3)) * 512 + cb + (C.tid & 7) * 16; a = *(const u32x4*)p; b = *(const u32x4*)(p + 8); }
__device__ __forceinline__ void hg_ldiv(Ctx& C, int unit, unsigned (&iv)[16]) {
    size_t R0; int cb; hg_rc(unit, R0, cb); const bf16_t* p = WSP(WS_IB) + (R0 + 16 * (C.tid >> 7)) * 512 + cb + (C.tid & 127);
#pragma unroll
    for (int i = 0; i < 16; ++i) iv[i] = p[(size_t)i * 512]; }
__device__ __forceinline__ void hg_ldsf(Ctx& C, const bf16_t* SinT, int unit, bf16x8 (&sf)[8]) {
    const bf16_t* sp = SinT + (size_t)unit * 16384 + (size_t)(32 * (C.wave >> 1) + (C.lane & 31)) * 128 + 8 * (C.lane >> 5);
#pragma unroll
    for (int ks = 0; ks < 8; ++ks) sf[ks] = *(const bf16x8*)(sp + 16 * ks); }
__device__ __forceinline__ void hgrn_stage(Ctx& C, int cb, const float* lbin, u32x4 fb0, u32x4 fb1) {
    LAS float* Bc = (LAS float*)(C.lds + HG_BC); LAS float* KK = (LAS float*)(C.lds + HG_KK); LAS float* Q4 = (LAS float*)(C.lds + HG_Q4);
    const int tid = C.tid;
    { const int row = tid >> 3, seg = tid & 7;
      float fp[16]; { float a[8], b[8]; unpack8(fb0, a); unpack8(fb1, b);
#pragma unroll
          for (int i = 0; i < 8; ++i) { fp[i] = a[i]; fp[8 + i] = b[i]; } }
      float lbv[16]; { const f32x4* lp = (const f32x4*)((const float*)(C.ws + WS_LBT) + cb + seg * 16);
#pragma unroll
          for (int i = 0; i < 4; ++i) { const f32x4 t_ = lp[i]; lbv[4 * i] = t_.x; lbv[4 * i + 1] = t_.y; lbv[4 * i + 2] = t_.z; lbv[4 * i + 3] = t_.w; } }
#pragma unroll
      for (int i = 0; i < 16; ++i) { const float lb = lbv[i];
          const float f = lb + (1.f - lb) * sigm(fp[i]);
          Bc[row * 128 + seg * 16 + i] = __builtin_amdgcn_logf(f);
          KK[row * 128 + seg * 16 + i] = 1.f - f; } }
    __syncthreads();
    const int col = tid & 127, q = tid >> 7;
    { float s = 0.f;
#pragma unroll
      for (int r = 0; r < 16; ++r) { s += Bc[(16 * q + r) * 128 + col]; Bc[(16 * q + r) * 128 + col] = s; }
      Q4[q * 128 + col] = s; }
    __syncthreads();
    { float off = 0.f;
      for (int qq = 0; qq < q; ++qq) off += Q4[qq * 128 + col];
      if (q > 0) {
#pragma unroll
          for (int r = 0; r < 16; ++r) Bc[(16 * q + r) * 128 + col] += off; } }
    __syncthreads();
}
__device__ __forceinline__ void hgrn_stage_vT(Ctx& C, LAS bf16_t* vsT, const unsigned (&t)[16]) {
    const int v = C.tid & 127, sq = C.tid >> 7;
    u32x4 w0, w1; w0.x = t[0] | (t[1] << 16); w0.y = t[2] | (t[3] << 16); w0.z = t[4] | (t[5] << 16); w0.w = t[6] | (t[7] << 16);
    w1.x = t[8] | (t[9] << 16); w1.y = t[10] | (t[11] << 16); w1.z = t[12] | (t[13] << 16); w1.w = t[14] | (t[15] << 16);
    *(LAS u32x4*)(vsT + v * 72 + 16 * sq) = w0; *(LAS u32x4*)(vsT + v * 72 + 16 * sq + 8) = w1;
}
__device__ __forceinline__ void hgrn_local_unit(Ctx& C, int unit, int unext, HgIn& R, bf16_t* LcT, float* DEC, const float* lbin) {
    size_t R0; int cb; hg_rc(unit, R0, cb);
    LAS float* Bc = (LAS float*)(C.lds + HG_BC); LAS float* KK = (LAS float*)(C.lds + HG_KK);
    LAS bf16_t* kdecT = (LAS bf16_t*)(C.lds + HG_R); LAS bf16_t* vsT = (LAS bf16_t*)(C.lds + HG_R + 18432);
    { const u32x4 f0 = R.fb0, f1 = R.fb1; hg_ld16(C, WSP(WS_FB), unext, R.fb0, R.fb1); hgrn_stage(C, cb, lbin, f0, f1); }
    { const int d = C.tid & 127, sq = C.tid >> 7; const float bl = Bc[63 * 128 + d];
      unsigned w[8];
#pragma unroll
      for (int i = 0; i < 8; ++i) { const int s0 = 16 * sq + 2 * i;
          const float a = KK[s0 * 128 + d] * ex2(bl - Bc[s0 * 128 + d]), bb = KK[(s0 + 1) * 128 + d] * ex2(bl - Bc[(s0 + 1) * 128 + d]);
          w[i] = pk2(a, bb); }
      u32x4 w0 = {w[0], w[1], w[2], w[3]}, w1 = {w[4], w[5], w[6], w[7]};
      *(LAS u32x4*)(kdecT + d * 72 + 16 * sq) = w0; *(LAS u32x4*)(kdecT + d * 72 + 16 * sq + 8) = w1; }
    hgrn_stage_vT(C, vsT, R.iv); hg_ldiv(C, unext, R.iv);
    if (C.tid < 128) DEC[(size_t)unit * 128 + C.tid] = ex2(Bc[63 * 128 + C.tid]);
    __syncthreads();
    { const int r32 = C.lane & 31, hi = C.lane >> 5, vb = C.wave >> 1, dbp = C.wave & 1;
      f32x16 c0, c1;
#pragma unroll
      for (int r = 0; r < 16; ++r) { c0[r] = 0.f; c1[r] = 0.f; }
#pragma unroll
      for (int ks = 0; ks < 4; ++ks) {
          const bf16x8 a = *(const LAS bf16x8*)(vsT + (32 * vb + r32) * 72 + 16 * ks + 8 * hi);
          const bf16x8 b0 = *(const LAS bf16x8*)(kdecT + (64 * dbp + r32) * 72 + 16 * ks + 8 * hi);
          const bf16x8 b1 = *(const LAS bf16x8*)(kdecT + (64 * dbp + 32 + r32) * 72 + 16 * ks + 8 * hi);
          c0 = mfma32(a, b0, c0); c1 = mfma32(a, b1, c1); }
      bf16_t* o = LcT + (size_t)unit * 16384;
#pragma unroll
      for (int r = 0; r < 16; ++r) { const int v = 32 * vb + crow(r, hi); o[v * 128 + 64 * dbp + r32] = f2bf(c0[r]); o[v * 128 + 64 * dbp + 32 + r32] = f2bf(c1[r]); } }
    __syncthreads();
}
__device__ __forceinline__ void hgrn_scan(Ctx& C, const bf16_t* LcT, const float* DEC, bf16_t* SinT) {
    for (int gid = C.bid * NTHR + C.tid; gid < 32 * 4096; gid += C.G * NTHR) {
        const int bh = gid >> 12, quad = gid & 4095, v = quad >> 5, d0 = (quad & 31) * 4;
        float st[4] = {0.f, 0.f, 0.f, 0.f};
#pragma unroll 4
        for (int n = 0; n < 64; ++n) {
            const int unit = bh * 64 + n; const size_t e = (size_t)unit * 16384 + v * 128 + d0;
            const u32x2 lc = *(const u32x2*)(LcT + e); const f32x4 dc = *(const f32x4*)(DEC + (size_t)unit * 128 + d0);
            u32x2 w; w.x = pk2(st[0], st[1]); w.y = pk2(st[2], st[3]);
            *(u32x2*)(SinT + e) = w;
            st[0] = dc.x * st[0] + bf2f(lc.x & 0xffffu); st[1] = dc.y * st[1] + bf2f(lc.x >> 16);
            st[2] = dc.z * st[2] + bf2f(lc.y & 0xffffu); st[3] = dc.w * st[3] + bf2f(lc.y >> 16);
        }
    }
}
__device__ __forceinline__ void hgrn_out_unit(Ctx& C, int unit, int unext, HgOIn& R, const bf16_t* SinT, const float* lbin, const float* onb) {
    size_t R0; int cb; hg_rc(unit, R0, cb);
    LAS float* Bc = (LAS float*)(C.lds + HG_BC); LAS float* KK = (LAS float*)(C.lds + HG_KK);
    LAS bf16_t* QTl = (LAS bf16_t*)(C.lds + HG_R); LAS bf16_t* KTl = (LAS bf16_t*)(C.lds + HG_R + 17408);
    LAS bf16_t* vsT = (LAS bf16_t*)(C.lds + HG_R + 34816); LAS bf16_t* Pl = (LAS bf16_t*)(C.lds + HG_R + 34816 + 18432);
    LAS float* OF = (LAS float*)(C.lds + 0);
    { const u32x4 f0 = R.fb0, f1 = R.fb1; hg_ld16(C, WSP(WS_FB), unext, R.fb0, R.fb1); hgrn_stage(C, cb, lbin, f0, f1);
#ifdef HGO_REP_A
      hgrn_stage(C, cb, lbin, f0, f1);
#endif
    }
#ifdef HGO_REP_B
    for (int rb_ = 0; rb_ < 2; ++rb_)
#endif
    { const int row = C.tid >> 3, seg = C.tid & 7;
      float qv[16]; { float a[8], bq[8]; unpack8(R.qb0, a); unpack8(R.qb1, bq);
#pragma unroll
          for (int i = 0; i < 8; ++i) { qv[i] = a[i]; qv[8 + i] = bq[i]; } }
#ifdef HGO_REP_B
      if (rb_ == 1)
#endif
      hg_ld16(C, WSP(WS_QB), unext, R.qb0, R.qb1);
      unsigned wq[8], wk[8];
#pragma unroll
      for (int i = 0; i < 8; ++i) { const int d = seg * 16 + 2 * i;
          const float b0 = Bc[row * 128 + d], b1 = Bc[row * 128 + d + 1];
          wq[i] = pk2(qv[2 * i] * ex2(b0), qv[2 * i + 1] * ex2(b1));
          wk[i] = pk2(KK[row * 128 + d] * ex2(-b0), KK[row * 128 + d + 1] * ex2(-b1)); }
      u32x4 a0 = {wq[0], wq[1], wq[2], wq[3]}, a1 = {wq[4], wq[5], wq[6], wq[7]}, k0 = {wk[0], wk[1], wk[2], wk[3]}, k1 = {wk[4], wk[5], wk[6], wk[7]};
      *(LAS u32x4*)(QTl + row * 136 + seg * 16) = a0; *(LAS u32x4*)(QTl + row * 136 + seg * 16 + 8) = a1;
      *(LAS u32x4*)(KTl + row * 136 + seg * 16) = k0; *(LAS u32x4*)(KTl + row * 136 + seg * 16 + 8) = k1; }
    hgrn_stage_vT(C, vsT, R.iv); hg_ldiv(C, unext, R.iv);
    __syncthreads();
    const int r32 = C.lane & 31, hi = C.lane >> 5;
#ifdef HGO_REP_C
    for (int rc_ = 0; rc_ < 2; ++rc_) {
    if (rc_) __syncthreads();
#else
    {
#endif
    if (C.wave < 4) {
        const int tb = C.wave >> 1, sb = C.wave & 1;
        f32x16 c;
#pragma unroll
        for (int r = 0; r < 16; ++r) c[r] = 0.f;
        if (!(tb == 0 && sb == 1)) {
#pragma unroll
            for (int ks = 0; ks < 8; ++ks) {
                const bf16x8 a = *(const LAS bf16x8*)(QTl + (32 * tb + r32) * 136 + 16 * ks + 8 * hi);
                const bf16x8 bb = *(const LAS bf16x8*)(KTl + (32 * sb + r32) * 136 + 16 * ks + 8 * hi);
                c = mfma32(a, bb, c); }
        }
#pragma unroll
        for (int r = 0; r < 16; ++r) { const int t = 32 * tb + crow(r, hi), s = 32 * sb + r32; Pl[t * 72 + s] = f2bf((s <= t) ? c[r] : 0.f); }
    }
    __syncthreads();
    { const int tb = C.wave & 1, vb = C.wave >> 1;
      f32x16 c;
#pragma unroll
      for (int r = 0; r < 16; ++r) c[r] = 0.f;
#pragma unroll
      for (int ks = 0; ks < 4; ++ks) {
          const bf16x8 a = *(const LAS bf16x8*)(Pl + (32 * tb + r32) * 72 + 16 * ks + 8 * hi);
          const bf16x8 bb = *(const LAS bf16x8*)(vsT + (32 * vb + r32) * 72 + 16 * ks + 8 * hi);
          c = mfma32(a, bb, c); }
#pragma unroll
      for (int ks = 0; ks < 8; ++ks) {
          const bf16x8 a = *(const LAS bf16x8*)(QTl + (32 * tb + r32) * 136 + 16 * ks + 8 * hi);
          c = mfma32(a, R.sf[ks], c); }
#ifdef HGO_REP_C
      if (rc_ == 1)
#endif
      hg_ldsf(C, SinT, unext, R.sf);
#ifdef DUP_SF
      { bf16x8 x_[8]; hg_ldsf(C, SinT, unext ^ 1, x_); asm volatile("" :: "v"(x_[0]), "v"(x_[1]), "v"(x_[2]), "v"(x_[3]), "v"(x_[4]), "v"(x_[5]), "v"(x_[6]), "v"(x_[7])); }
#endif
#pragma unroll
      for (int r = 0; r < 16; ++r) OF[(32 * tb + crow(r, hi)) * 132 + 32 * vb + r32] = c[r]; }
    }
    __syncthreads();
#ifdef HGO_REP_D
    for (int rd_ = 0; rd_ < 2; ++rd_)
#endif
    { const int row = C.tid >> 3, seg = C.tid & 7;
      float o[16]; float ss = 0.f;
#pragma unroll
      for (int i = 0; i < 16; ++i) { o[i] = OF[row * 132 + seg * 16 + i]; ss += o[i] * o[i]; }
      ss += __shfl_xor(ss, 1); ss += __shfl_xor(ss, 2); ss += __shfl_xor(ss, 4);
      const float rs = 1.f / sqrtf(ss * (1.f / 128.f) + EPS);
      float g[16]; { float a[8], bq[8]; unpack8(R.gb0, a); unpack8(R.gb1, bq);
#pragma unroll
          for (int i = 0; i < 8; ++i) { g[i] = a[i]; g[8 + i] = bq[i]; } }
#ifdef HGO_REP_D
      if (rd_ == 1)
#endif
      hg_ld16(C, WSP(WS_GB), unext, R.gb0, R.gb1);
      float ov[16];
#pragma unroll
      for (int i = 0; i < 16; ++i) ov[i] = o[i] * (rs * O8_SCALE) * onb[seg * 16 + i] * g[i];
      u32x4 w8; w8.x = pk4_fp8(ov[0], ov[1], ov[2], ov[3]); w8.y = pk4_fp8(ov[4], ov[5], ov[6], ov[7]); w8.z = pk4_fp8(ov[8], ov[9], ov[10], ov[11]); w8.w = pk4_fp8(ov[12], ov[13], ov[14], ov[15]);
      *(u32x4*)(C.ws + WS_O8B + (size_t)(R0 + row) * 512 + cb + seg * 16) = w8; }
    __syncthreads();
}

template <int D, bool MASKED, bool QN>
__device__ __forceinline__ void attn_unit(Ctx& C, const float* qgain, float qscale, const bf16_t* Qu, int ldq, const bf16_t* Kh, const bf16_t* Vh, int ldkv, const bf16_t* Zu, bf16_t* Ou, int ldo,
                                          int ntiles, const unsigned long long* mask_u, float sl2, int kvref) {
    constexpr int KS = D + 8, VS = 72, NDB = D / 32, NKS = D / 16;
    LAS bf16_t* Kt = (LAS bf16_t*)C.lds; LAS bf16_t* Vt = (LAS bf16_t*)(C.lds + 64 * KS * 2);
    const int tid = C.tid, wid = C.wave, lane = C.lane, r32 = lane & 31, hi = lane >> 5;
    bf16x8 qr[NKS];
    { const bf16_t* Qw = Qu + (size_t)(wid * 32 + r32) * ldq;
#pragma unroll
      for (int ks = 0; ks < NKS; ++ks) qr[ks] = *(const bf16x8*)(Qw + ks * 16 + hi * 8); }
    if (QN) {
        float ss = 0.f;
#pragma unroll
        for (int ks = 0; ks < NKS; ++ks) { float f[8]; unpack8(__builtin_bit_cast(u32x4, qr[ks]), f);
#pragma unroll
            for (int i = 0; i < 8; ++i) ss += f[i] * f[i]; }
        ss += __shfl_xor(ss, 32);
        const float rs = qscale / sqrtf(ss * (1.f / (float)D) + EPS);
#pragma unroll
        for (int ks = 0; ks < NKS; ++ks) { float f[8]; unpack8(__builtin_bit_cast(u32x4, qr[ks]), f); const float* gp = qgain + ks * 16 + hi * 8;
            u32x4 w; w.x = pk2(f[0] * rs * gp[0], f[1] * rs * gp[1]); w.y = pk2(f[2] * rs * gp[2], f[3] * rs * gp[3]); w.z = pk2(f[4] * rs * gp[4], f[5] * rs * gp[5]); w.w = pk2(f[6] * rs * gp[6], f[7] * rs * gp[7]);
            qr[ks] = __builtin_bit_cast(bf16x8, w); }
    }
    f32x16 o[NDB];
#pragma unroll
    for (int db = 0; db < NDB; ++db)
#pragma unroll
        for (int r = 0; r < 16; ++r) o[db][r] = 0.f;
    float m = -1e30f, l = 0.f;
    for (int j = 0; j < ntiles; ++j) {
        __syncthreads();
        for (int i = tid; i < 64 * D / 8; i += NTHR) { const int key = i / (D / 8), seg = i % (D / 8);
            *(LAS u32x4*)(Kt + key * KS + seg * 8) = *(const u32x4*)(Kh + (size_t)(64 * j + key) * ldkv + seg * 8); }
        { constexpr int NK = 64 / (NTHR / D); const int d = tid % D, sq = tid / D;
          const bf16_t* vp = Vh + (size_t)(64 * j + sq * NK) * ldkv + d;
          unsigned t[NK];
#pragma unroll
          for (int i = 0; i < NK; ++i) t[i] = vp[(size_t)i * ldkv];
#pragma unroll
          for (int c = 0; c < NK / 8; ++c) { u32x4 w; w.x = t[8 * c] | (t[8 * c + 1] << 16); w.y = t[8 * c + 2] | (t[8 * c + 3] << 16); w.z = t[8 * c + 4] | (t[8 * c + 5] << 16); w.w = t[8 * c + 6] | (t[8 * c + 7] << 16);
              *(LAS u32x4*)(Vt + d * VS + sq * NK + c * 8) = w; } }
        __syncthreads();
        f32x16 p0, p1;
#pragma unroll
        for (int r = 0; r < 16; ++r) { p0[r] = 0.f; p1[r] = 0.f; }
#pragma unroll
        for (int ks = 0; ks < NKS; ++ks) {
            const bf16x8 a0 = *(const LAS bf16x8*)(Kt + r32 * KS + ks * 16 + hi * 8);
            const bf16x8 a1 = *(const LAS bf16x8*)(Kt + (32 + r32) * KS + ks * 16 + hi * 8);
            p0 = mfma32(a0, qr[ks], p0); p1 = mfma32(a1, qr[ks], p1); }
        if (MASKED) {
            const unsigned long long w = mask_u[(size_t)(wid * 32 + r32) * 64 + j];
            const unsigned wlo = (unsigned)w >> (4 * hi), whi = (unsigned)(w >> 32) >> (4 * hi);
            const float bb = sl2 * (float)(64 * j + 4 * hi - kvref);
#pragma unroll
            for (int r = 0; r < 16; ++r) { const int kc = (r & 3) + 8 * (r >> 2);
                p0[r] = ((wlo >> kc) & 1u) ? p0[r] + (bb + sl2 * (float)kc) : -INFINITY;
                p1[r] = ((whi >> kc) & 1u) ? p1[r] + (bb + sl2 * (float)(kc + 32)) : -INFINITY; }
        }
        float mt = fmaxf(p0[0], p1[0]);
#pragma unroll
        for (int r = 1; r < 16; ++r) mt = fmaxf(mt, fmaxf(p0[r], p1[r]));
        mt = fmaxf(mt, __shfl_xor(mt, 32));
        const float mn = fmaxf(m, mt), alpha = ex2(m - mn); m = mn;
        float s = 0.f;
#pragma unroll
        for (int r = 0; r < 16; ++r) { p0[r] = ex2(p0[r] - mn); p1[r] = ex2(p1[r] - mn); s += p0[r] + p1[r]; }
        l = l * alpha + s;
#pragma unroll
        for (int r = 0; r < 16; ++r) { const float a = __shfl(alpha, crow(r, hi));
#pragma unroll
            for (int db = 0; db < NDB; ++db) o[db][r] *= a; }
        bf16x8 pa[4];
        { u32x4 w;
          w.x = pk2(p0[0], p0[1]); w.y = pk2(p0[2], p0[3]); w.z = pk2(p0[4], p0[5]); w.w = pk2(p0[6], p0[7]); pa[0] = __builtin_bit_cast(bf16x8, w);
          w.x = pk2(p0[8], p0[9]); w.y = pk2(p0[10], p0[11]); w.z = pk2(p0[12], p0[13]); w.w = pk2(p0[14], p0[15]); pa[1] = __builtin_bit_cast(bf16x8, w);
          w.x = pk2(p1[0], p1[1]); w.y = pk2(p1[2], p1[3]); w.z = pk2(p1[4], p1[5]); w.w = pk2(p1[6], p1[7]); pa[2] = __builtin_bit_cast(bf16x8, w);
          w.x = pk2(p1[8], p1[9]); w.y = pk2(p1[10], p1[11]); w.z = pk2(p1[12], p1[13]); w.w = pk2(p1[14], p1[15]); pa[3] = __builtin_bit_cast(bf16x8, w); }
#pragma unroll
        for (int s4 = 0; s4 < 4; ++s4)
#pragma unroll
            for (int db = 0; db < NDB; ++db) {
                const LAS bf16_t* vp = Vt + (db * 32 + r32) * VS + s4 * 16 + hi * 4;
                const u32x2 lo = *(const LAS u32x2*)vp, h2 = *(const LAS u32x2*)(vp + 8);
                u32x4 w = {lo.x, lo.y, h2.x, h2.y};
                o[db] = mfma32(pa[s4], __builtin_bit_cast(bf16x8, w), o[db]); }
    }
    l += __shfl_xor(l, 32);
    const float inv = 1.f / l;
#pragma unroll
    for (int r = 0; r < 16; ++r) { const int q = crow(r, hi); const float iq = __shfl(inv, q); const size_t off = (size_t)(wid * 32 + q) * ldo;
#pragma unroll
        for (int db = 0; db < NDB; ++db) { const int d = db * 32 + r32; const float z = bf2f(Zu[off + d]); Ou[off + d] = f2bf(o[db][r] * iq * z); } }
}
__device__ __forceinline__ void cross_unit(Ctx& C, int b, int h, int qpair, const float* qgain) {
    constexpr int KS = 136, VS = 264;
    LAS bf16_t* Kt = (LAS bf16_t*)C.lds; LAS bf16_t* Vt = (LAS bf16_t*)(C.lds + 256 * KS * 2);
    int tid = C.tid; asm volatile("" : "+v"(tid));
    const int wid = C.wave, lane = tid & 63, r32 = lane & 31, hi = lane >> 5;
    LAS float* wsf = (LAS float*)(C.lds + 256 * KS * 2 + 128 * VS * 2) + wid * 32 + 4 * hi;
    const bf16_t* Kh = WSP(WS_MKV) + (size_t)b * MEMLEN * 512 + h * 128;
    const bf16_t* Vh = WSP(WS_MKVT) + (size_t)h * 128 * TM + b * MEMLEN;
    { u32x4 kv[8], vv[8];
#pragma unroll
      for (int c = 0; c < 8; ++c) { const int i = tid + c * NTHR; kv[c] = *(const u32x4*)(Kh + (size_t)(i >> 4) * 512 + (i & 15) * 8); }
#pragma unroll
      for (int c = 0; c < 8; ++c) { const int i = tid + c * NTHR; vv[c] = *(const u32x4*)(Vh + (size_t)(i >> 5) * TM + (i & 31) * 8); }
#pragma unroll
      for (int c = 0; c < 8; ++c) { const int i = tid + c * NTHR; *(LAS u32x4*)(Kt + (i >> 4) * KS + (i & 15) * 8) = kv[c]; }
#pragma unroll
      for (int c = 0; c < 8; ++c) { const int i = tid + c * NTHR; *(LAS u32x4*)(Vt + (i >> 5) * VS + (i & 31) * 8) = vv[c]; } }
    __syncthreads();
#pragma unroll 1
    for (int qq = 0; qq < 2; ++qq) {
        const size_t qrow = (size_t)b * SEQ + (size_t)(qpair * 2 + qq) * 256 + wid * 32;
        const bf16_t* Qw = WSP(WS_QC) + qrow * 512 + h * 128; const bf16_t* Zw = WSP(WS_ZC) + qrow * 512 + h * 128; unsigned char* O8w = C.ws + WS_O8C + qrow * 512 + h * 128;
        bf16x8 qr[8];
#pragma unroll
        for (int ks = 0; ks < 8; ++ks) qr[ks] = *(const bf16x8*)(Qw + (size_t)r32 * 512 + ks * 16 + hi * 8);
        int lo_ = hi * 2048 + r32 * 4; asm volatile("" : "+v"(lo_));
        u32x2 zv[16];
#pragma unroll
        for (int r = 0; r < 16; ++r) zv[r] = *(const u32x2*)(Zw + (unsigned)((r & 3) + 8 * (r >> 2)) * 512u + (unsigned)lo_);
        { float ss = 0.f;
#pragma unroll
          for (int ks = 0; ks < 8; ++ks) { float f[8]; unpack8(__builtin_bit_cast(u32x4, qr[ks]), f);
#pragma unroll
              for (int i = 0; i < 8; ++i) ss += f[i] * f[i]; }
          ss += __shfl_xor(ss, 32);
          const float rs = C2C / sqrtf(ss * (1.f / 128.f) + EPS);
#pragma unroll
          for (int ks = 0; ks < 8; ++ks) { float f[8]; unpack8(__builtin_bit_cast(u32x4, qr[ks]), f); const float* gp = qgain + ks * 16 + hi * 8;
              u32x4 w; w.x = pk2(f[0] * rs * gp[0], f[1] * rs * gp[1]); w.y = pk2(f[2] * rs * gp[2], f[3] * rs * gp[3]); w.z = pk2(f[4] * rs * gp[4], f[5] * rs * gp[5]); w.w = pk2(f[6] * rs * gp[6], f[7] * rs * gp[7]);
              qr[ks] = __builtin_bit_cast(bf16x8, w); } }
        f32x16 o[4];
#pragma unroll
        for (int db = 0; db < 4; ++db)
#pragma unroll
            for (int r = 0; r < 16; ++r) o[db][r] = 0.f;
        float m = -1e30f, l = 0.f;
#pragma unroll 1
        for (int j = 0; j < 4; ++j) {
            f32x16 p0, p1;
#pragma unroll
            for (int r = 0; r < 16; ++r) { p0[r] = 0.f; p1[r] = 0.f; }
#pragma unroll
            for (int ks = 0; ks < 8; ++ks) {
                const bf16x8 a0 = *(const LAS bf16x8*)(Kt + (64 * j + r32) * KS + ks * 16 + hi * 8);
                const bf16x8 a1 = *(const LAS bf16x8*)(Kt + (64 * j + 32 + r32) * KS + ks * 16 + hi * 8);
                p0 = mfma32(a0, qr[ks], p0); p1 = mfma32(a1, qr[ks], p1); }
            float mt = fmaxf(p0[0], p1[0]);
#pragma unroll
            for (int r = 1; r < 16; ++r) mt = fmaxf(mt, fmaxf(p0[r], p1[r]));
            mt = fmaxf(mt, __shfl_xor(mt, 32));
            const float mn = fmaxf(m, mt), alpha = ex2(m - mn); m = mn;
            float s_ = 0.f;
#pragma unroll
            for (int r = 0; r < 16; ++r) { p0[r] = ex2(p0[r] - mn); p1[r] = ex2(p1[r] - mn); s_ += p0[r] + p1[r]; }
            l = l * alpha + s_;
            if (j > 0) {
                if (hi == 0) wsf[r32] = alpha;
                asm volatile("s_waitcnt lgkmcnt(0)" ::: "memory");
#pragma unroll
                for (int r = 0; r < 16; ++r) { const float a = wsf[(r & 3) + 8 * (r >> 2)];
#pragma unroll
                    for (int db = 0; db < 4; ++db) o[db][r] *= a; }
                asm volatile("s_waitcnt lgkmcnt(0)" ::: "memory"); }
            bf16x8 pa[4];
            { u32x4 w;
              w.x = pk2(p0[0], p0[1]); w.y = pk2(p0[2], p0[3]); w.z = pk2(p0[4], p0[5]); w.w = pk2(p0[6], p0[7]); pa[0] = __builtin_bit_cast(bf16x8, w);
              w.x = pk2(p0[8], p0[9]); w.y = pk2(p0[10], p0[11]); w.z = pk2(p0[12], p0[13]); w.w = pk2(p0[14], p0[15]); pa[1] = __builtin_bit_cast(bf16x8, w);
              w.x = pk2(p1[0], p1[1]); w.y = pk2(p1[2], p1[3]); w.z = pk2(p1[4], p1[5]); w.w = pk2(p1[6], p1[7]); pa[2] = __builtin_bit_cast(bf16x8, w);
              w.x = pk2(p1[8], p1[9]); w.y = pk2(p1[10], p1[11]); w.z = pk2(p1[12], p1[13]); w.w = pk2(p1[14], p1[15]); pa[3] = __builtin_bit_cast(bf16x8, w); }
#pragma unroll
            for (int s4 = 0; s4 < 4; ++s4)
#pragma unroll
                for (int db = 0; db < 4; ++db) {
                    const LAS bf16_t* vp = Vt + (db * 32 + r32) * VS + 64 * j + s4 * 16 + hi * 4;
                    const u32x2 lo = *(const LAS u32x2*)vp, h2 = *(const LAS u32x2*)(vp + 8);
                    u32x4 w = {lo.x, lo.y, h2.x, h2.y};
                    o[db] = mfma32(pa[s4], __builtin_bit_cast(bf16x8, w), o[db]); }
        }
        l += __shfl_xor(l, 32);
        const float inv = 1.f / l;
        if (hi == 0) wsf[r32] = inv;
        asm volatile("s_waitcnt lgkmcnt(0)" ::: "memory");
#pragma unroll
        for (int r = 0; r < 16; ++r) { const float iq = wsf[(r & 3) + 8 * (r >> 2)] * O8_SCALE;
            const float z0 = bf2f(zv[r].x & 0xffffu), z1 = bf2f(zv[r].x >> 16), z2 = bf2f(zv[r].y & 0xffffu), z3 = bf2f(zv[r].y >> 16);
            *(unsigned*)(O8w + (unsigned)((r & 3) + 8 * (r >> 2)) * 512u + (unsigned)lo_) = pk4_fp8(o[0][r] * iq * z0, o[1][r] * iq * z1, o[2][r] * iq * z2, o[3][r] * iq * z3); }
        asm volatile("s_waitcnt lgkmcnt(0)" ::: "memory");
    }
    __syncthreads();
}
}
#define ATTN_OUT_FP8 32
#include <hip/hip_bf16.h>
#include <cmath>
namespace attn_a {
using bf16=__hip_bfloat16;
using bf16x8=__attribute__((ext_vector_type(8)))short;
using s16x4=__attribute__((ext_vector_type(4)))short;
using f32x16=__attribute__((ext_vector_type(16)))float;
using u32x4=__attribute__((ext_vector_type(4)))unsigned;
constexpr int BATCH=8,NHEAD=8,SEQ=4096,D=64,DM=NHEAD*D;
constexpr int NW=8,QBLK=32,QB=QBLK*NW,KVBLK=64,NQB=SEQ/QB;
constexpr int ATTN_PITCH=DM, ATTN_UNIT_ROWS=QB;
__device__ __forceinline__ int crow(int r,int hi){return (r&3)+8*(r>>2)+4*hi;}
#define SBAR() __builtin_amdgcn_sched_barrier(0)
__device__ __forceinline__ void kmask(f32x16&p0,f32x16&p1,unsigned long long M,float sl2,int hi){
  const unsigned wlo=(unsigned)M>>(2*hi), whi=(unsigned)(M>>32)>>(2*hi);
  #pragma unroll
  for(int r=0;r<16;++r){ const int kc=(r&3)+8*(r>>2), kb=8*(r>>2)+((r>>1)&1)+4*(r&1);
    const unsigned m0=(unsigned)(((int)(wlo<<(31-kb)))>>31), m1=(unsigned)(((int)(whi<<(31-kb)))>>31);
    const unsigned v0=__float_as_uint(__builtin_fmaf(sl2,(float)kc,p0[r])), v1=__float_as_uint(__builtin_fmaf(sl2,(float)(kc+32),p1[r]));
    unsigned r0_,r1_; asm("v_bfi_b32 %0, %1, %2, %3":"=v"(r0_):"v"(m0),"v"(v0),"s"(0xff800000u)); asm("v_bfi_b32 %0, %1, %2, %3":"=v"(r1_):"v"(m1),"v"(v1),"s"(0xff800000u));
    p0[r]=__uint_as_float(r0_); p1[r]=__uint_as_float(r1_); }
}

constexpr int NSLOT=3, SLOTB=8192;
constexpr int LDS_K=0, LDS_V=NSLOT*SLOTB, LDS_WS=2*NSLOT*SLOTB, LDS_OST=LDS_WS+NW*64*4, LDS_BYTES=LDS_OST+NW*4096;
constexpr float C2=0.125f*1.4426950408889634f;
__device__ __forceinline__ void glds16(const void*gsrc,unsigned lds_dst){unsigned keep;
  asm volatile("s_mov_b32 %0, m0\n\ts_mov_b32 m0, %2\n\ts_nop 0\n\tglobal_load_lds_dwordx4 %1, off\n\ts_mov_b32 m0, %0":"=&s"(keep):"v"(gsrc),"s"(lds_dst):"memory");}
__device__ __forceinline__ void glds4(const void*gsrc,unsigned lds_dst){unsigned keep;
  asm volatile("s_mov_b32 %0, m0\n\ts_mov_b32 m0, %2\n\ts_nop 0\n\tglobal_load_lds_dword %1, off\n\ts_mov_b32 m0, %0":"=&s"(keep):"v"(gsrc),"s"(lds_dst):"memory");}
__device__ __forceinline__ float max3f(float a,float b,float c){float r;asm("v_max3_f32 %0, %1, %2, %3":"=v"(r):"v"(a),"v"(b),"v"(c));return r;}
__device__ __forceinline__ float max2f(float a,float b){float r;asm("v_max_f32_e32 %0, %1, %2":"=v"(r):"v"(a),"v"(b));return r;}
__device__ __forceinline__ float fadd_s(float a,float b){float r;asm("v_add_f32_e32 %0, %1, %2":"=v"(r):"v"(a),"v"(b));return r;}
__device__ __forceinline__ float fsub_s(float a,float b){float r;asm("v_sub_f32_e32 %0, %1, %2":"=v"(r):"v"(a),"v"(b));return r;}
typedef float f32x2_t __attribute__((ext_vector_type(2))); typedef __bf16 bf16x2_t __attribute__((ext_vector_type(2)));
__device__ __forceinline__ unsigned cvtpk_s(float lo,float hi){f32x2_t v={lo,hi};bf16x2_t b=__builtin_convertvector(v,bf16x2_t);return __builtin_bit_cast(unsigned,b);}
#define WAIT_BAR(N) asm volatile("s_waitcnt vmcnt(" #N ") lgkmcnt(0)\n\ts_barrier":::"memory")

__device__ __forceinline__ void qkt(f32x16&p0,f32x16&p1,const char*Kslot,const bf16x8*qr,const f32x16&negm,int r32,int hi){
  const char*kb=Kslot+hi*1024+r32*16;
  #pragma unroll
  for(int d0=0;d0<4;++d0){
    const bf16x8 b0=*reinterpret_cast<const bf16x8*>(kb+d0*2048);
    const bf16x8 b1=*reinterpret_cast<const bf16x8*>(kb+d0*2048+512);
    if(d0==0){p0=__builtin_amdgcn_mfma_f32_32x32x16_bf16(b0,qr[0],negm,0,0,0);p1=__builtin_amdgcn_mfma_f32_32x32x16_bf16(b1,qr[0],negm,0,0,0);}
    else{p0=__builtin_amdgcn_mfma_f32_32x32x16_bf16(b0,qr[d0],p0,0,0,0);p1=__builtin_amdgcn_mfma_f32_32x32x16_bf16(b1,qr[d0],p1,0,0,0);}}
}
typedef __attribute__((address_space(3))) const char* lds_cptr;
typedef short v4i16_t __attribute__((ext_vector_type(4)));
__device__ __forceinline__ void kload8(bf16x8*kf,lds_cptr kp){
  kf[0]=*(const __attribute__((address_space(3))) bf16x8*)(kp);      kf[1]=*(const __attribute__((address_space(3))) bf16x8*)(kp+512);
  kf[2]=*(const __attribute__((address_space(3))) bf16x8*)(kp+2048); kf[3]=*(const __attribute__((address_space(3))) bf16x8*)(kp+2560);
  kf[4]=*(const __attribute__((address_space(3))) bf16x8*)(kp+4096); kf[5]=*(const __attribute__((address_space(3))) bf16x8*)(kp+4608);
  kf[6]=*(const __attribute__((address_space(3))) bf16x8*)(kp+6144); kf[7]=*(const __attribute__((address_space(3))) bf16x8*)(kp+6656);
}
__device__ __forceinline__ void kload2(bf16x8*kf,lds_cptr kp,int j){ kf[2*j]=*(const __attribute__((address_space(3))) bf16x8*)(kp+j*2048); kf[2*j+1]=*(const __attribute__((address_space(3))) bf16x8*)(kp+j*2048+512); }
__device__ __forceinline__ s16x4 vtr(lds_cptr p){ return __builtin_bit_cast(s16x4,__builtin_amdgcn_ds_read_tr16_b64_v4i16((__attribute__((address_space(3))) v4i16_t*)p)); }
__device__ __forceinline__ float rowmax(const f32x16&p0,const f32x16&p1){
  float a=max3f(p0[0],p0[1],p1[0]),b=max3f(p0[2],p0[3],p1[1]);a=max3f(a,p1[2],p1[3]);
  #pragma unroll
  for(int r=4;r<16;r+=4){a=max3f(a,p0[r],p0[r+1]);b=max3f(b,p0[r+2],p0[r+3]);a=max3f(a,p1[r],p1[r+1]);b=max3f(b,p1[r+2],p1[r+3]);}
  const float m=max2f(a,b);
  auto rr=__builtin_amdgcn_permlane32_swap(__float_as_uint(m),__float_as_uint(m),false,false);
  return max2f(__uint_as_float(rr[0]),__uint_as_float(rr[1]));
}
__device__ __forceinline__ void pv(f32x16*o,int vb,bf16x8 pa0,bf16x8 pa1,bf16x8 pa2,bf16x8 pa3){
  #pragma unroll
  for(int d0=0;d0<2;++d0){s16x4 lo[4],hi[4];
    #pragma unroll
    for(int ks=0;ks<4;++ks){
      asm volatile("ds_read_b64_tr_b16 %0,%1 offset:%c2":"=&v"(lo[ks]):"v"(vb),"i"(d0*4096+ks*1024):"memory");
      asm volatile("ds_read_b64_tr_b16 %0,%1 offset:%c2":"=&v"(hi[ks]):"v"(vb),"i"(d0*4096+ks*1024+512):"memory");}
    asm volatile("s_waitcnt lgkmcnt(0)":::"memory");SBAR();
    #define PK(k) (bf16x8){lo[k][0],lo[k][1],lo[k][2],lo[k][3],hi[k][0],hi[k][1],hi[k][2],hi[k][3]}
    o[d0]=__builtin_amdgcn_mfma_f32_32x32x16_bf16(pa0,PK(0),o[d0],0,0,0);
    o[d0]=__builtin_amdgcn_mfma_f32_32x32x16_bf16(pa1,PK(1),o[d0],0,0,0);
    o[d0]=__builtin_amdgcn_mfma_f32_32x32x16_bf16(pa2,PK(2),o[d0],0,0,0);
    o[d0]=__builtin_amdgcn_mfma_f32_32x32x16_bf16(pa3,PK(3),o[d0],0,0,0);
    #undef PK
  }
}

#ifndef ATTN_STORE16
#define ATTN_STORE16(p,v) (*(u32x4*)(p)=(v))
#endif
template<int THRL> __device__ __forceinline__ void attn_unit(int b,int h,int qb,const bf16*Q,const bf16*__restrict__ K,const bf16*__restrict__ V,bf16*O,const bf16*Z,const unsigned long long*MK,float sl2,int tstart,char*shm){
  int tid_=threadIdx.x; asm volatile("":"+v"(tid_));
  const int tid=tid_,lane=tid&63,r32=lane&31,hi=lane>>5; const int wid=__builtin_amdgcn_readfirstlane(tid>>6);
  const long rowbase=(long)b*SEQ; const int q0=qb*QB;
  const bf16*Qw=Q+(((rowbase+q0+wid*QBLK)>>5)*NHEAD+h)*2048;
  const bf16*Kh=K+(rowbase+(long)tstart*KVBLK)*DM+h*D,*Vh=V+(rowbase+(long)tstart*KVBLK)*DM+h*D;
  const unsigned lds0=(unsigned)(uintptr_t)shm;
  float*wsf=(float*)(shm+LDS_WS)+wid*64;
  const bf16*ksrc=Kh+(long)lane*DM+wid*8;
  const bf16*vsrc=Vh+(long)(16*(wid&3)+(lane>>2))*DM+(wid>>2)*32+(lane&3)*8;
  const unsigned kdst=lds0+LDS_K+wid*1024, vdst=lds0+LDS_V+wid*1024;
  #define DMA_K(t,slot) glds16(ksrc+(long)(t)*KVBLK*DM,(unsigned)__builtin_amdgcn_readfirstlane(kdst+(slot)))
  #define DMA_V(t,slot) glds16(vsrc+(long)(t)*KVBLK*DM,(unsigned)__builtin_amdgcn_readfirstlane(vdst+(slot)))
  const int vb0=(int)(lds0+LDS_V)+((lane>>4)&1)*32+(lane&3)*8+(4*hi+((lane&15)>>2))*64;
  const char*Kbase=shm+LDS_K; bf16x8 kf[8];
  const lds_cptr shm3=(lds_cptr)shm; const lds_cptr kp0=shm3+LDS_K+hi*1024+r32*16; const lds_cptr vp0=shm3+LDS_V+((lane>>4)&1)*32+(lane&3)*8+(4*hi+((lane&15)>>2))*64;
  const int NT=(q0+QB)/KVBLK-tstart;
  const unsigned*msrc=(const unsigned*)(MK+((size_t)(b*64+tstart))*4096+(q0+wid*QBLK+(lane>>1)))+(lane&1);
  const unsigned mdst=lds0+LDS_BYTES+wid*512; const lds_cptr mrd=(lds_cptr)shm+LDS_BYTES+wid*512+r32*8;
  glds4(msrc,(unsigned)__builtin_amdgcn_readfirstlane(mdst)); glds4(msrc+8192,(unsigned)__builtin_amdgcn_readfirstlane(mdst+256));
  DMA_K(0,0);DMA_V(0,0);DMA_K(1,SLOTB);
  bf16x8 qr[4];
  #pragma unroll
  for(int d0=0;d0<4;++d0)qr[d0]=*reinterpret_cast<const bf16x8*>(&Qw[d0*512+lane*8]);
  float mhat=0.f,l_reg=0.f;f32x16 o[2];o[0]=f32x16{};o[1]=f32x16{};
  const int qrel=wid*QBLK+r32;
  float tbias=sl2*(float)(4*hi+64*tstart-(q0+QB-1)); const float sl64=64.f*sl2;
  f32x16 negm; _Pragma("unroll") for(int r=0;r<16;++r)negm[r]=tbias; asm volatile("":"+v"(negm));
  #define NEGM_NEXT() do{ tbias+=sl64; const float nb_=tbias-mhat; _Pragma("unroll") for(int r=0;r<16;++r)negm[r]=nb_; asm volatile("":"+v"(negm)); }while(0)
  #define MLOAD(boff,tt) glds4(msrc+(size_t)8192*(tt),(unsigned)__builtin_amdgcn_readfirstlane(mdst+(boff)))
  #define MWORD(boff) (*(const __attribute__((address_space(3))) unsigned long long*)(mrd+(boff)))
  #define CMASK(P0,P1,boff) kmask(P0,P1,MWORD(boff),sl2,hi)
  bool resc=false;
  #define START(P0,P1) do{ const float rm=rowmax(P0,P1); resc=false; \
    { const float dl=max2f(rm,-16000.f); mhat=fadd_s(mhat,dl); \
      _Pragma("unroll") for(int r=0;r<16;++r){P0[r]=fsub_s(P0[r],dl);P1[r]=fsub_s(P1[r],dl);} } \
    _Pragma("unroll") for(int r=0;r<16;++r)P0[r]=__builtin_amdgcn_exp2f(P0[r]); }while(0)
  #define RESC() do{ if(resc){ asm volatile("s_waitcnt lgkmcnt(0)":::"memory"); \
      _Pragma("unroll") for(int d_=0;d_<2;++d_) _Pragma("unroll") for(int r=0;r<16;++r)o[d_][r]*=wsf[crow(r,hi)]; } }while(0)
  f32x16 pA0,pA1,pB0,pB1;
  int sl_prev=0,sl_cur=0,sl_next=SLOTB;
  #define ROT() do{sl_prev=sl_cur;sl_cur=sl_next;sl_next=(sl_next==(NSLOT-1)*SLOTB)?0:sl_next+SLOTB;}while(0)
  DMA_K(2,2*SLOTB);
  WAIT_BAR(3);
  qkt(pA0,pA1,Kbase,qr,negm,r32,hi);asm volatile("s_nop 15\n\ts_nop 7":"+v"(pA0),"+v"(pA1));CMASK(pA0,pA1,0);
  START(pA0,pA1); NEGM_NEXT();
  _Pragma("unroll") for(int r=0;r<16;++r)pA1[r]=__builtin_amdgcn_exp2f(pA1[r]);
  WAIT_BAR(0);
  DMA_K(3,0);DMA_V(1,SLOTB);
  ROT();
  kload8(kf,kp0+sl_cur);
  WAIT_BAR(2);
  s16x4 vlo[8],vhi[8]; u32x4 pw0,pw1,pw2,pw3;
  #define PKW(P,B) cvtpk_s(P[B],P[B+1])
  #define PAF(k) __builtin_bit_cast(bf16x8,pw##k)
  #define VFR(i) (bf16x8){vlo[i][0],vlo[i][1],vlo[i][2],vlo[i][3],vhi[i][0],vhi[i][1],vhi[i][2],vhi[i][3]}
  #define PIN(x) asm volatile("":"+v"(x))
  #define MX3(a,b,c) __builtin_fmaxf(__builtin_fmaxf((a),(b)),(c))
  #define GAPA(MF,A0,A1,A2,A3,W0,W1,PW) do{ MF; sacc+=A0; sacc+=A1; sacc+=A2; sacc+=A3; PIN(sacc); W0; W1; PIN(PW); SBAR(); }while(0)
  #define EX(v) __builtin_amdgcn_exp2f(v)
  #define GAPB(MF,X,B) do{ MF; X[B]=EX(X[B]); X[B+1]=EX(X[B+1]); X[B+2]=EX(X[B+2]); X[B+3]=EX(X[B+3]); PIN(X); SBAR(); }while(0)
  #define VRD(i) do{ vlo[i]=vtr(vp_+(((i)>>2)*4096+((i)&3)*1024)); vhi[i]=vtr(vp_+(((i)>>2)*4096+((i)&3)*1024+512)); }while(0)
  #define KRD(G,j) do{ if(G){ kload2(kf,kp0+sl_next,j); SBAR(); } }while(0)
  #define STEP(C0,C1,P0,P1,t,GK,GV,GL,MCUR,MNXT,GM) do{ SBAR(); \
    const lds_cptr vp_=vp0+sl_prev; \
    VRD(0); SBAR(); float sacc=(P0[0]+P0[1]); \
    GAPA(C0=__builtin_amdgcn_mfma_f32_32x32x16_bf16(kf[0],qr[0],negm,0,0,0), P0[2],P0[3],P0[4],P0[5],     pw0[0]=PKW(P0,0), pw0[1]=PKW(P0,2), pw0); \
    VRD(4); SBAR(); GAPA(C1=__builtin_amdgcn_mfma_f32_32x32x16_bf16(kf[1],qr[0],negm,0,0,0), P0[6],P0[7],P0[8],P0[9],     pw0[2]=PKW(P0,4), pw0[3]=PKW(P0,6), pw0); \
    VRD(1); SBAR(); GAPA(C0=__builtin_amdgcn_mfma_f32_32x32x16_bf16(kf[2],qr[1],C0,0,0,0),   P0[10],P0[11],P0[12],P0[13], pw1[0]=PKW(P0,8), pw1[1]=PKW(P0,10), pw1); \
    VRD(5); SBAR(); GAPA(C1=__builtin_amdgcn_mfma_f32_32x32x16_bf16(kf[3],qr[1],C1,0,0,0),   P0[14],P0[15],P1[0],P1[1],   pw1[2]=PKW(P0,12),pw1[3]=PKW(P0,14), pw1); \
    VRD(2); SBAR(); GAPA(C0=__builtin_amdgcn_mfma_f32_32x32x16_bf16(kf[4],qr[2],C0,0,0,0),   P1[2],P1[3],P1[4],P1[5],     pw2[0]=PKW(P1,0), pw2[1]=PKW(P1,2), pw2); \
    VRD(6); SBAR(); GAPA(C1=__builtin_amdgcn_mfma_f32_32x32x16_bf16(kf[5],qr[2],C1,0,0,0),   P1[6],P1[7],P1[8],P1[9],     pw2[2]=PKW(P1,4), pw2[3]=PKW(P1,6), pw2); \
    VRD(3); SBAR(); GAPA(C0=__builtin_amdgcn_mfma_f32_32x32x16_bf16(kf[6],qr[3],C0,0,0,0),   P1[10],P1[11],P1[12],P1[13], pw3[0]=PKW(P1,8), pw3[1]=PKW(P1,10), pw3); \
    VRD(7); SBAR(); GAPA(C1=__builtin_amdgcn_mfma_f32_32x32x16_bf16(kf[7],qr[3],C1,0,0,0),   P1[14],P1[15],0.f,0.f,       pw3[2]=PKW(P1,12),pw3[3]=PKW(P1,14), pw3); \
    l_reg+=sacc; \
    if(GM){MLOAD(MNXT,(t)+1);} if(GK){DMA_K((t)+3,sl_cur);} if(GV){DMA_V((t)+1,sl_next);} \
    CMASK(C0,C1,MCUR); \
    { float a=MX3(C0[0],C0[1],C1[0]),b=MX3(C0[2],C0[3],C1[1]); a=MX3(a,C1[2],C1[3]); \
      _Pragma("unroll") for(int r=4;r<16;r+=4){a=MX3(a,C0[r],C0[r+1]);b=MX3(b,C0[r+2],C0[r+3]);a=MX3(a,C1[r],C1[r+1]);b=MX3(b,C1[r+2],C1[r+3]);} \
      float rm=__builtin_fmaxf(a,b); { auto rr=__builtin_amdgcn_permlane32_swap(__float_as_uint(rm),__float_as_uint(rm),false,false); rm=__builtin_fmaxf(__uint_as_float(rr[0]),__uint_as_float(rr[1])); } \
      resc=false; \
      if(__builtin_expect(__any(rm>(float)THRL),0)){ const float dl=__builtin_fmaxf(rm,0.f); mhat+=dl; \
        _Pragma("unroll") for(int r=0;r<16;++r){C0[r]-=dl;C1[r]-=dl;} \
        const float f=__builtin_amdgcn_exp2f(-dl); l_reg*=f; if(hi==0)wsf[r32]=f; resc=true; } } \
    NEGM_NEXT(); \
    SBAR(); \
    GAPB(o[0]=__builtin_amdgcn_mfma_f32_32x32x16_bf16(PAF(0),VFR(0),o[0],0,0,0), C0,0); \
    GAPB(o[1]=__builtin_amdgcn_mfma_f32_32x32x16_bf16(PAF(0),VFR(4),o[1],0,0,0), C0,4); \
    KRD(GL,0); GAPB(o[0]=__builtin_amdgcn_mfma_f32_32x32x16_bf16(PAF(1),VFR(1),o[0],0,0,0), C0,8); \
    KRD(GL,1); GAPB(o[1]=__builtin_amdgcn_mfma_f32_32x32x16_bf16(PAF(1),VFR(5),o[1],0,0,0), C0,12); \
    KRD(GL,2); GAPB(o[0]=__builtin_amdgcn_mfma_f32_32x32x16_bf16(PAF(2),VFR(2),o[0],0,0,0), C1,0); \
    KRD(GL,3); GAPB(o[1]=__builtin_amdgcn_mfma_f32_32x32x16_bf16(PAF(2),VFR(6),o[1],0,0,0), C1,4); \
    GAPB(o[0]=__builtin_amdgcn_mfma_f32_32x32x16_bf16(PAF(3),VFR(3),o[0],0,0,0), C1,8); \
    GAPB(o[1]=__builtin_amdgcn_mfma_f32_32x32x16_bf16(PAF(3),VFR(7),o[1],0,0,0), C1,12); \
    }while(0)
  int t=1;
  for(;t+5<NT;t+=2){
    STEP(pB0,pB1,pA0,pA1,t,true,true,true,256,0,true);     WAIT_BAR(2); RESC(); ROT();
    STEP(pA0,pA1,pB0,pB1,t+1,true,true,true,0,256,true);   WAIT_BAR(2); RESC(); ROT();
  }
  #define ENDW(tt) do{ if((tt)+3<NT){WAIT_BAR(2);} else if((tt)+2<NT){WAIT_BAR(1);} else {WAIT_BAR(0);} }while(0)
  for(;t+1<NT;t+=2){
    STEP(pB0,pB1,pA0,pA1,t,(t+3<NT),(t+1<NT),(t+1<NT),256,0,(t+1<NT));       ENDW(t);   RESC(); ROT();
    STEP(pA0,pA1,pB0,pB1,t+1,(t+4<NT),(t+2<NT),(t+2<NT),0,256,(t+2<NT));     ENDW(t+1); RESC(); ROT();
  }
  STEP(pB0,pB1,pA0,pA1,NT-1,false,false,false,256,0,false); RESC();
  { float sacc=pB0[0]+pB0[1]; _Pragma("unroll") for(int r=2;r<16;++r)sacc+=pB0[r]; _Pragma("unroll") for(int r=0;r<16;++r)sacc+=pB1[r]; l_reg+=sacc;
    pw0=(u32x4){PKW(pB0,0),PKW(pB0,2),PKW(pB0,4),PKW(pB0,6)};pw1=(u32x4){PKW(pB0,8),PKW(pB0,10),PKW(pB0,12),PKW(pB0,14)};pw2=(u32x4){PKW(pB1,0),PKW(pB1,2),PKW(pB1,4),PKW(pB1,6)};pw3=(u32x4){PKW(pB1,8),PKW(pB1,10),PKW(pB1,12),PKW(pB1,14)};
    SBAR(); pv(o,vb0+sl_cur,PAF(0),PAF(1),PAF(2),PAF(3)); }
  #undef PKW
  #undef PAF
  #undef VFR
  #undef PIN
  #undef MX3
  #undef GAPA
  #undef GAPB
  #undef EX
  #undef VRD
  #undef KRD
  #undef STEP
  #undef ENDW
  {auto rr=__builtin_amdgcn_permlane32_swap(__float_as_uint(l_reg),__float_as_uint(l_reg),false,false);l_reg=__uint_as_float(rr[0])+__uint_as_float(rr[1]);}
  if(hi==0)wsf[32+r32]=l_reg;asm volatile("s_waitcnt lgkmcnt(0)":::"memory");
  float rli[16];
  #pragma unroll
  for(int r=0;r<16;++r)rli[r]=__builtin_amdgcn_rcpf(wsf[32+crow(r,hi)]);
  bf16*Ow=O+(rowbase+q0+wid*QBLK)*DM+h*D;
  { bf16*stg=(bf16*)(shm+LDS_OST)+wid*2048;
    #pragma unroll
    for(int r=0;r<16;++r){const int orow=crow(r,hi);
      #pragma unroll
      for(int d0=0;d0<2;++d0)stg[orow*64+d0*32+r32]=__float2bfloat16(o[d0][r]*rli[r]);}
    asm volatile("s_waitcnt lgkmcnt(0)":::"memory");
    const bf16*Zw=Z+(rowbase+q0+wid*QBLK)*DM+h*D;
    #pragma unroll
    for(int i=0;i<4;++i){const int row=i*8+(lane>>3),ch=lane&7; const u32x4 v=*(const u32x4*)(stg+row*64+ch*8); const u32x4 z=*(const u32x4*)(Zw+(long)row*DM+ch*8); u32x4 w;
      #pragma unroll
      for(int e=0;e<4;++e){ const float a0=__uint_as_float(v[e]<<16)*__uint_as_float(z[e]<<16), a1=__uint_as_float(v[e]&0xffff0000u)*__uint_as_float(z[e]&0xffff0000u); w[e]=cvtpk_s(a0,a1); }
      #ifdef ATTN_OUT_FP8
      { float f[8];
        #pragma unroll
        for(int e=0;e<4;++e){ f[2*e]=__builtin_amdgcn_fmed3f(__uint_as_float(w[e]<<16)*(float)(ATTN_OUT_FP8),-448.f,448.f); f[2*e+1]=__builtin_amdgcn_fmed3f(__uint_as_float(w[e]&0xffff0000u)*(float)(ATTN_OUT_FP8),-448.f,448.f); }
        int p0=__builtin_amdgcn_cvt_pk_fp8_f32(f[0],f[1],0,false); p0=__builtin_amdgcn_cvt_pk_fp8_f32(f[2],f[3],p0,true);
        int p1=__builtin_amdgcn_cvt_pk_fp8_f32(f[4],f[5],0,false); p1=__builtin_amdgcn_cvt_pk_fp8_f32(f[6],f[7],p1,true);
        typedef unsigned u32x2_t __attribute__((ext_vector_type(2))); u32x2_t w8={(unsigned)p0,(unsigned)p1};
        *(u32x2_t*)((unsigned char*)O+((rowbase+q0+wid*QBLK+row)*(long)DM+h*D+ch*8))=w8; }
      #else
      ATTN_STORE16(Ow+(long)row*DM+ch*8,w);
      #endif
      } }
  asm volatile("s_waitcnt lgkmcnt(0)\n\ts_barrier":::"memory");
  #undef DMA_K
  #undef DMA_V
  #undef CMASK
  #undef NEGM_NEXT
  #undef MLOAD
  #undef MWORD
  #undef START
  #undef RESC
  #undef ROT
}
constexpr int ATTN_LDS_BYTES=LDS_BYTES;
#undef SBAR
#undef WAIT_BAR
}
__device__ const unsigned char att_order[128] = {127, 111, 126, 110, 125, 109, 95, 94, 93, 124, 108, 92, 123, 107, 91, 122, 106, 90, 121, 105, 89, 120, 104, 88, 119, 103, 87, 79, 78, 77, 76, 75, 74, 73, 72, 71, 118, 102, 86, 70, 117, 101, 85, 69, 116, 100, 84, 68, 63, 62, 61, 60, 59, 58, 57, 56, 55, 54, 53, 52, 115, 99, 83, 67, 51, 114, 98, 82, 66, 50, 47, 46, 45, 44, 43, 42, 41, 40, 39, 38, 37, 36, 35, 34, 113, 97, 81, 65, 49, 33, 31, 30, 29, 28, 27, 26, 25, 24, 23, 22, 21, 20, 19, 18, 17, 15, 14, 13, 12, 11, 10, 9, 8, 7, 6, 5, 4, 3, 2, 1, 112, 96, 80, 64, 48, 32, 16, 0};
#define GAS __attribute__((address_space(1)))
typedef GAS unsigned gu32;
#define RLX_AGENT __ATOMIC_RELAXED, __HIP_MEMORY_SCOPE_AGENT
#define XB_TMO      128
#define XB_XCNT(j)  (256  + 64 * (j))
#define XB_XSUB(j)  (1280 + 64 * (j))
#define XB_XGEN(j)  (2304 + 64 * (j))
#define XB_TOP      3328
#define XB_TOPGEN   3392
#define XCD_BAR_WORDS 3456
#define XB_SPIN_CAP (1u << 18)

__device__ __forceinline__ unsigned xb_ld(unsigned* p)              { return __hip_atomic_load(p, __ATOMIC_RELAXED, __HIP_MEMORY_SCOPE_AGENT); }
__device__ __forceinline__ unsigned xb_add(unsigned* p, unsigned v) { return __hip_atomic_fetch_add(p, v, __ATOMIC_RELAXED, __HIP_MEMORY_SCOPE_AGENT); }
__device__ __forceinline__ unsigned xb_xcc_id() { return (unsigned)__builtin_amdgcn_s_getreg((3 << 11) | 20) & 0xFu; }
#define XB_SPIN(cond, bar) do { unsigned _sp = 0; while (cond) { __builtin_amdgcn_s_sleep(1); \
    if ((++_sp & 255u) == 0u) { if (xb_ld(&(bar)[XB_TMO])) break; if (_sp > XB_SPIN_CAP) { atomicAdd(&(bar)[XB_TMO], 1u); break; } } } } while (0)

struct XcdBarrier {
    unsigned* bar; unsigned x;
    volatile LAS unsigned* st;
};

__device__ __forceinline__ XcdBarrier xcd_barrier_post(unsigned* bar, volatile LAS unsigned* st) {
    XcdBarrier b; b.bar = bar; b.x = xb_xcc_id(); b.st = st;
    if (threadIdx.x == 0) (void)xb_add(&bar[XB_XCNT(b.x)], 1u);
    return b;
}
__device__ __forceinline__ void xcd_barrier_complete(unsigned* bar, unsigned x, unsigned& nloc, unsigned& nx) {
    const unsigned G = gridDim.x * gridDim.y * gridDim.z;
    unsigned sum, cnt, mine, sp = 0u;
    for (;;) {
        sum = 0u; cnt = 0u; mine = 0u;
#pragma unroll
        for (unsigned j = 0; j < 16; ++j) { const unsigned c = xb_ld(&bar[XB_XCNT(j)]); sum += c; cnt += (c > 0u) ? 1u : 0u; mine = (j == x) ? c : mine; }
        if (sum == G) break;
        __builtin_amdgcn_s_sleep(1);
        if ((++sp & 255u) == 0u) { if (xb_ld(&bar[XB_TMO])) break; if (sp > XB_SPIN_CAP) { atomicAdd(&bar[XB_TMO], 1u); break; } }
    }
    nloc = mine > 0u ? mine : 1u; nx = cnt > 0u ? cnt : 1u;
}

__device__ __forceinline__ void xcd_barrier(const XcdBarrier& b) {
    asm volatile("s_waitcnt vmcnt(0)" ::: "memory");
    __syncthreads();
    if (threadIdx.x == 0) {
        unsigned* bar = b.bar;
        __builtin_amdgcn_s_waitcnt(0);
        unsigned nloc = b.st[0], nx = b.st[1];
        if (nloc == 0u) { xcd_barrier_complete(bar, b.x, nloc, nx); b.st[0] = nloc; b.st[1] = nx; }
        const unsigned old = xb_add(&bar[XB_XSUB(b.x)], 1u);
        const unsigned gen = old / nloc;
        if (old + 1u == (gen + 1u) * nloc) {
            __builtin_amdgcn_fence(__ATOMIC_RELEASE, "agent");
            asm volatile("s_waitcnt vmcnt(0)" ::: "memory");
            const unsigned og = xb_add(&bar[XB_TOP], 1u);
            const unsigned tg = og / nx;
            if (og + 1u == (tg + 1u) * nx) xb_add(&bar[XB_TOPGEN], 1u);
            else XB_SPIN(xb_ld(&bar[XB_TOPGEN]) == tg, bar);
            __builtin_amdgcn_fence(__ATOMIC_ACQUIRE, "agent");
            xb_add(&bar[XB_XGEN(b.x)], 1u);
            asm volatile("s_waitcnt vmcnt(0)" ::: "memory");
        } else {
            XB_SPIN(xb_ld(&bar[XB_XGEN(b.x)]) == gen, bar);
            __builtin_amdgcn_fence(__ATOMIC_ACQUIRE, "agent");
            asm volatile("s_waitcnt vmcnt(0)" ::: "memory");
        }
    }
    __syncthreads();
}
#ifndef N_LAUNCH_MODE
#define N_LAUNCH_MODE 1
#endif
namespace cg = cooperative_groups;
#ifndef REPS_HGL
#define REPS_HGL 1
#endif
#ifndef REPS_IDX
#define REPS_IDX 1
#endif
#ifndef REPS_CROSS
#define REPS_CROSS 1
#endif
#ifndef REPS_HGO
#define REPS_HGO 1
#endif
#ifndef G1_NOSTORE
#define G1_NOSTORE 0
#endif
#ifndef REPS_GATE
#define REPS_GATE 1
#endif
#ifndef REPS_P6
#define REPS_P6 1
#endif
#ifndef REPS_BR0
#define REPS_BR0 1
#endif
#ifndef REPS_ATT
#define REPS_ATT 1
#endif
#ifndef REPS_G1F8
#define REPS_G1F8 1
#endif
#ifndef REPS_G1IX
#define REPS_G1IX 1
#endif
#ifndef REPS_P0
#define REPS_P0 1
#endif
#ifdef PROBE_ID
#define PT0(id) do { if ((id) == PROBE_ID) pt0_ = __builtin_amdgcn_s_memrealtime(); } while (0)
#define PT1(id) do { if ((id) == PROBE_ID) pt1_ += __builtin_amdgcn_s_memrealtime() - pt0_; } while (0)
#else
#define PT0(id) do { } while (0)
#define PT1(id) do { } while (0)
#endif
using namespace hy;
struct Args { const float* in[14]; float* out; unsigned char* ws; };
constexpr int NPHASE = 7;

template <int PH> __global__ void __launch_bounds__(512, 2) fwd_kernel(Args args) {
    extern __shared__ __attribute__((aligned(16))) unsigned char lds_raw[];
    unsigned long long pt0_ = 0, pt1_ = 0; (void)pt0_; (void)pt1_;
    Ctx C;
    C.out = args.out; C.ws = args.ws; C.lds = (LAS unsigned char*)lds_raw;
    C.tid = threadIdx.x; C.lane = C.tid & 63; C.wave = __builtin_amdgcn_readfirstlane(C.tid >> 6); C.G = gridDim.x; C.bid = blockIdx.x;
#ifndef PHASE_MASK
#define PHASE_MASK 0x7f
#endif
#define IN(k) (((PHASE_MASK >> (k)) & 1) && (PH < 0 || PH == (k)))
    volatile LAS unsigned* bar_st = (volatile LAS unsigned*)(C.lds + LDS_BYTES - 16);
    if (C.tid < 4) bar_st[C.tid] = 0u;
    __syncthreads();
    XcdBarrier bar = xcd_barrier_post((unsigned*)C.ws + 4096, bar_st);
#define QNEXT(qi, var) do { volatile LAS unsigned* qs_ = (volatile LAS unsigned*)(C.lds + LDS_BYTES - 8); if (C.tid == 0) *qs_ = atomicAdd((unsigned*)(C.ws + 36864) + 64 * (qi), 1u); \
        __syncthreads(); var = *qs_; __syncthreads(); } while (0)
#ifdef DUP_BAR
#define SEAM(k) do { if (IN(k) && IN((k) + 1)) { xcd_barrier(bar); xcd_barrier(bar); } } while (0)
#else
#define SEAM(k) do { if (IN(k) && IN((k) + 1)) { xcd_barrier(bar); } } while (0)
#endif
    bf16_t* LcT = (bf16_t*)((unsigned char*)C.out + OUT_LCT); bf16_t* SinT = (bf16_t*)((unsigned char*)C.out + OUT_SINT); bf16_t* OA = LcT;     float* DEC = (float*)(C.ws + WS_DEC);

    PT0(0);
    if (IN(0)) for (int rep_ = 0; rep_ < REPS_P0; ++rep_) { if (rep_) __syncthreads(); p0_prologue(C, args.in[0], args.in[1], args.in[2], args.in[3], args.in[4], args.in[9], args.in[12], args.in[13], args.in[7]); }
    SEAM(0); PT1(0); PT0(1);
    if (IN(1))
    {
        { pg8::Gemm g{WSP(WS_H8), (const bf16_t*)(C.ws + WS_W8), T, N1 - (IX_HI - IX_LO), DM / 2}; pg8::SkipOrder S; S.so.init(T, N1 - (IX_HI - IX_LO), C.G, C.bid); S.lo = IX_LO / 256; S.skip = (IX_HI - IX_LO) / 256; EpiP1 E{C.ws, args.in[5], args.in[6]};
          PT0(10); for (int rep_ = 0; rep_ < REPS_G1F8; ++rep_) { E.nostore = (rep_ > 0) && G1_NOSTORE; pg8::gemm_phase<EpiP1, pg8::SkipOrder, true, true, true>(C.lds, g, S, E); } PT1(10); }
        { pg8::Gemm g{WSP(WS_H), WSP(WS_WIX), T, IX_HI - IX_LO, DM}; pg8::SkipOrder S; S.so.init(T, IX_HI - IX_LO, C.G, C.bid); S.lo = 0; S.skip = IX_LO / 256; EpiP1 E{C.ws, args.in[5], args.in[6]};
          for (int rep_ = 0; rep_ < REPS_G1IX; ++rep_) pg8::gemm_phase<EpiP1, pg8::SkipOrder, true, true>(C.lds, g, S, E); }
        if (C.G == 256 ? (C.bid >= 128) : true) { const int G2 = (C.G == 256) ? 128 : C.G, c2 = (C.G == 256) ? C.bid - 128 : C.bid;
          { pg8::Gemm g{WSP(WS_HM), WSP(WS_WM), TM, 512, DM}; pg8::StaticOrder S; S.init(TM, 512, G2, c2); EpiPlain<0> E{WSP(WS_MKV), 512};
            pg8::gemm_phase<EpiPlain<0>, pg8::StaticOrder, true, true>(C.lds, g, S, E); }
          { const int c3 = (c2 + G2 - 16) % G2;
            pg8::Gemm g{WSP(WS_WM) + (size_t)512 * DM, WSP(WS_HM), 512, TM, DM}; pg8::StaticOrder S; S.init(512, TM, G2, c3); EpiPlain<0> E{WSP(WS_MKVT), TM};
            pg8::gemm_phase<EpiPlain<0>, pg8::StaticOrder, true, true>(C.lds, g, S, E); } }
    }
    SEAM(1); PT1(1); PT0(2);
    if (IN(2)) {
        const int gw = C.bid * NWAVES + C.wave, NGW = C.G * NWAVES;
        norm_rows_inplace(WSP(WS_MKV), 512, TM, 128, args.in[11], 1.f, gw, NGW, C.lane);
        __syncthreads();
        PT0(12);
        for (int rep_ = 0; rep_ < REPS_HGL; ++rep_)
        { HgIn R; if (C.bid < 2048) { hg_ld16(C, WSP(WS_FB), C.bid, R.fb0, R.fb1); hg_ldiv(C, C.bid, R.iv); }
          for (int u = C.bid; u < 2048; u += C.G) hgrn_local_unit(C, u, (u + C.G < 2048) ? u + C.G : u, R, LcT, DEC, args.in[7]); }
        PT1(12); PT0(13);
        for (int rep_ = 0; rep_ < REPS_IDX; ++rep_)
        for (int i = 0;; ++i) { const int idx = i * C.G + ((i & 1) ? (C.G - 1 - C.bid) : C.bid); if (idx >= 2048) break; indexer_unit(C, idx & 7, 255 - (idx >> 3)); }
    }
    PT1(13); SEAM(2); PT1(2); PT0(3);
    if (IN(3)) {
        PT0(14); hgrn_scan(C, LcT, DEC, SinT); PT1(14); PT0(15);
        for (int rep_ = 0; rep_ < REPS_CROSS; ++rep_)
        for (int u = C.bid; u < 256; u += C.G) cross_unit(C, u >> 5, (u >> 3) & 3, u & 7, args.in[10]);
    }
    PT1(15); SEAM(3); PT1(3); PT0(4);
    if (IN(4)) {
        PT0(16);
        for (int rep_ = 0; rep_ < REPS_ATT; ++rep_)
        for (;;) {
            unsigned ui; QNEXT(rep_, ui);
            if (ui >= 1024u) break;
            const int combo = att_order[ui >> 3], b = ui & 7, h = combo >> 4, qb = combo & 15;
            const float sl2 = ex2(-(float)(h + 1)) * LOG2E;
            int tstart;
            { const float gq = fabsf(args.in[5][C.lane]), gk = fabsf(args.in[6][C.lane]);
              const float A = __uint_as_float(wave_max_dpp(__float_as_uint(gq))) * __uint_as_float(wave_max_dpp(__float_as_uint(gk))) * (64.f * C2A * 1.02f);
              const unsigned lv = wave_max_dpp(C.lane < 16 ? ((const unsigned*)(C.ws + WS_LMINV))[b * 256 + qb * 16 + C.lane] : 0u);
              const float lim = (float)(4095 - (int)lv) - (2.f * A + 32.f) / sl2 + 1.f;
              int ts = lim > 0.f ? ((int)(lim * (1.f / 64.f))) & ~1 : 0; const int ntl = 4 * (qb + 1);
              ts = ts > ntl - 4 ? ntl - 4 : ts; tstart = __builtin_amdgcn_readfirstlane(ts); }
            attn_a::attn_unit<8>(b, h, qb, (const attn_a::bf16*)WSP(WS_QA), (const attn_a::bf16*)WSP(WS_KA), (const attn_a::bf16*)WSP(WS_VA), (attn_a::bf16*)OA, (const attn_a::bf16*)WSP(WS_ZA),
                                 (const unsigned long long*)(C.ws + WS_MASK), sl2, tstart, (char*)lds_raw);
        }
        PT1(16); PT0(17);
        for (int rep_ = 0; rep_ < REPS_HGO; ++rep_)
        { HgOIn R; if (C.bid < 2048) { hg_ld16(C, WSP(WS_FB), C.bid, R.fb0, R.fb1); hg_ld16(C, WSP(WS_QB), C.bid, R.qb0, R.qb1); hg_ldiv(C, C.bid, R.iv); hg_ldsf(C, SinT, C.bid, R.sf); hg_ld16(C, WSP(WS_GB), C.bid, R.gb0, R.gb1); }
          for (int u = C.bid; u < 2048; u += C.G) hgrn_out_unit(C, u, (u + C.G < 2048) ? u + C.G : u, R, SinT, args.in[7], args.in[8]); }
    }
    PT1(17); SEAM(4); PT1(4); PT0(5);
    static_assert(O8_SCALE == (float)(ATTN_OUT_FP8), "attention output scale");
    if (IN(5))
    {
#pragma unroll 1
        for (int n = 0; n < 3; ++n) {
            { pg8::Gemm g{WSP(WS_H8), (const bf16_t*)(C.ws + WS_WG8 + (size_t)n * DM * DM), T, DM, DM / 2}; pg8::StaticOrder S; S.init(T, DM, C.G, C.bid); EpiPlain<1> E{WSP(WS_G), DM};
              PT0(18); for (int rep_ = 0; rep_ < REPS_GATE; ++rep_) pg8::gemm_phase<EpiPlain<1>, pg8::StaticOrder, true, true, true>(C.lds, g, S, E); PT1(18); }
            { const bf16_t* br = (n == 0) ? OA : (n == 1) ? WSP(WS_O8B) : WSP(WS_O8C);
              pg8::Gemm g{br, (const bf16_t*)(C.ws + WS_WB + (size_t)n * DM * 512), T, DM, 256}; pg8::StaticOrder S; S.init(T, DM, C.G, C.bid); PT0(19);
              if (n < 2) { EpiMerge<false> E{WSP(WS_G), WSP(WS_MB), n == 0 ? 1 : 0, nullptr}; for (int rep_ = 0; rep_ < (n == 0 ? REPS_BR0 : 1); ++rep_) pg8::gemm_phase<EpiMerge<false>, pg8::StaticOrder, true, true, true>(C.lds, g, S, E); }
              else { EpiMerge<true> E{WSP(WS_G), WSP(WS_MB), 0, C.ws + WS_M8}; pg8::gemm_phase<EpiMerge<true>, pg8::StaticOrder, true, true, true>(C.lds, g, S, E); } PT1(19); }
        }
    }
    SEAM(5); PT1(5); PT0(6);
    if (IN(6))
    {
        pg8::Gemm g{WSP(WS_M8), WSP(WS_WO), T, DM, DM / 2}; pg8::StaticOrder S; S.init(T, DM, C.G, C.bid); EpiOut E{args.in[0], C.out};
        for (int rep_ = 0; rep_ < REPS_P6; ++rep_) pg8::gemm_phase<EpiOut, pg8::StaticOrder, true, true, true>(C.lds, g, S, E);
    }
    PT1(6);
#ifdef PROBE_ID
    if (blockIdx.x == 0 && threadIdx.x == 0) { const unsigned long long te_ = __builtin_amdgcn_s_memrealtime(), d_ = pt1_; while (__builtin_amdgcn_s_memrealtime() - te_ < d_) __builtin_amdgcn_s_sleep(8); }
#endif
#undef IN
#undef SEAM
}

extern "C" void kernel_launch(void* const* d_in, const int* in_sizes, int n_in, void* d_out, int out_size, void* d_ws, size_t ws_size, hipStream_t stream) {
    static int grid = 0;
    if (grid == 0) {
        if (n_in != 14 || out_size != T * DM || ws_size < WS_END) { fprintf(stderr, "kernel_launch: unexpected problem shape (n_in %d out %d ws %zu)\n", n_in, out_size, ws_size); grid = -1; return; }
        int dev = 0, cus = 0, per_cu = 0;
        hipGetDevice(&dev); hipDeviceGetAttribute(&cus, hipDeviceAttributeMultiprocessorCount, dev);
#if N_LAUNCH_MODE == 1
        if (hipFuncSetAttribute((const void*)fwd_kernel<-1>, hipFuncAttributeMaxDynamicSharedMemorySize, LDS_BYTES) != hipSuccess) { fprintf(stderr, "kernel_launch: hipFuncSetAttribute failed\n"); grid = -1; return; }
        hipOccupancyMaxActiveBlocksPerMultiprocessor(&per_cu, (const void*)fwd_kernel<-1>, NTHR, LDS_BYTES);
        (void)hipGetLastError();
#endif
        if (per_cu < 1) per_cu = 1;
        grid = cus;
    }
    if (grid < 0) return;
    if (hipMemsetAsync(d_ws, 0, 65536, stream) != hipSuccess) { fprintf(stderr, "kernel_launch: hipMemsetAsync failed\n"); return; }
    Args a{};
    for (int i = 0; i < 14; ++i) a.in[i] = (const float*)d_in[i];
    a.out = (float*)d_out; a.ws = (unsigned char*)d_ws;
#if N_LAUNCH_MODE == 1
    void* kargs[] = {&a};
#ifdef HOST_TWICE
    (void)hipLaunchCooperativeKernel((const void*)fwd_kernel<-1>, dim3(grid), dim3(NTHR), kargs, LDS_BYTES, stream);
    (void)hipMemsetAsync(d_ws, 0, 65536, stream);
#endif
    hipError_t e = hipLaunchCooperativeKernel((const void*)fwd_kernel<-1>, dim3(grid), dim3(NTHR), kargs, LDS_BYTES, stream);
    if (e != hipSuccess) fprintf(stderr, "kernel_launch: cooperative launch failed: %s (grid %d)\n", hipGetErrorString(e), grid);
#else
#define LAUNCH_PH(p) do { (void)hipFuncSetAttribute((const void*)fwd_kernel<p>, hipFuncAttributeMaxDynamicSharedMemorySize, LDS_BYTES); hipLaunchKernelGGL(fwd_kernel<p>, dim3(grid), dim3(NTHR), LDS_BYTES, stream, a); } while (0)
    LAUNCH_PH(0); LAUNCH_PH(1); LAUNCH_PH(2); LAUNCH_PH(3); LAUNCH_PH(4); LAUNCH_PH(5); LAUNCH_PH(6);
#endif
}
```

```cpp
#include <hip/hip_runtime.h>
#include <hip/hip_cooperative_groups.h>
#include <cstdio>
#include <cstdint>
#define N_LAUNCH_MODE 1
namespace pg8 {
#define PG8_LAS __attribute__((address_space(3)))
typedef unsigned short bf16_t;
typedef short bf16x8 __attribute__((ext_vector_type(8)));
typedef float f32x4 __attribute__((ext_vector_type(4)));
typedef unsigned u32x4 __attribute__((ext_vector_type(4)));
constexpr int BM = 256, BK = 64, HALF = 128, HTB = HALF * BK * 2  , STAGE_BYTES = 8 * HTB, NXCD = 8, WGM = 8;

__host__ __device__ __forceinline__ int lds_byte(int r, int c) { const int st = (r >> 4) * 2 + (c >> 5), rr = r & 15, cc = c & 31, ob = rr * 64 + cc * 2; return st * 1024 + (ob ^ (((ob >> 9) & 1) << 5)); }
__host__ __device__ __forceinline__ void stage_rc(int b, int& R, int& C) { const int st = b / 1024, sb = b % 1024, swz = sb ^ (((sb >> 9) & 1) << 5); R = (st >> 1) * 16 + swz / 64; C = (st & 1) * 32 + (swz % 64) / 2; }
__host__ __device__ __forceinline__ int perm32(int rho) { const int n = rho >> 4, i = rho & 15; return 8 * (i >> 2) + 4 * n + (i & 3); }

struct Unit { int pm, pn, n; };
struct Gemm { const bf16_t* A; const bf16_t* Bt; int M, N, K; int nodma = 0; int K2 = 0; };
constexpr float F8_DESCALE = 1.f / 256.f;
template <class E, class = void> struct epi_self_descale { static constexpr bool value = false; };
template <class E> struct epi_self_descale<E, decltype((void)E::SELF_DESCALE)> { static constexpr bool value = E::SELF_DESCALE; };

struct StaticOrder {
    int nM, nN, nwg, G, c;
    __host__ __device__ void init(int M, int N, int G_, int c_) { nM = M / BM; nN = N / BM; nwg = nM * nN; G = G_; c = c_; }
    __host__ __device__ bool next(int i, Unit& u) const {
        const long L = (long)i * G + c; if (L >= nwg) return false;
        int wgid = (int)L; { const int q = nwg / NXCD, r = nwg % NXCD, xcd = wgid % NXCD, off = wgid / NXCD; wgid = (xcd < r ? xcd * (q + 1) : r * (q + 1) + (xcd - r) * q) + off; }
        const int nig = WGM * nN, gid = wgid / nig, fm = gid * WGM, gsz = (nM - fm) < WGM ? (nM - fm) : WGM;
        u.pm = fm + ((wgid % nig) % gsz); u.pn = (wgid % nig) / gsz; u.n = 0; return true;
    }
    __device__ __forceinline__ const char* abase(const Gemm& g, const Unit&) const { return (const char*)g.A; }
    __device__ __forceinline__ const char* bbase(const Gemm& g, const Unit&) const { return (const char*)g.Bt; }
    __device__ __forceinline__ void a_ready(const Unit&) const {}
    __device__ __forceinline__ void done(const Unit&) const {}
};

struct SkipOrder {
    StaticOrder so; int lo, skip;
    __host__ __device__ bool next(int i, Unit& u) const { if (!so.next(i, u)) return false; if (u.pn >= lo) u.pn += skip; return true; }
    __device__ __forceinline__ const char* abase(const Gemm& g, const Unit&) const { return (const char*)g.A; }
    __device__ __forceinline__ const char* bbase(const Gemm& g, const Unit&) const { return (const char*)g.Bt; }
    __device__ __forceinline__ void a_ready(const Unit&) const {}
    __device__ __forceinline__ void done(const Unit&) const {}
};

struct P5Order {
    StaticOrder so; int Rc;
    const char* base; long a_gate, a_b0, a_b1, a_b2, b_gate, b_br, sb_gate, sb_br;
    __host__ __device__ void init(int M, int N, int G, int c) { so.init(M, N, G, c); Rc = (so.nwg - c + G - 1) / G; if (Rc < 0) Rc = 0; }
    __host__ __device__ bool next(int i, Unit& u) const { const int per = 2 * Rc; if (per == 0) return false; const int n = i / per, q = i - n * per; if (n >= 3) return false;
#ifdef P5_ALT
        const int kind = q & 1; (void)so.next(q >> 1, u); u.n = 2 * n + kind; return true; }
#else
        const int kind = q >= Rc ? 1 : 0; (void)so.next(q - kind * Rc, u); u.n = 2 * n + kind; return true; }
#endif
    __device__ __forceinline__ int kclass(const Unit& u) const { return u.n & 1; }
    __device__ __forceinline__ const char* abase(const Gemm&, const Unit& u) const { const long k = -(long)(u.n & 1), m1 = -(long)((u.n >> 1) == 1), m2 = -(long)((u.n >> 1) == 2);
        return base + ((~k & a_gate) | (k & (a_b0 + ((a_b1 - a_b0) & m1) + ((a_b2 - a_b0) & m2)))); }
    __device__ __forceinline__ const char* bbase(const Gemm&, const Unit& u) const { const long k = -(long)(u.n & 1), n = u.n >> 1; return base + ((~k & (b_gate + n * sb_gate)) | (k & (b_br + n * sb_br))); }
    __device__ __forceinline__ void a_ready(const Unit&) const {}
    __device__ __forceinline__ void done(const Unit&) const {}
};

struct MergeOrder {
    StaticOrder so; const char* a0; const char* b0; long da1, da2, db1, db2;
    __host__ __device__ bool next(int i, Unit& u) const { const int t = i / 3; if (!so.next(t, u)) return false; u.n = i - 3 * t; return true; }
    __device__ __forceinline__ const char* abase(const Gemm&, const Unit& u) const { const long m1 = -(long)(u.n == 1), m2 = -(long)(u.n == 2); return a0 + ((da1 & m1) | (da2 & m2)); }
    __device__ __forceinline__ const char* bbase(const Gemm&, const Unit& u) const { const long m1 = -(long)(u.n == 1), m2 = -(long)(u.n == 2); return b0 + ((db1 & m1) | (db2 & m2)); }
    __device__ __forceinline__ void a_ready(const Unit&) const {}
    __device__ __forceinline__ void done(const Unit&) const {}
};

__device__ __forceinline__ unsigned cvt_pk_bf16(float lo, float hi) { unsigned r; asm volatile("v_cvt_pk_bf16_f32 %0, %1, %2" : "=v"(r) : "v"(lo), "v"(hi)); return r; }
typedef float f32x2 __attribute__((ext_vector_type(2)));
__device__ __forceinline__ f32x2 gelu_pk(f32x2 v) {
    const f32x2 av = __builtin_elementwise_abs(v), d = av * 0.2316418882f + 1.0f;
    f32x2 t; t.x = __builtin_amdgcn_rcpf(d.x); t.y = __builtin_amdgcn_rcpf(d.y);
    f32x2 q = t * 0.5307027145f + (-0.7265760135f); q = q * t + 0.7107068705f; q = q * t + (-0.142248368f); q = q * t + 0.127414796f; q = q * t;
    const f32x2 s = (v * v) * (-0.72134752044f);
    f32x2 e; e.x = __builtin_amdgcn_exp2f(s.x); e.y = __builtin_amdgcn_exp2f(s.y);
    const f32x2 m = v * (q * e), r = v - m;
    f32x2 o; o.x = v.x < 0.f ? m.x : r.x; o.y = v.y < 0.f ? m.y : r.y; return o;
}

template <int ACT  > struct EpiBf16 {
    static constexpr bool PERM = true, AFTER_DRAIN = false; static_assert(ACT == 0 || ACT == 1, "EpiBf16: ACT is 0 (none) or 1 (gelu_pk)");
    bf16_t* O; int ldc; const float* bias; int split_cols; size_t split_stride; float scale0;
    __device__ __forceinline__ void operator()(const f32x4 (&acc)[2][2][4][2], const Unit& u, int wr, int wc, int fr, int fq) const {
        const int row0 = u.pm * BM + wr * 64 + fr; int colt = u.pn * BM; bf16_t* base = O;
        float sc = 1.f; if (split_cols) { const int t = colt / split_cols; base += (size_t)t * split_stride; colt -= t * split_cols; if (t == 0) sc = scale0; }
        const int col0 = colt + wc * 32 + 8 * fq, bcol0 = u.pn * BM + wc * 32 + 8 * fq;
        f32x4 bv[2][2];
#pragma unroll
        for (int bj = 0; bj < 2; ++bj)
#pragma unroll
            for (int n = 0; n < 2; ++n) bv[bj][n] = bias ? *(const f32x4*)(bias + bcol0 + bj * HALF + 4 * n) : (f32x4){0.f, 0.f, 0.f, 0.f};
#pragma unroll
        for (int ai = 0; ai < 2; ++ai)
#pragma unroll
            for (int m = 0; m < 4; ++m) { bf16_t* rowp = base + (size_t)(row0 + ai * HALF + m * 16) * ldc + col0;
#pragma unroll
                for (int bj = 0; bj < 2; ++bj) { f32x4 v0 = acc[ai][bj][m][0] + bv[bj][0], v1 = acc[ai][bj][m][1] + bv[bj][1];
                    if (ACT == 1) { f32x2 a = gelu_pk((f32x2){v0[0], v0[1]}), b = gelu_pk((f32x2){v0[2], v0[3]}), c = gelu_pk((f32x2){v1[0], v1[1]}), d = gelu_pk((f32x2){v1[2], v1[3]});
                        v0 = (f32x4){a.x, a.y, b.x, b.y}; v1 = (f32x4){c.x, c.y, d.x, d.y}; }
                    v0 = v0 * sc; v1 = v1 * sc; u32x4 w; w.x = cvt_pk_bf16(v0[0], v0[1]); w.y = cvt_pk_bf16(v0[2], v0[3]); w.z = cvt_pk_bf16(v1[0], v1[1]); w.w = cvt_pk_bf16(v1[2], v1[3]);
                    *(u32x4*)(rowp + bj * HALF) = w; } }
    }
};
typedef int pg8_v8i __attribute__((ext_vector_type(8))); typedef int pg8_v4i __attribute__((ext_vector_type(4)));
__device__ __forceinline__ pg8_v8i pg8_cat(bf16x8 lo, bf16x8 hi) { const pg8_v4i a = __builtin_bit_cast(pg8_v4i, lo), b = __builtin_bit_cast(pg8_v4i, hi); return __builtin_shufflevector(a, b, 0, 1, 2, 3, 4, 5, 6, 7); }
template <class Epi, class Sched, bool ALIGN_EPI = false, bool SP2 = false, bool F8 = false, int PROBE_NODMA = 0, bool DUALK = false>
__device__ __forceinline__ void gemm_phase(PG8_LAS unsigned char* lds, const Gemm g, const Sched& S, const Epi& E) {
    int tid_ = threadIdx.x; asm volatile("" : "+v"(tid_));
    const int tid = tid_, wid = __builtin_amdgcn_readfirstlane(tid >> 6), lane = tid & 63, wr = wid >> 2, wc = wid & 3, fr = lane & 15, fq = lane >> 4;
    static_assert(!DUALK || SP2, "DUALK needs the SP2 loop");
    const int K = g.K, K1 = DUALK ? g.K2 : g.K, nt0 = K / BK, nt1 = K1 / BK; const bool nodma_ = g.nodma != 0; (void)nodma_;
    unsigned voffA0, voffB0, voffA1, voffB1;
    { int R, C; stage_rc(tid * 16, R, C); const int Rb = Epi::PERM ? ((R & ~31) + perm32(R & 31)) : R;
        voffA0 = (unsigned)(R * K + C) * 2u; voffB0 = (unsigned)(Rb * K + C) * 2u; voffA1 = (unsigned)(R * K1 + C) * 2u; voffB1 = (unsigned)(Rb * K1 + C) * 2u; }
    const size_t kstep = (size_t)(BK * 2);
    const size_t rstep0 = (size_t)64 * K * 2, rstep1 = (size_t)64 * K1 * 2;
    const size_t hstep0 = (size_t)HALF * K * 2, hstep1 = (size_t)HALF * K1 * 2;
    const size_t tstep0 = 2 * hstep0, tstep1 = 2 * hstep1;
#define PG8_SEL(c, x0, x1) ((DUALK && (c)) ? (x1) : (x0))
    const unsigned ldsw = (unsigned)wid * 1024u;
    const int aoff = lds_byte(wr * 64 + fr, F8 ? fq * 16 : fq * 8), boff = lds_byte(wc * 32 + fr, F8 ? fq * 16 : fq * 8);
    constexpr int KOFF = F8 ? 16 : 1024;
#define PG8_SA(b, h) (((b) * 2 + (h)) * HTB)
#define PG8_SB(b, h) ((4 + (b) * 2 + (h)) * HTB)
#define PG8_STAGE(bufoff, gbase, voff, rstep_) do { if (PROBE_NODMA >= 1 && nodma_) break; _Pragma("unroll") for (int _i = 0; _i < 2; ++_i) \
        __builtin_amdgcn_global_load_lds((const unsigned*)((const char*)(gbase) + _i * (rstep_) + (voff)), (PG8_LAS unsigned*)(lds + (bufoff) + ldsw + _i * 8192), 16, 0, 0); } while (0)
#define PG8_LDA(dst, b, h) do { if (PROBE_NODMA >= 2 && nodma_) break; _Pragma("unroll") for (int m = 0; m < 4; ++m) _Pragma("unroll") for (int k = 0; k < 2; ++k) dst[m][k] = *(const PG8_LAS bf16x8*)(lds + PG8_SA(b, h) + aoff + m * 2048 + k * KOFF); } while (0)
#define PG8_LDB(dst, b, h) do { if (PROBE_NODMA >= 2 && nodma_) break; _Pragma("unroll") for (int n = 0; n < 2; ++n) _Pragma("unroll") for (int k = 0; k < 2; ++k) dst[n][k] = *(const PG8_LAS bf16x8*)(lds + PG8_SB(b, h) + boff + n * 2048 + k * KOFF); } while (0)
#define PG8_MMA(ai, bj, At, Bt) do { __builtin_amdgcn_s_setprio(1); \
        if constexpr (F8) { _Pragma("unroll") for (int m = 0; m < 4; ++m) _Pragma("unroll") for (int n = 0; n < 2; ++n) \
            acc[ai][bj][m][n] = __builtin_amdgcn_mfma_scale_f32_16x16x128_f8f6f4(pg8_cat(Bt[n][0], Bt[n][1]), pg8_cat(At[m][0], At[m][1]), acc[ai][bj][m][n], 0, 0, 0, 0, 0, 0);   \
            _Pragma("unroll") for (int m = 0; m < 4; ++m) _Pragma("unroll") for (int n = 0; n < 2; ++n) asm volatile("" : "+v"(acc[ai][bj][m][n]));   } \
        else { _Pragma("unroll") for (int m = 0; m < 4; ++m) _Pragma("unroll") for (int n = 0; n < 2; ++n) _Pragma("unroll") for (int k = 0; k < 2; ++k) \
            acc[ai][bj][m][n] = __builtin_amdgcn_mfma_f32_16x16x32_bf16(Bt[n][k], At[m][k], acc[ai][bj][m][n], 0, 0, 0); } \
        __builtin_amdgcn_s_setprio(0); } while (0)
#define PG8_MMAH(ai, bj, At, Bt, m0) do { _Pragma("unroll") for (int m = (m0); m < (m0) + 2; ++m) _Pragma("unroll") for (int n = 0; n < 2; ++n) \
            acc[ai][bj][m][n] = __builtin_amdgcn_mfma_scale_f32_16x16x128_f8f6f4(pg8_cat(Bt[n][0], Bt[n][1]), pg8_cat(At[m][0], At[m][1]), acc[ai][bj][m][n], 0, 0, 0, 0, 0, 0); \
            _Pragma("unroll") for (int m = (m0); m < (m0) + 2; ++m) _Pragma("unroll") for (int n = 0; n < 2; ++n) asm volatile("" : "+v"(acc[ai][bj][m][n])); } while (0)
#ifndef F8_ILV
#define F8_ILV 0
#endif
#define PG8_WAIT_V(n) asm volatile("s_waitcnt vmcnt(" #n ")" ::: "memory")
#define PG8_WAIT_L(n) asm volatile("s_waitcnt lgkmcnt(" #n ")" ::: "memory")
#define PG8_BAR __builtin_amdgcn_s_barrier()
#define PG8_SCHED __builtin_amdgcn_sched_barrier(0)
    Unit cur, nxt; int ui = 0;
    if (!S.next(0, cur)) return;
    f32x4 acc[2][2][4][2];
#pragma unroll
    for (int a = 0; a < 2; ++a)
#pragma unroll
        for (int b = 0; b < 2; ++b)
#pragma unroll
            for (int m = 0; m < 4; ++m)
#pragma unroll
                for (int n = 0; n < 2; ++n) acc[a][b][m][n] = (f32x4){0.f, 0.f, 0.f, 0.f};
    bf16x8 At[4][2], B0[2][2], B1[2][2];
    int cc = 0; if constexpr (DUALK) cc = S.kclass(cur);
    const char* cA = S.abase(g, cur) + (size_t)cur.pm * PG8_SEL(cc, tstep0, tstep1); const char* cB = S.bbase(g, cur) + (size_t)cur.pn * PG8_SEL(cc, tstep0, tstep1);
    unsigned voffA = PG8_SEL(cc, voffA0, voffA1), voffB = PG8_SEL(cc, voffB0, voffB1); size_t hstep = PG8_SEL(cc, hstep0, hstep1), rstep = PG8_SEL(cc, rstep0, rstep1); int nt = PG8_SEL(cc, nt0, nt1);
    S.a_ready(cur);
    if constexpr (SP2) {
        PG8_STAGE(PG8_SB(0, 0), cB, voffB, rstep); PG8_STAGE(PG8_SB(0, 1), cB + hstep, voffB, rstep); PG8_STAGE(PG8_SA(0, 0), cA, voffA, rstep); PG8_STAGE(PG8_SA(0, 1), cA + hstep, voffA, rstep);
        if (wr == 1) PG8_BAR;
        PG8_WAIT_V(2); PG8_BAR;
        PG8_STAGE(PG8_SB(1, 0), cB + kstep, voffB, rstep); PG8_STAGE(PG8_SA(1, 0), cA + kstep, voffA, rstep); PG8_STAGE(PG8_SB(1, 1), cB + hstep + kstep, voffB, rstep);
        PG8_WAIT_V(6); PG8_BAR;
    } else {
        PG8_STAGE(PG8_SB(0, 0), cB, voffB, rstep); PG8_STAGE(PG8_SA(0, 0), cA, voffA, rstep); PG8_STAGE(PG8_SB(0, 1), cB + hstep, voffB, rstep); PG8_STAGE(PG8_SA(0, 1), cA + hstep, voffA, rstep);
        if (wr == 1) PG8_BAR;
        PG8_WAIT_V(4); PG8_BAR;
        PG8_STAGE(PG8_SB(1, 0), cB + kstep, voffB, rstep); PG8_STAGE(PG8_SA(1, 0), cA + kstep, voffA, rstep); PG8_STAGE(PG8_SB(1, 1), cB + hstep + kstep, voffB, rstep);
        PG8_WAIT_V(6); PG8_BAR;
    }
    for (;;) {
        const bool has_next = S.next(ui + 1, nxt);
        int cn = cc; if constexpr (DUALK) { if (has_next) cn = S.kclass(nxt); }
        const char* nA = has_next ? S.abase(g, nxt) + (size_t)nxt.pm * PG8_SEL(cn, tstep0, tstep1) : cA; const char* nB = has_next ? S.bbase(g, nxt) + (size_t)nxt.pn * PG8_SEL(cn, tstep0, tstep1) : cB;
#pragma unroll 1
        for (int t = 0; t < nt; t += 2) {
            const bool last = (t == nt - 2);
            const char* a1 = cA + (size_t)(t + 1) * kstep;
            const char* a2 = last ? nA : cA + (size_t)(t + 2) * kstep; const char* b2 = last ? nB : cB + (size_t)(t + 2) * kstep;
            const char* a3 = a2 + kstep; const char* b3 = b2 + kstep;
            const unsigned voffA2 = last ? PG8_SEL(cn, voffA0, voffA1) : voffA, voffB2 = last ? PG8_SEL(cn, voffB0, voffB1) : voffB;
            const size_t hstep2 = last ? PG8_SEL(cn, hstep0, hstep1) : hstep, rstep2 = last ? PG8_SEL(cn, rstep0, rstep1) : rstep; (void)voffA2; (void)voffB2; (void)hstep2; (void)rstep2;
            if (last && has_next) S.a_ready(nxt);
            if constexpr (SP2) {
            PG8_LDB(B0, 0, 0); PG8_LDB(B1, 0, 1); PG8_SCHED; PG8_LDA(At, 0, 0); PG8_STAGE(PG8_SA(1, 1), a1 + hstep, voffA, rstep);
            PG8_WAIT_V(8); PG8_WAIT_L(0); PG8_BAR; PG8_MMA(0, 0, At, B0); PG8_MMA(0, 1, At, B1); PG8_BAR; PG8_SCHED;
            if constexpr (F8 && F8_ILV) {
            PG8_LDA(At, 0, 1); PG8_WAIT_V(2); PG8_WAIT_L(0); PG8_BAR; __builtin_amdgcn_s_setprio(1);
            PG8_MMAH(1, 0, At, B0, 0); PG8_STAGE(PG8_SB(0, 0), b2, voffB2, rstep2); PG8_MMAH(1, 0, At, B0, 2); PG8_STAGE(PG8_SB(0, 1), b2 + hstep2, voffB2, rstep2);
            PG8_MMAH(1, 1, At, B1, 0); PG8_STAGE(PG8_SA(0, 0), a2, voffA2, rstep2); PG8_MMAH(1, 1, At, B1, 2); __builtin_amdgcn_s_setprio(0); PG8_BAR; PG8_SCHED;
            } else {
            PG8_LDA(At, 0, 1); PG8_STAGE(PG8_SB(0, 0), b2, voffB2, rstep2); PG8_STAGE(PG8_SB(0, 1), b2 + hstep2, voffB2, rstep2); PG8_STAGE(PG8_SA(0, 0), a2, voffA2, rstep2);
            PG8_WAIT_V(8); PG8_WAIT_L(0); PG8_BAR; PG8_MMA(1, 0, At, B0); PG8_MMA(1, 1, At, B1); PG8_BAR; PG8_SCHED; }
            PG8_LDB(B0, 1, 0); PG8_LDB(B1, 1, 1); PG8_SCHED; PG8_LDA(At, 1, 0); PG8_STAGE(PG8_SA(0, 1), a2 + hstep2, voffA2, rstep2);
            PG8_WAIT_V(8); PG8_WAIT_L(0); PG8_BAR; PG8_MMA(0, 0, At, B0); PG8_MMA(0, 1, At, B1); PG8_BAR; PG8_SCHED;
            if constexpr (F8 && F8_ILV) {
            PG8_LDA(At, 1, 1); PG8_WAIT_V(2); PG8_WAIT_L(0); PG8_BAR; __builtin_amdgcn_s_setprio(1);
            PG8_MMAH(1, 0, At, B0, 0); PG8_STAGE(PG8_SB(1, 0), b3, voffB2, rstep2); PG8_MMAH(1, 0, At, B0, 2); PG8_STAGE(PG8_SB(1, 1), b3 + hstep2, voffB2, rstep2);
            PG8_MMAH(1, 1, At, B1, 0); PG8_STAGE(PG8_SA(1, 0), a3, voffA2, rstep2); PG8_MMAH(1, 1, At, B1, 2); __builtin_amdgcn_s_setprio(0); PG8_BAR; PG8_SCHED;
            } else {
            PG8_LDA(At, 1, 1); PG8_STAGE(PG8_SB(1, 0), b3, voffB2, rstep2); PG8_STAGE(PG8_SB(1, 1), b3 + hstep2, voffB2, rstep2); PG8_STAGE(PG8_SA(1, 0), a3, voffA2, rstep2);
            PG8_WAIT_V(8); PG8_WAIT_L(0); PG8_BAR; PG8_MMA(1, 0, At, B0); PG8_MMA(1, 1, At, B1); PG8_BAR; PG8_SCHED; }
            } else {
            PG8_LDB(B0, 0, 0); PG8_SCHED; PG8_LDA(At, 0, 0); PG8_STAGE(PG8_SA(1, 1), a1 + hstep, voffA, rstep);
            PG8_WAIT_L(8); PG8_BAR; PG8_WAIT_L(0); PG8_MMA(0, 0, At, B0); PG8_BAR; PG8_SCHED;
            PG8_LDB(B1, 0, 1); PG8_STAGE(PG8_SB(0, 0), b2, voffB, rstep);
            PG8_BAR; PG8_WAIT_L(0); PG8_MMA(0, 1, At, B1); PG8_BAR;
            PG8_LDA(At, 0, 1); PG8_STAGE(PG8_SA(0, 0), a2, voffA, rstep);
            PG8_BAR; PG8_WAIT_L(0); PG8_MMA(1, 0, At, B0); PG8_BAR; PG8_SCHED;
            PG8_STAGE(PG8_SB(0, 1), b2 + hstep, voffB, rstep);
            PG8_WAIT_V(6); PG8_BAR; PG8_MMA(1, 1, At, B1); PG8_BAR;
            PG8_LDB(B0, 1, 0); PG8_SCHED; PG8_LDA(At, 1, 0); PG8_STAGE(PG8_SA(0, 1), a2 + hstep, voffA, rstep);
            PG8_WAIT_L(8); PG8_BAR; PG8_WAIT_L(0); PG8_MMA(0, 0, At, B0); PG8_BAR; PG8_SCHED;
            PG8_LDB(B1, 1, 1); PG8_STAGE(PG8_SB(1, 0), b3, voffB, rstep);
            PG8_BAR; PG8_WAIT_L(0); PG8_MMA(0, 1, At, B1); PG8_BAR;
            PG8_LDA(At, 1, 1); PG8_STAGE(PG8_SA(1, 0), a3, voffA, rstep);
            PG8_BAR; PG8_WAIT_L(0); PG8_MMA(1, 0, At, B0); PG8_BAR; PG8_SCHED;
            PG8_STAGE(PG8_SB(1, 1), b3 + hstep, voffB, rstep);
            PG8_WAIT_V(6); PG8_BAR; PG8_MMA(1, 1, At, B1); PG8_BAR;
            }
        }
        if constexpr (ALIGN_EPI) { if (wr == 0) PG8_BAR; }
        static_assert(F8 || !epi_self_descale<Epi>::value, "a self-descaling epilogue needs the fp8 body");
        if constexpr (F8 && !epi_self_descale<Epi>::value) {
#pragma unroll
            for (int a = 0; a < 2; ++a)
#pragma unroll
                for (int b = 0; b < 2; ++b)
#pragma unroll
                    for (int m = 0; m < 4; ++m)
#pragma unroll
                        for (int n = 0; n < 2; ++n) acc[a][b][m][n] = acc[a][b][m][n] * F8_DESCALE;
        }
        if constexpr (!Epi::AFTER_DRAIN) { int tl = threadIdx.x; asm volatile("" : "+v"(tl));
            E(acc, cur, wr, wc, tl & 15, (tl >> 4) & 3); S.done(cur); }
        if (!has_next) break;
#pragma unroll
        for (int a = 0; a < 2; ++a)
#pragma unroll
            for (int b = 0; b < 2; ++b)
#pragma unroll
                for (int m = 0; m < 4; ++m)
#pragma unroll
                    for (int n = 0; n < 2; ++n) acc[a][b][m][n] = (f32x4){0.f, 0.f, 0.f, 0.f};
        cur = nxt; cA = nA; cB = nB; ++ui;
        if constexpr (DUALK) { cc = cn; voffA = PG8_SEL(cc, voffA0, voffA1); voffB = PG8_SEL(cc, voffB0, voffB1); hstep = PG8_SEL(cc, hstep0, hstep1); rstep = PG8_SEL(cc, rstep0, rstep1); nt = PG8_SEL(cc, nt0, nt1); }
        if constexpr (ALIGN_EPI) { if (wr == 1) PG8_BAR; }
    }
    PG8_WAIT_V(0);
    if constexpr (!ALIGN_EPI) { if (wr == 0) PG8_BAR; }
    PG8_BAR;
    if constexpr (Epi::AFTER_DRAIN) { E.fused(acc, cur, wr, wc, fr, fq, lds, wid, lane); S.done(cur); }
#undef PG8_SEL
#undef PG8_SA
#undef PG8_SB
#undef PG8_STAGE
#undef PG8_LDA
#undef PG8_LDB
#undef PG8_MMA
#undef PG8_MMAH
#undef PG8_WAIT_V
#undef PG8_WAIT_L
#undef PG8_BAR
#undef PG8_SCHED
}
}
namespace hy {
#define LAS __attribute__((address_space(3)))
typedef unsigned short bf16_t;
typedef short bf16x8 __attribute__((ext_vector_type(8)));
typedef float f32x4 __attribute__((ext_vector_type(4)));
typedef float f32x16 __attribute__((ext_vector_type(16)));
typedef unsigned u32x4 __attribute__((ext_vector_type(4)));
typedef unsigned u32x2 __attribute__((ext_vector_type(2)));

constexpr int BATCH = 8, SEQ = 4096, DM = 1024, T = BATCH * SEQ, MEMLEN = 256, TM = BATCH * MEMLEN;
constexpr int NSRC = 8776, N1 = 5888, NALL = 8960;
constexpr float EPS = 1e-6f, LOG2E = 1.4426950408889634f;
constexpr float C2A = 0.125f * LOG2E;
constexpr float C2C = 0.08838834764831845f * LOG2E;
constexpr int NWAVES = 8, NTHR = 512;

constexpr size_t MiB = 1u << 20;
constexpr size_t WS_WIN = 1 * MiB, WS_WM = 19 * MiB, WS_WB = 21 * MiB, WS_WO = 24 * MiB, WS_HM = 26 * MiB, WS_MKV = 30 * MiB, WS_H = 34 * MiB;
constexpr size_t WS_QA = 98 * MiB, WS_GB = 130 * MiB, WS_QC = 162 * MiB;
constexpr size_t WS_KA = 194 * MiB, WS_VA = 226 * MiB, WS_ZA = 258 * MiB, WS_QI = 290 * MiB, WS_KW = 322 * MiB, WS_QB = 330 * MiB, WS_FB = 362 * MiB, WS_IB = 394 * MiB, WS_ZC = 426 * MiB;
constexpr size_t WS_MASK = 458 * MiB, WS_DEC = 474 * MiB, WS_H8 = 476 * MiB, WS_END = 508 * MiB;
constexpr size_t WS_W8 = WS_WIN, WS_WG8 = WS_W8 + (size_t)N1 * DM;
constexpr size_t WS_WIX = WS_WIN + 6 * MiB;
#ifndef IDX_FP8
#define IDX_FP8 0
#endif
constexpr int IX_LO = 2048, IX_HI = 2816;
constexpr float H8_SCALE = 4.f, WG8_SCALE = 64.f;
constexpr float O8_SCALE = 16.f, WB8_SCALE = 16.f;
constexpr float M8_SCALE = 16.f, WO8_SCALE = 16.f;
constexpr size_t WS_MKVT = WS_MKV + 2 * MiB;
constexpr size_t WS_O8C = WS_H + 16 * MiB, WS_O8B = WS_H + 32 * MiB, WS_M8 = WS_ZC;
constexpr size_t WS_G = 194 * MiB, WS_MB = 330 * MiB;
constexpr size_t WS_OB = WS_QI;
constexpr size_t OUT_LCT = 0, OUT_SINT = 64 * MiB;
constexpr size_t WS_LBT = 49152;
constexpr size_t WS_LMINV = 40960;

constexpr int LDS_BYTES = 147456;

__device__ __forceinline__ float bf2f(unsigned u16) { return __uint_as_float(u16 << 16); }
__device__ __forceinline__ unsigned pk2(float lo, float hi) { typedef float f2 __attribute__((ext_vector_type(2))); typedef __bf16 b2 __attribute__((ext_vector_type(2))); f2 v = {lo, hi}; b2 b = __builtin_convertvector(v, b2); return __builtin_bit_cast(unsigned, b); }
__device__ __forceinline__ unsigned pk4_fp8(float a, float b, float c, float d) {
    a = __builtin_amdgcn_fmed3f(a, -448.f, 448.f); b = __builtin_amdgcn_fmed3f(b, -448.f, 448.f); c = __builtin_amdgcn_fmed3f(c, -448.f, 448.f); d = __builtin_amdgcn_fmed3f(d, -448.f, 448.f);
    int w = __builtin_amdgcn_cvt_pk_fp8_f32(a, b, 0, false); w = __builtin_amdgcn_cvt_pk_fp8_f32(c, d, w, true); return (unsigned)w; }
__device__ __forceinline__ unsigned pk4_fp8_nc(float a, float b, float c, float d) {
    int w = __builtin_amdgcn_cvt_pk_fp8_f32(a, b, 0, false); w = __builtin_amdgcn_cvt_pk_fp8_f32(c, d, w, true); return (unsigned)w; }
__device__ __forceinline__ bf16_t f2bf(float f) { return (bf16_t)(pk2(f, 0.f) & 0xffffu); }
__device__ __forceinline__ float ex2(float x) { return __builtin_amdgcn_exp2f(x); }
__device__ __forceinline__ float rcpf_(float x) { return __builtin_amdgcn_rcpf(x); }
__device__ __forceinline__ float sigm(float x) { return rcpf_(1.f + ex2(-LOG2E * x)); }
__device__ __forceinline__ float silu(float x) { return x * sigm(x); }
__device__ __forceinline__ int crow(int r, int hi) { return (r & 3) + 8 * (r >> 2) + 4 * hi; }
__device__ __forceinline__ f32x16 mfma32(bf16x8 a, bf16x8 b, f32x16 c) { return __builtin_amdgcn_mfma_f32_32x32x16_bf16(a, b, c, 0, 0, 0); }
__device__ __forceinline__ f32x4 mfma16(bf16x8 a, bf16x8 b, f32x4 c) { return __builtin_amdgcn_mfma_f32_16x16x32_bf16(a, b, c, 0, 0, 0); }
__device__ __forceinline__ float wave_sum(float v) {
#pragma unroll
    for (int o = 1; o < 64; o <<= 1) v += __shfl_xor(v, o);
    return v;
}
__device__ __forceinline__ int wave_sum_i(int v) {
#pragma unroll
    for (int o = 1; o < 64; o <<= 1) v += __shfl_xor(v, o);
    return v;
}
__device__ __forceinline__ unsigned wave_sum_dpp(unsigned v) {
    v += (unsigned)__builtin_amdgcn_update_dpp(0, (int)v, 0x111, 0xf, 0xf, true);
    v += (unsigned)__builtin_amdgcn_update_dpp(0, (int)v, 0x112, 0xf, 0xf, true);
    v += (unsigned)__builtin_amdgcn_update_dpp(0, (int)v, 0x114, 0xf, 0xf, true);
    v += (unsigned)__builtin_amdgcn_update_dpp(0, (int)v, 0x118, 0xf, 0xf, true);
    v += (unsigned)__builtin_amdgcn_update_dpp(0, (int)v, 0x142, 0xa, 0xf, false);
    v += (unsigned)__builtin_amdgcn_update_dpp(0, (int)v, 0x143, 0xc, 0xf, false);
    return (unsigned)__builtin_amdgcn_readlane((int)v, 63);
}
__device__ __forceinline__ unsigned umax_(unsigned a, unsigned b) { return a > b ? a : b; }
__device__ __forceinline__ unsigned wave_max_dpp(unsigned v) {
    v = umax_(v, (unsigned)__builtin_amdgcn_update_dpp(0, (int)v, 0x111, 0xf, 0xf, true));
    v = umax_(v, (unsigned)__builtin_amdgcn_update_dpp(0, (int)v, 0x112, 0xf, 0xf, true));
    v = umax_(v, (unsigned)__builtin_amdgcn_update_dpp(0, (int)v, 0x114, 0xf, 0xf, true));
    v = umax_(v, (unsigned)__builtin_amdgcn_update_dpp(0, (int)v, 0x118, 0xf, 0xf, true));
    v = umax_(v, (unsigned)__builtin_amdgcn_update_dpp(0, (int)v, 0x142, 0xa, 0xf, false));
    v = umax_(v, (unsigned)__builtin_amdgcn_update_dpp(0, (int)v, 0x143, 0xc, 0xf, false));
    return (unsigned)__builtin_amdgcn_readlane((int)v, 63);
}
__device__ __forceinline__ void unpack8(u32x4 v, float (&f)[8]) {
#pragma unroll
    for (int i = 0; i < 4; ++i) { f[2 * i] = bf2f(v[i] & 0xffffu); f[2 * i + 1] = bf2f(v[i] >> 16); }
}

struct Ctx {
    float* out; unsigned char* ws;
    LAS unsigned char* lds; int tid, lane, wave, G, bid;
};
#define WSP(off) ((bf16_t*)(C.ws + (off)))

__device__ __forceinline__ int win_src_col(int r) {
    if (r < 1024) {
        const int g = r & 511, pt = g >> 8, bj = (g >> 7) & 1, wc = (g >> 5) & 3, j = g & 31;
        return (r & 512) + (4 * pt + wc) * 64 + 32 * bj + j; }
    if (r < 2632) return r;
    if (r < 2688) return -1;
    if (r < 5248) return r - 56;
    if (r < 5760) { const int j = (r - 5248) & 127;
        return (r - j) - 56 + (j & 3) * 32 + (j >> 2); }
    if (r < 5888) return -1;
    return r - 184;
}
__device__ __forceinline__ void p0_transpose_item(const float* W, int K, int N, bf16_t* WT, unsigned char* W8, float w8s, bool winmap, LAS float* scr, int item, int nblk, int lane, bool kperm = false) {
    const int kb = item / nblk, nb = item % nblk, k0 = 64 * kb, n0 = 32 * nb;
    const int dcol = n0 + (lane & 31); const int sc = winmap ? win_src_col(dcol) : dcol;
    float tv[32];
#pragma unroll
    for (int i = 0; i < 32; ++i) { const int kq = k0 + 2 * i + (lane >> 5); const int ks_ = kperm ? ((kq & ~127) | ((kq & 3) * 32 + ((kq & 127) >> 2))) : kq;
        tv[i] = W[(size_t)ks_ * N + (sc >= 0 ? sc : 0)]; }
#pragma unroll
    for (int i = 0; i < 32; ++i) { const int kk = 2 * i + (lane >> 5); scr[kk * 33 + (lane & 31)] = sc >= 0 ? tv[i] : 0.f; }
    asm volatile("s_waitcnt lgkmcnt(0)" ::: "memory");
    const int c = lane & 7;
#pragma unroll
    for (int j = 0; j < 4; ++j) { const int n = (lane >> 3) + 8 * j; const LAS float* s = scr + (8 * c) * 33 + n;
        if (W8 && (IDX_FP8 || !(winmap && n0 >= IX_LO && n0 < IX_HI))) {
            u32x2 o8; o8.x = pk4_fp8(s[0 * 33] * w8s, s[1 * 33] * w8s, s[2 * 33] * w8s, s[3 * 33] * w8s); o8.y = pk4_fp8(s[4 * 33] * w8s, s[5 * 33] * w8s, s[6 * 33] * w8s, s[7 * 33] * w8s);
            *(u32x2*)(W8 + (size_t)(n0 + n) * K + k0 + 8 * c) = o8; continue; }
        u32x4 o; o.x = pk2(s[0 * 33], s[1 * 33]); o.y = pk2(s[2 * 33], s[3 * 33]); o.z = pk2(s[4 * 33], s[5 * 33]); o.w = pk2(s[6 * 33], s[7 * 33]);
        *(u32x4*)(WT + (size_t)(n0 + n) * K + k0 + 8 * c) = o; }
    asm volatile("s_waitcnt lgkmcnt(0)" ::: "memory");
}
__device__ __forceinline__ void rms_row_to_bf16(const float* xrow, const float* gain, bf16_t* orow, int lane) {
    const f32x4* xr = (const f32x4*)xrow + lane; const f32x4* gr = (const f32x4*)gain + lane;
    f32x4 v[4]; float s = 0.f;
#pragma unroll
    for (int j = 0; j < 4; ++j) { v[j] = xr[64 * j]; s += (v[j].x * v[j].x + v[j].y * v[j].y) + (v[j].z * v[j].z + v[j].w * v[j].w); }
    const float rstd = 1.f / sqrtf(wave_sum(s) * (1.f / DM) + EPS);
    u32x2* o8 = (u32x2*)orow + lane;
#pragma unroll
    for (int j = 0; j < 4; ++j) { const f32x4 g = gr[64 * j]; u32x2 w; w.x = pk2(v[j].x * rstd * g.x, v[j].y * rstd * g.y); w.y = pk2(v[j].z * rstd * g.z, v[j].w * rstd * g.w); o8[64 * j] = w; }
}
__device__ __forceinline__ void p0_prologue(Ctx& C, const float* x, const float* mem, const float* norm_in, const float* norm_mem, const float* w_in, const float* w_mkv, const float* w_br, const float* w_out, const float* lbin, int parts = 3) {
    LAS float* scr = (LAS float*)(C.lds + C.wave * 16384);
#ifdef P0_ROLES
    const int role = C.wave >> 2, gw = C.bid * 4 + (C.wave & 3), NGW = C.G * 4;
    if (role == 0) parts = 1; else parts = 2;
    const int TB = T - P0_ROWS_A;
#else
    const int gw = C.bid * NWAVES + C.wave, NGW = C.G * NWAVES;
    const int TB = T;
#endif
    constexpr int I_IN = 16 * (NALL / 32), I_M = 16 * 32, I_B = 8 * 32, I_O = 16 * 32;
    constexpr int NITEMS = I_IN + I_M + 3 * I_B + I_O;
    if (parts & 1)
    for (int it = gw; it < NITEMS; it += NGW) {
        int r = it;
        if (r < I_IN) { p0_transpose_item(w_in, DM, NSRC, WSP(WS_WIX), C.ws + WS_W8, WG8_SCALE, true, scr, r, NALL / 32, C.lane); continue; } r -= I_IN;
        if (r < I_M) { p0_transpose_item(w_mkv, DM, DM, WSP(WS_WM), nullptr, 0.f, false, scr, r, 32, C.lane); continue; } r -= I_M;
        if (r < 3 * I_B) { const int n = r / I_B; p0_transpose_item(w_br + (size_t)n * 512 * DM, 512, DM, nullptr, C.ws + WS_WB + (size_t)n * DM * 512, WB8_SCALE, false, scr, r % I_B, 32, C.lane, n == 2); continue; } r -= 3 * I_B;
        p0_transpose_item(w_out, DM, DM, nullptr, C.ws + WS_WO, WO8_SCALE, false, scr, r, 32, C.lane);
    }
#ifdef P0_ROLES
    const int m_lo = (parts & 2) ? 0 : TB, m_hi = (parts & 2) ? TB : T;
#else
    if (!(parts & 2)) return;
    const int m_lo = 0, m_hi = T;
#endif
    f32x4 gnv[4];
#pragma unroll
    for (int j = 0; j < 4; ++j) gnv[j] = ((const f32x4*)norm_in)[C.lane + 64 * j];
    for (int m = m_lo + gw; m < m_hi; m += 2 * NGW) {
        f32x4 v[2][4]; float sq[2];
#pragma unroll
        for (int r = 0; r < 2; ++r) { const int mr = (m + r * NGW < m_hi) ? m + r * NGW : m;
            const f32x4* xr = (const f32x4*)(x + (size_t)mr * DM) + C.lane;
#pragma unroll
            for (int j = 0; j < 4; ++j) v[r][j] = xr[64 * j]; }
#pragma unroll
        for (int r = 0; r < 2; ++r) { float s_ = 0.f;
#pragma unroll
            for (int j = 0; j < 4; ++j) s_ += (v[r][j].x * v[r][j].x + v[r][j].y * v[r][j].y) + (v[r][j].z * v[r][j].z + v[r][j].w * v[r][j].w);
            sq[r] = s_; }
#pragma unroll
        for (int o = 1; o < 64; o <<= 1) { sq[0] += __shfl_xor(sq[0], o); sq[1] += __shfl_xor(sq[1], o); }
#pragma unroll
        for (int r = 0; r < 2; ++r) { const int mr = (m + r * NGW < m_hi) ? m + r * NGW : m; const float rstd = 1.f / sqrtf(sq[r] * (1.f / DM) + EPS); u32x2* o8 = (u32x2*)(WSP(WS_H) + (size_t)mr * DM) + C.lane;
#pragma unroll
            for (int j = 0; j < 4; ++j) { const f32x4 g = gnv[j]; const float h0 = v[r][j].x * rstd * g.x, h1 = v[r][j].y * rstd * g.y, h2 = v[r][j].z * rstd * g.z, h3 = v[r][j].w * rstd * g.w;
                if (!IDX_FP8) { u32x2 w; w.x = pk2(h0, h1); w.y = pk2(h2, h3); o8[64 * j] = w; }
                ((unsigned*)(C.ws + WS_H8 + (size_t)mr * DM))[C.lane + 64 * j] = pk4_fp8(h0 * H8_SCALE, h1 * H8_SCALE, h2 * H8_SCALE, h3 * H8_SCALE); } }
    }
    if (C.bid == 0) { const float a0 = lbin[C.tid], a1 = lbin[512 + C.tid]; ((float*)(C.ws + WS_LBT))[C.tid] = 1.f / (1.f + expf(a1 - a0)); }
#ifdef P0_ROLES
    if (parts & 2)
#endif
    for (int m = gw; m < TM; m += NGW) rms_row_to_bf16(mem + (size_t)m * DM, norm_mem, WSP(WS_HM) + (size_t)m * DM, C.lane);
}

using pg8::Unit;
template <bool DESC> struct EpiP1T {
    static constexpr bool PERM = true, AFTER_DRAIN = false, SELF_DESCALE = DESC;
    static constexpr float DS = DESC ? pg8::F8_DESCALE : 1.f;
    unsigned char* ws; const float* gq; const float* gk; bool nostore = false;
    __device__ __forceinline__ void operator()(const f32x4 (&acc)[2][2][4][2], const Unit& u, int wr, int wc, int fr, int fq) const {
        if (nostore) return;
        const int row0 = u.pm * 256 + wr * 64 + fr;
        if (u.pn < 4) {
            const bool isq = u.pn < 2; const float* gain = isq ? gq : gk; const float scale = isq ? C2A : 1.f;
            const int head = 4 * (u.pn & 1) + wc;
            bf16_t* qbase = (bf16_t*)(ws + WS_QA) + ((size_t)(u.pm * 8 + wr * 2) * 8 + head) * 2048 + (fq >> 1) * 512 + ((fq & 1) * 32 + fr) * 8;
            bf16_t* base = (bf16_t*)(ws + WS_KA) + head * 64 + 8 * fq;
            f32x4 g[2][2];
#pragma unroll
            for (int bj = 0; bj < 2; ++bj)
#pragma unroll
                for (int n = 0; n < 2; ++n) g[bj][n] = *(const f32x4*)(gain + 32 * bj + 8 * fq + 4 * n);
#pragma unroll
            for (int ai = 0; ai < 2; ++ai)
#pragma unroll
                for (int m = 0; m < 4; ++m) {
                    float ss = 0.f;
#pragma unroll
                    for (int bj = 0; bj < 2; ++bj)
#pragma unroll
                        for (int n = 0; n < 2; ++n) { const f32x4 v = acc[ai][bj][m][n]; ss += (v[0] * v[0] + v[1] * v[1]) + (v[2] * v[2] + v[3] * v[3]); }
                    ss += __shfl_xor(ss, 16); ss += __shfl_xor(ss, 32);
                    const float rs = (scale * DS) / sqrtf(ss * (DS * DS / 64.f) + EPS);
#pragma unroll
                    for (int bj = 0; bj < 2; ++bj) { const f32x4 v0 = acc[ai][bj][m][0] * g[bj][0] * rs, v1 = acc[ai][bj][m][1] * g[bj][1] * rs;
                        u32x4 w; w.x = pk2(v0[0], v0[1]); w.y = pk2(v0[2], v0[3]); w.z = pk2(v1[0], v1[1]); w.w = pk2(v1[2], v1[3]);
                        if (isq) *(u32x4*)(qbase + ((ai * 4 + (m >> 1)) * 8) * 2048 + bj * 1024 + (m & 1) * 128) = w;
                        else *(u32x4*)(base + (size_t)(row0 + ai * 128 + m * 16) * 512 + 32 * bj) = w; }
                }
            return;
        }
#pragma unroll
        for (int bj = 0; bj < 2; ++bj) {
            const int unit = u.pn * 2 + bj;
            if (unit >= 45) continue;
            int buf, cu, ld = 512;
            if (unit >= 16 && unit < 20) {
                const int h = 2 * (unit & 3) + (wc >> 1), ks = wc & 1;
#pragma unroll
                for (int ai = 0; ai < 2; ++ai)
#pragma unroll
                    for (int m = 0; m < 4; ++m) { const int row = row0 + ai * 128 + m * 16; const f32x4 v0 = acc[ai][bj][m][0] * DS, v1 = acc[ai][bj][m][1] * DS;
                        u32x4 w; w.x = pk2(v0[0], v0[1]); w.y = pk2(v0[2], v0[3]); w.z = pk2(v1[0], v1[1]); w.w = pk2(v1[2], v1[3]);
                        *(u32x4*)((bf16_t*)(ws + WS_QI) + (size_t)(row >> 4) * 8192 + h * 1024 + ks * 512 + (fq * 16 + (row & 15)) * 8) = w; }
                continue; }
            if (unit < 20) { buf = unit >> 2; cu = (unit & 3) * 128; }
            else if (unit == 20) {
                if (wc < 2 || (wc == 2 && fq == 0)) {
#pragma unroll
                    for (int ai = 0; ai < 2; ++ai)
#pragma unroll
                        for (int m = 0; m < 4; ++m) { const int row = row0 + ai * 128 + m * 16; const f32x4 v0 = acc[ai][bj][m][0] * DS, v1 = acc[ai][bj][m][1] * DS;
                            u32x4 w; w.x = pk2(v0[0], v0[1]); w.y = pk2(v0[2], v0[3]); w.z = pk2(v1[0], v1[1]); w.w = pk2(v1[2], v1[3]);
                            bf16_t* dst = (wc < 2) ? (bf16_t*)(ws + WS_KW) + (size_t)(row >> 4) * 1024 + wc * 512 + (fq * 16 + (row & 15)) * 8 : (bf16_t*)(ws + WS_KW + 4 * MiB) + (size_t)row * 8;
                            *(u32x4*)dst = w; } }
                continue; }
            else { const int i = unit - 21; buf = 6 + (i >> 2); cu = (i & 3) * 128; }
            size_t off;
            switch (buf) { case 0: off = WS_QA; break; case 1: off = WS_KA; break; case 2: off = WS_VA; break; case 3: off = WS_ZA; break; case 4: off = WS_QI; break; case 5: off = WS_KW; break;
                           case 6: off = WS_QB; break; case 7: off = WS_FB; break; case 8: off = WS_IB; break; case 9: off = WS_GB; break; case 10: off = WS_QC; break; default: off = WS_ZC; break; }
            const bool act = (buf == 3) || (buf == 6) || (buf == 9) || (buf == 11);
            bf16_t* base = (bf16_t*)(ws + off) + cu + wc * 32 + 8 * fq;
#pragma unroll
            for (int ai = 0; ai < 2; ++ai)
#pragma unroll
                for (int m = 0; m < 4; ++m) {
                    f32x4 v0 = acc[ai][bj][m][0], v1 = acc[ai][bj][m][1];
                    if (act) {
#pragma unroll
                        for (int e = 0; e < 4; ++e) { constexpr float KS = -LOG2E * DS, ID = 1.f / DS; v0[e] = v0[e] * rcpf_(__builtin_fmaf(ex2(KS * v0[e]), ID, ID)); v1[e] = v1[e] * rcpf_(__builtin_fmaf(ex2(KS * v1[e]), ID, ID)); }
                    } else if (DESC) { v0 = v0 * DS; v1 = v1 * DS; }
                    u32x4 w; w.x = pk2(v0[0], v0[1]); w.y = pk2(v0[2], v0[3]); w.z = pk2(v1[0], v1[1]); w.w = pk2(v1[2], v1[3]);
#ifdef G1_NT_STORE
                    __builtin_nontemporal_store(w, (u32x4*)(base + (size_t)(row0 + ai * 128 + m * 16) * ld));
#else
                    *(u32x4*)(base + (size_t)(row0 + ai * 128 + m * 16) * ld) = w;
#endif
                }
        }
    }
};
using EpiP1 = EpiP1T<false>;
using EpiP1F8 = EpiP1T<true>;
#define M_FP8 1
#define T21_WIDE 1
constexpr float G8_SCALE = 64.f;
template <int ACT  > struct EpiPlain {
    static constexpr bool PERM = true, AFTER_DRAIN = false;
    bf16_t* O; int ld;
    __device__ __forceinline__ void operator()(const f32x4 (&acc)[2][2][4][2], const Unit& u, int wr, int wc, int fr, int fq) const {
        const int row0 = u.pm * 256 + wr * 64 + fr, col0 = u.pn * 256 + wc * 32 + 8 * fq;
#pragma unroll
        for (int bj = 0; bj < 2; ++bj)
#pragma unroll
            for (int ai = 0; ai < 2; ++ai)
#pragma unroll
                for (int m = 0; m < 4; ++m) {
                    f32x4 v0 = acc[ai][bj][m][0], v1 = acc[ai][bj][m][1];
                    if (ACT == 1) {
#pragma unroll
                        for (int e = 0; e < 4; ++e) { v0[e] = sigm(v0[e]); v1[e] = sigm(v1[e]); }
                    }

                    if (ACT == 3) {
#pragma unroll
                        for (int e = 0; e < 4; ++e) { v0[e] = (sigm(v0[e]) - 0.5f) * G8_SCALE; v1[e] = (sigm(v1[e]) - 0.5f) * G8_SCALE; }
                        u32x2 w8; w8.x = pk4_fp8(v0[0], v0[1], v0[2], v0[3]); w8.y = pk4_fp8(v1[0], v1[1], v1[2], v1[3]);
                        *(u32x2*)((unsigned char*)O + (size_t)(row0 + ai * 128 + m * 16) * ld + col0 + bj * 128) = w8; continue; }
                    u32x4 w; w.x = pk2(v0[0], v0[1]); w.y = pk2(v0[2], v0[3]); w.z = pk2(v1[0], v1[1]); w.w = pk2(v1[2], v1[3]);
                    *(u32x4*)(O + (size_t)(row0 + ai * 128 + m * 16) * ld + col0 + bj * 128) = w;
                }
    }
};
__device__ __forceinline__ void swap16x2(u32x2& a, u32x2& b) {
    auto r0 = __builtin_amdgcn_permlane16_swap(a.x, b.x, false, false); a.x = r0[0]; b.x = r0[1];
    auto r1 = __builtin_amdgcn_permlane16_swap(a.y, b.y, false, false); a.y = r1[0]; b.y = r1[1];
}
template <bool DESC> struct EpiGate8T {
    static constexpr bool PERM = true, AFTER_DRAIN = false;
    unsigned char* O; int ld;
    __device__ __forceinline__ void operator()(const f32x4 (&acc)[2][2][4][2], const Unit& u, int wr, int wc, int fr, int fq) const {
        const int odd = fq & 1;
        const int row0 = u.pm * 256 + wr * 64 + fr + 16 * odd, col0 = u.pn * 256 + wc * 32 + 8 * (fq - odd);
#pragma unroll
        for (int bj = 0; bj < 2; ++bj)
#pragma unroll
            for (int ai = 0; ai < 2; ++ai)
#pragma unroll
                for (int mp = 0; mp < 4; mp += 2) {
                    u32x2 w[2];
#pragma unroll
                    for (int k = 0; k < 2; ++k) { f32x4 v0 = acc[ai][bj][mp + k][0], v1 = acc[ai][bj][mp + k][1];
#pragma unroll
                        for (int e = 0; e < 4; ++e) { constexpr float KS = -LOG2E * (DESC ? pg8::F8_DESCALE : 1.f); v0[e] = __builtin_fmaf(rcpf_(1.f + ex2(KS * v0[e])), G8_SCALE, -0.5f * G8_SCALE); v1[e] = __builtin_fmaf(rcpf_(1.f + ex2(KS * v1[e])), G8_SCALE, -0.5f * G8_SCALE); }
                        w[k].x = pk4_fp8_nc(v0[0], v0[1], v0[2], v0[3]); w[k].y = pk4_fp8_nc(v1[0], v1[1], v1[2], v1[3]); }
                    swap16x2(w[0], w[1]);
                    u32x4 o; o.x = w[0].x; o.y = w[0].y; o.z = w[1].x; o.w = w[1].y;
                    *(u32x4*)(O + (size_t)(row0 + ai * 128 + mp * 16) * ld + col0 + bj * 128) = o;
                }
    }
};
using EpiGate8 = EpiGate8T<false>;
template <bool LAST> struct EpiMerge {
    static constexpr bool PERM = true, AFTER_DRAIN = false;
    const bf16_t* Gt; bf16_t* MB; int first; unsigned char* M8;
    __device__ __forceinline__ void operator()(const f32x4 (&acc)[2][2][4][2], const Unit& u, int wr, int wc, int fr, int fq) const {
        const int row0 = u.pm * 256 + wr * 64 + fr, col0 = u.pn * 256 + wc * 32 + 8 * fq;
#pragma unroll
        for (int bj = 0; bj < 2; ++bj)
#pragma unroll
            for (int ai = 0; ai < 2; ++ai)
#pragma unroll
                for (int m = 0; m < 4; ++m) {
                    const size_t off = (size_t)(row0 + ai * 128 + m * 16) * DM + col0 + bj * 128;
                    float g[8], mo[8];
                    { typedef float f2_ __attribute__((ext_vector_type(2))); const u32x2 g8 = *(const u32x2*)((const unsigned char*)Gt + off);
                      const f2_ a = __builtin_amdgcn_cvt_pk_f32_fp8((int)g8.x, false), b = __builtin_amdgcn_cvt_pk_f32_fp8((int)g8.x, true), c = __builtin_amdgcn_cvt_pk_f32_fp8((int)g8.y, false), d = __builtin_amdgcn_cvt_pk_f32_fp8((int)g8.y, true);
                      g[0] = a.x; g[1] = a.y; g[2] = b.x; g[3] = b.y; g[4] = c.x; g[5] = c.y; g[6] = d.x; g[7] = d.y;
#pragma unroll
                      for (int e = 0; e < 8; ++e) g[e] = g[e] * (1.f / G8_SCALE) + 0.5f; }
#ifdef M_FP8
                    if (!first) { typedef float f2_ __attribute__((ext_vector_type(2))); const u32x2 m8 = *(const u32x2*)(M8 + off);
                        const f2_ a = __builtin_amdgcn_cvt_pk_f32_fp8((int)m8.x, false), b = __builtin_amdgcn_cvt_pk_f32_fp8((int)m8.x, true), c = __builtin_amdgcn_cvt_pk_f32_fp8((int)m8.y, false), d = __builtin_amdgcn_cvt_pk_f32_fp8((int)m8.y, true);
                        mo[0] = a.x; mo[1] = a.y; mo[2] = b.x; mo[3] = b.y; mo[4] = c.x; mo[5] = c.y; mo[6] = d.x; mo[7] = d.y;
#pragma unroll
                        for (int e = 0; e < 8; ++e) mo[e] *= (1.f / M8_SCALE); }
#else
                    if (!first) unpack8(*(const u32x4*)(MB + off), mo);
#endif
                    else {
#pragma unroll
                        for (int e = 0; e < 8; ++e) mo[e] = 0.f;
                    }
                    const f32x4 v0 = acc[ai][bj][m][0], v1 = acc[ai][bj][m][1];
                    float r[8];
#pragma unroll
                    for (int e = 0; e < 4; ++e) { r[e] = mo[e] + g[e] * v0[e]; r[4 + e] = mo[4 + e] + g[4 + e] * v1[e]; }
#ifdef M_FP8
                    constexpr bool OUT8 = true;
#else
                    constexpr bool OUT8 = LAST;
#endif
                    if constexpr (OUT8) { u32x2 w8; w8.x = pk4_fp8(r[0] * M8_SCALE, r[1] * M8_SCALE, r[2] * M8_SCALE, r[3] * M8_SCALE); w8.y = pk4_fp8(r[4] * M8_SCALE, r[5] * M8_SCALE, r[6] * M8_SCALE, r[7] * M8_SCALE); *(u32x2*)(M8 + off) = w8; }
                    else { u32x4 w; w.x = pk2(r[0], r[1]); w.y = pk2(r[2], r[3]); w.z = pk2(r[4], r[5]); w.w = pk2(r[6], r[7]); *(u32x4*)(MB + off) = w; }
                }
    }
};
template <bool DESC> struct EpiMerge8T {
    static constexpr bool PERM = true, AFTER_DRAIN = false;
    const unsigned char* G8; unsigned char* M8; int first;
    __device__ __forceinline__ static void dec8(const u32x2 w, float (&f)[8]) { typedef float f2_ __attribute__((ext_vector_type(2)));
        const f2_ a = __builtin_amdgcn_cvt_pk_f32_fp8((int)w.x, false), b = __builtin_amdgcn_cvt_pk_f32_fp8((int)w.x, true), c = __builtin_amdgcn_cvt_pk_f32_fp8((int)w.y, false), d = __builtin_amdgcn_cvt_pk_f32_fp8((int)w.y, true);
        f[0] = a.x; f[1] = a.y; f[2] = b.x; f[3] = b.y; f[4] = c.x; f[5] = c.y; f[6] = d.x; f[7] = d.y; }
    __device__ __forceinline__ void operator()(const f32x4 (&acc)[2][2][4][2], const Unit& u, int wr, int wc, int fr, int fq) const {
        const int odd = fq & 1;
        const int row0 = u.pm * 256 + wr * 64 + fr + 16 * odd, col0 = u.pn * 256 + wc * 32 + 8 * (fq - odd);
        u32x4 gq[8], mq[8];
#pragma unroll
        for (int it = 0; it < 8; ++it) { const int bj = it >> 2, ai = (it >> 1) & 1, mp = (it & 1) * 2;
            const size_t off = (size_t)(row0 + ai * 128 + mp * 16) * DM + col0 + bj * 128;
            gq[it] = *(const u32x4*)(G8 + off);
            if (!first) mq[it] = *(const u32x4*)(M8 + off); else mq[it] = (u32x4){0u, 0u, 0u, 0u}; }
#pragma unroll
        for (int it = 0; it < 8; ++it) { const int bj = it >> 2, ai = (it >> 1) & 1, mp = (it & 1) * 2;
            const size_t off = (size_t)(row0 + ai * 128 + mp * 16) * DM + col0 + bj * 128;
            u32x2 gw[2] = {{gq[it].x, gq[it].y}, {gq[it].z, gq[it].w}}; swap16x2(gw[0], gw[1]);
            u32x2 mw[2] = {{mq[it].x, mq[it].y}, {mq[it].z, mq[it].w}}; if (!first) swap16x2(mw[0], mw[1]);
            u32x2 ow[2];
#pragma unroll
            for (int k = 0; k < 2; ++k) {
                float g[8], mo[8]; dec8(gw[k], g); dec8(mw[k], mo);
                const f32x4 v0 = acc[ai][bj][mp + k][0], v1 = acc[ai][bj][mp + k][1];
                float r[8];
#pragma unroll
                for (int e = 0; e < 4; ++e) { constexpr float DS = DESC ? pg8::F8_DESCALE : 1.f, CA = (M8_SCALE / G8_SCALE) * DS, CB = 0.5f * M8_SCALE * DS; r[e] = mo[e] + (g[e] * CA + CB) * v0[e]; r[4 + e] = mo[4 + e] + (g[4 + e] * CA + CB) * v1[e]; }
                ow[k].x = pk4_fp8(r[0], r[1], r[2], r[3]); ow[k].y = pk4_fp8(r[4], r[5], r[6], r[7]); }
            swap16x2(ow[0], ow[1]);
            u32x4 o; o.x = ow[0].x; o.y = ow[0].y; o.z = ow[1].x; o.w = ow[1].y;
            *(u32x4*)(M8 + off) = o; }
    }
};
using EpiMerge8 = EpiMerge8T<false>;
struct EpiP5 {
    static constexpr bool PERM = true, AFTER_DRAIN = false;
#ifdef T21_WIDE
    static constexpr bool SELF_DESCALE = true;
#endif
    unsigned char* ws;
    __device__ __forceinline__ void operator()(const f32x4 (&acc)[2][2][4][2], const Unit& u, int wr, int wc, int fr, int fq) const {
#ifdef T21_WIDE
        if (!(u.n & 1)) { const EpiGate8T<true> e{ws + WS_G, DM}; e(acc, u, wr, wc, fr, fq); }
        else { const EpiMerge8T<true> e{ws + WS_G, ws + WS_M8, u.n == 1 ? 1 : 0}; e(acc, u, wr, wc, fr, fq); }
#else
        if (!(u.n & 1)) { const EpiPlain<3> e{(bf16_t*)(ws + WS_G), DM}; e(acc, u, wr, wc, fr, fq); }
        else if (u.n == 5) { const EpiMerge<true> e{(const bf16_t*)(ws + WS_G), (bf16_t*)(ws + WS_MB), 0, ws + WS_M8}; e(acc, u, wr, wc, fr, fq); }
#ifdef M_FP8
        else { const EpiMerge<false> e{(const bf16_t*)(ws + WS_G), (bf16_t*)(ws + WS_MB), u.n == 1 ? 1 : 0, ws + WS_M8}; e(acc, u, wr, wc, fr, fq); }
#else
        else { const EpiMerge<false> e{(const bf16_t*)(ws + WS_G), (bf16_t*)(ws + WS_MB), u.n == 1 ? 1 : 0, nullptr}; e(acc, u, wr, wc, fr, fq); }
#endif
#endif
    }
};
struct EpiOut {
    static constexpr bool PERM = true, AFTER_DRAIN = false;
    const float* x; float* out;
    __device__ __forceinline__ void operator()(const f32x4 (&acc)[2][2][4][2], const Unit& u, int wr, int wc, int fr, int fq) const {
        const int row0 = u.pm * 256 + wr * 64 + fr, col0 = u.pn * 256 + wc * 32 + 8 * fq;
#pragma unroll
        for (int ai = 0; ai < 2; ++ai) {
            f32x4 xv[8][2];
#pragma unroll
            for (int it = 0; it < 8; ++it) { const int m = it >> 1, bj = it & 1; const size_t off = (size_t)(row0 + ai * 128 + m * 16) * DM + col0 + bj * 128;
                xv[it][0] = *(const f32x4*)(x + off); xv[it][1] = *(const f32x4*)(x + off + 4); }
#pragma unroll
            for (int it = 0; it < 8; ++it) { const int m = it >> 1, bj = it & 1; const size_t off = (size_t)(row0 + ai * 128 + m * 16) * DM + col0 + bj * 128;
                *(f32x4*)(out + off) = xv[it][0] + acc[ai][bj][m][0]; *(f32x4*)(out + off + 4) = xv[it][1] + acc[ai][bj][m][1]; }
        }
    }
};

__device__ __forceinline__ void norm_rows_inplace(bf16_t* buf, int ld, int nrows, int hd, const float* gain, float scale, int gw, int NGW, int lane) {
    for (int r = gw; r < nrows; r += NGW) {
        bf16_t* p = buf + (size_t)r * ld + lane * 8;
        float f[8]; unpack8(*(const u32x4*)p, f);
        float ss = 0.f;
#pragma unroll
        for (int i = 0; i < 8; ++i) ss += f[i] * f[i];
        ss += __shfl_xor(ss, 1); ss += __shfl_xor(ss, 2); ss += __shfl_xor(ss, 4);
        if (hd == 128) ss += __shfl_xor(ss, 8);
        const float rs = scale / sqrtf(ss / (float)hd + EPS);
        const float* g = gain + ((lane * 8) % hd);
        u32x4 w; w.x = pk2(f[0] * rs * g[0], f[1] * rs * g[1]); w.y = pk2(f[2] * rs * g[2], f[3] * rs * g[3]); w.z = pk2(f[4] * rs * g[4], f[5] * rs * g[5]); w.w = pk2(f[6] * rs * g[6], f[7] * rs * g[7]);
        *(u32x4*)p = w;
    }
}

constexpr int IDX_RS = 8208;
typedef float f32x2_t __attribute__((ext_vector_type(2)));
__device__ __forceinline__ unsigned mono16x2(f32x2_t v) {
    typedef _Float16 h2 __attribute__((ext_vector_type(2))); typedef short s2 __attribute__((ext_vector_type(2)));
    const h2 h = __builtin_convertvector(v, h2); const unsigned hb = __builtin_bit_cast(unsigned, h);
    const s2 sg = __builtin_bit_cast(s2, hb) >> 15;
    return hb ^ (__builtin_bit_cast(unsigned, sg) | 0x80008000u);
}
__device__ __forceinline__ unsigned mono16(float s) {
    const _Float16 h = (_Float16)s; const unsigned b = (unsigned)__builtin_bit_cast(unsigned short, h);
    return (b & 0x8000u) ? (~b & 0xffffu) : (b | 0x8000u);
}
__device__ __forceinline__ void indexer_unit(Ctx& C, int b, int blk) {
    const bf16_t* QI = WSP(WS_QI); const bf16_t* KW = WSP(WS_KW); unsigned char* maskb = C.ws + WS_MASK;
    int lane = C.lane; asm volatile("" : "+v"(lane));
    const int wid = C.wave, fr = lane & 15, fq = lane >> 4;
    const int t0 = blk * 16; const size_t rowbase = (size_t)b * SEQ;
    bf16x8 qf[8][2];
    { const bf16_t* qt = QI + ((rowbase >> 4) + blk) * 8192 + lane * 8;
#pragma unroll
      for (int h = 0; h < 8; ++h)
#pragma unroll
          for (int ks = 0; ks < 2; ++ks) qf[h][ks] = *(const bf16x8*)(qt + h * 1024 + ks * 512); }
    float wv[8]; unpack8(*(const u32x4*)((const bf16_t*)(C.ws + WS_KW + 4 * MiB) + (rowbase + t0 + fr) * 8), wv);
    bf16x8 qbar[2];
#pragma unroll
    for (int ks = 0; ks < 2; ++ks) { float acc8[8] = {0.f, 0.f, 0.f, 0.f, 0.f, 0.f, 0.f, 0.f};
#pragma unroll
        for (int h = 0; h < 8; ++h) { float f[8]; unpack8(__builtin_bit_cast(u32x4, qf[h][ks]), f);
#pragma unroll
            for (int i = 0; i < 8; ++i) acc8[i] += wv[h] * f[i]; }
        u32x4 w_; w_.x = pk2(acc8[0], acc8[1]); w_.y = pk2(acc8[2], acc8[3]); w_.z = pk2(acc8[4], acc8[5]); w_.w = pk2(acc8[6], acc8[7]); qbar[ks] = __builtin_bit_cast(bf16x8, w_); }
    const int ntile = blk + 1;
    const int nmine = (ntile - wid + 7) >> 3;
    const bf16_t* kbase = KW + (rowbase >> 4) * 1024 + lane * 8;
#ifdef IDX_REP_COMP
#define IDX_REPC(K) for (int rc_ = 0; rc_ < 2; ++rc_) { asm volatile("" : "+v"(K[j_][0]), "+v"(K[j_][1]));
#define IDX_REPC_END }
#else
#define IDX_REPC(K) {
#define IDX_REPC_END }
#endif
#ifndef IDX_PIPE
#define IDX_PIPE 0
#endif
#if IDX_PIPE
#define IDX_SB __builtin_amdgcn_sched_barrier(0)
#define IDX_HSTEP(K, h, aN, aP) \
        aN = (f32x4){0.f, 0.f, 0.f, 0.f}; aN = mfma16(K[j_][0], qf[h][0], aN); IDX_SB; \
        s0_ = __builtin_fmaf(__builtin_fabsf(aP[0]), wv[(h) - 1], s0_); s1_ = __builtin_fmaf(__builtin_fabsf(aP[1]), wv[(h) - 1], s1_); asm("" : "+v"(s0_)); asm("" : "+v"(s1_)); IDX_SB; \
        aN = mfma16(K[j_][1], qf[h][1], aN); IDX_SB; \
        s2_ = __builtin_fmaf(__builtin_fabsf(aP[2]), wv[(h) - 1], s2_); s3_ = __builtin_fmaf(__builtin_fabsf(aP[3]), wv[(h) - 1], s3_); asm("" : "+v"(s2_)); asm("" : "+v"(s3_)); IDX_SB;
#define IDX_SCORE8(K) \
        f32x4 aA_ = {0.f, 0.f, 0.f, 0.f}, aB_; aA_ = mfma16(K[j_][0], qf[0][0], aA_); \
        f32x4 l_ = {0.f, 0.f, 0.f, 0.f}; l_ = mfma16(K[j_][0], qbar[0], l_); aA_ = mfma16(K[j_][1], qf[0][1], aA_); l_ = mfma16(K[j_][1], qbar[1], l_); IDX_SB; \
        float s0_ = 0.f, s1_ = 0.f, s2_ = 0.f, s3_ = 0.f; \
        IDX_HSTEP(K, 1, aB_, aA_) IDX_HSTEP(K, 2, aA_, aB_) IDX_HSTEP(K, 3, aB_, aA_) IDX_HSTEP(K, 4, aA_, aB_) IDX_HSTEP(K, 5, aB_, aA_) IDX_HSTEP(K, 6, aA_, aB_) IDX_HSTEP(K, 7, aB_, aA_) \
        s0_ = __builtin_fmaf(__builtin_fabsf(aB_[0]), wv[7], s0_); s1_ = __builtin_fmaf(__builtin_fabsf(aB_[1]), wv[7], s1_); s2_ = __builtin_fmaf(__builtin_fabsf(aB_[2]), wv[7], s2_); s3_ = __builtin_fmaf(__builtin_fabsf(aB_[3]), wv[7], s3_); \
        asm("" : "+v"(s0_)); asm("" : "+v"(s1_)); asm("" : "+v"(s2_)); asm("" : "+v"(s3_));
#else
#define IDX_SCORE8(K) \
        f32x4 l_ = {0.f, 0.f, 0.f, 0.f}; l_ = mfma16(K[j_][0], qbar[0], l_); l_ = mfma16(K[j_][1], qbar[1], l_); \
        float s0_ = 0.f, s1_ = 0.f, s2_ = 0.f, s3_ = 0.f; \
        _Pragma("unroll") for (int h = 0; h < 8; ++h) { f32x4 a_ = {0.f, 0.f, 0.f, 0.f}; a_ = mfma16(K[j_][0], qf[h][0], a_); a_ = mfma16(K[j_][1], qf[h][1], a_); \
            s0_ = __builtin_fmaf(__builtin_fabsf(a_[0]), wv[h], s0_); s1_ = __builtin_fmaf(__builtin_fabsf(a_[1]), wv[h], s1_); \
            s2_ = __builtin_fmaf(__builtin_fabsf(a_[2]), wv[h], s2_); s3_ = __builtin_fmaf(__builtin_fabsf(a_[3]), wv[h], s3_); \
            asm("" : "+v"(s0_)); asm("" : "+v"(s1_)); asm("" : "+v"(s2_)); asm("" : "+v"(s3_)); }
#endif
#define IDX_LOAD4(K, I0) do { _Pragma("unroll") for (int j_ = 0; j_ < 4; ++j_) { int kt_ = wid + 8 * ((I0) + j_); kt_ = kt_ < ntile ? kt_ : ntile - 1; \
        const bf16_t* p_ = kbase + (size_t)kt_ * 1024; K[j_][0] = *(const bf16x8*)p_; K[j_][1] = *(const bf16x8*)(p_ + 512); } } while (0)
#define IDX_COMP4(K, I0) do { _Pragma("unroll") for (int j_ = 0; j_ < 4; ++j_) { if ((I0) + j_ < nmine) { const int kt_ = wid + 8 * ((I0) + j_); \
        IDX_REPC(K) \
          \
        IDX_SCORE8(K) \
        unsigned k01_ = mono16x2((f32x2_t){s0_ + l_[0], s1_ + l_[1]}), k23_ = mono16x2((f32x2_t){s2_ + l_[2], s3_ + l_[3]}); \
        if (kt_ == ntile - 1) { const int lim_ = t0 + fr - kt_ * 16 - fq * 4;            \
            k01_ &= (lim_ >= 0 ? 0xffffu : 0u) | (lim_ >= 1 ? 0xffff0000u : 0u); k23_ &= (lim_ >= 2 ? 0xffffu : 0u) | (lim_ >= 3 ? 0xffff0000u : 0u); } \
        u32x2 w_; w_.x = k01_; w_.y = k23_; \
        *(LAS u32x2*)(C.lds + fr * IDX_RS + (kt_ * 16 + fq * 4) * 2) = w_; IDX_REPC_END } } } while (0)
#ifdef IDX_REP_MFMA
    for (int rep_ = 0; rep_ < 2; ++rep_)
#endif
    { bf16x8 ka[4][2], kb[4][2], kc[4][2];
      IDX_LOAD4(ka, 0); IDX_LOAD4(kb, 4);
      for (int i0 = 0; i0 < nmine;) {
          IDX_LOAD4(kc, i0 + 8);
          IDX_COMP4(ka, i0);
          i0 += 4; if (i0 >= nmine) break;
          IDX_LOAD4(ka, i0 + 8);
          IDX_COMP4(kb, i0);
          i0 += 4; if (i0 >= nmine) break;
          IDX_LOAD4(kb, i0 + 8);
          IDX_COMP4(kc, i0);
          i0 += 4;
      } }
#undef IDX_LOAD4
#undef IDX_COMP4
    {
      const int p0 = 16 * ntile, ng = ((((p0 + 511) >> 9) << 9) - p0) >> 3;
      for (int i = C.tid; i < ng * 16; i += NTHR) { const int row = i / ng, g = i - row * ng; u32x4 z = {0u, 0u, 0u, 0u}; *(LAS u32x4*)(C.lds + row * IDX_RS + (p0 + 8 * g) * 2) = z; } }
    __syncthreads();
#ifdef IDX_REP_SEL
#define IDX_NRR 4
#else
#define IDX_NRR 2
#endif
    unsigned lmv = 0u;
#pragma unroll 1
    for (int rr_ = 0; rr_ < IDX_NRR; ++rr_) {
        const int rr = rr_ & 1;
        const int q = 2 * wid + rr, t = t0 + q;
        unsigned char* mrow = maskb + ((size_t)b * 64 * 4096 + t) * 8 + (size_t)(lane >> 3) * 32768 + (lane & 7);
        if (t < 256) {
#pragma unroll
            for (int j = 0; j < 8; ++j) { int nb = t + 1 - (64 * j + lane) * 8; nb = nb < 0 ? 0 : (nb > 8 ? 8 : nb);
                mrow[(size_t)j * 262144] = (unsigned char)(((1u << ((nb + 1) >> 1)) - 1u) | (((1u << (nb >> 1)) - 1u) << 4)); }
            lmv = umax_(lmv, (unsigned)(4095 - t));
            continue;
        }
#define IDX_TPERM(N, S, SELLO, SELHI) _Pragma("unroll") for (int k = 0; k < (N); ++k) { if ((k & (S)) == 0) { const unsigned a_ = w[k], b_ = w[k + (S)]; \
            w[k] = __builtin_amdgcn_perm(a_, b_, SELLO); w[k + (S)] = __builtin_amdgcn_perm(a_, b_, SELHI); } }
#define IDX_TBFI(N, S, M) _Pragma("unroll") for (int k = 0; k < (N); ++k) { if ((k & (S)) == 0) { const unsigned a_ = w[k], b_ = w[k + (S)]; unsigned lo_, hi_; \
            asm("v_bfi_b32 %0, %1, %2, %3" : "=v"(lo_) : "s"(M), "v"(a_), "v"(b_ << (S))); asm("v_bfi_b32 %0, %1, %2, %3" : "=v"(hi_) : "s"(M), "v"(a_ >> (S)), "v"(b_)); w[k] = lo_; w[k + (S)] = hi_; } }
        unsigned ce, co, ae, ao, cnt_above = 0u;
#ifndef IDX_NOHALF
        if (t0 + 15 < 2048) {
            unsigned w[16];
#pragma unroll
            for (int j = 0; j < 4; ++j) {
                u32x4 v = {0u, 0u, 0u, 0u};
                if (512 * j <= t0 + 15) v = *(const LAS u32x4*)(C.lds + q * IDX_RS + (64 * j + lane) * 16);
                w[4 * j] = v[0]; w[4 * j + 1] = v[1]; w[4 * j + 2] = v[2]; w[4 * j + 3] = v[3];
            }
            IDX_TPERM(16, 8, 0x02060004u, 0x03070105u) IDX_TBFI(16, 4, 0x0f0f0f0fu) IDX_TBFI(16, 2, 0x33333333u) IDX_TBFI(16, 1, 0x55555555u)
            unsigned cand = 0xffffffffu, above = 0u;
#pragma unroll
            for (int b = 15; b >= 0; --b) {
                const unsigned o = cand & w[b];
                const unsigned tot = wave_sum_dpp((unsigned)__builtin_popcount(o));
                if (cnt_above + tot >= 256u) { cand = o; }
                else { cnt_above += tot; above |= o; cand &= ~w[b]; }
            }
            ce = cand & 0xffffu; co = cand >> 16; ae = above & 0xffffu; ao = above >> 16;
        } else
#endif
        {
        unsigned w[32];
#pragma unroll
        for (int j = 0; j < 8; ++j) {
            u32x4 v = {0u, 0u, 0u, 0u};
            if (512 * j <= t0 + 15) v = *(const LAS u32x4*)(C.lds + q * IDX_RS + (64 * j + lane) * 16);
            w[4 * j] = v[0]; w[4 * j + 1] = v[1]; w[4 * j + 2] = v[2]; w[4 * j + 3] = v[3];
        }
        IDX_TPERM(32, 16, 0x01000504u, 0x03020706u) IDX_TPERM(32, 8, 0x02060004u, 0x03070105u) IDX_TBFI(32, 4, 0x0f0f0f0fu) IDX_TBFI(32, 2, 0x33333333u) IDX_TBFI(32, 1, 0x55555555u)
        ce = 0xffffffffu; co = 0xffffffffu; ae = 0u; ao = 0u;
#pragma unroll
        for (int b = 15; b >= 0; --b) {
            const unsigned oe = ce & w[b], oo = co & w[16 + b];
            const unsigned tot = wave_sum_dpp((unsigned)(__builtin_popcount(oe) + __builtin_popcount(oo)));
            if (cnt_above + tot >= 256u) { ce = oe; co = oo; }
            else { cnt_above += tot; ae |= oe; ao |= oo; ce &= ~w[b]; co &= ~w[16 + b]; }
        }
        }
#undef IDX_TPERM
#undef IDX_TBFI
        int excess = (int)wave_sum_dpp((unsigned)(__builtin_popcount(ce) + __builtin_popcount(co))) - (256 - (int)cnt_above);
        while (excess > 0) {
            const int ie = ce ? 31 - __builtin_clz(ce) : -1, io = co ? 31 - __builtin_clz(co) : -1;
            const int i0 = ie >= 0 ? 2 * ie : -1, i1 = io >= 0 ? 2 * io + 1 : -1, itop = i0 > i1 ? i0 : i1;
            const unsigned p = itop >= 0 ? (unsigned)((((itop >> 3) << 9) | (lane << 3) | (itop & 7)) + 1) : 0u;
            const unsigned pm = wave_max_dpp(p);
            if (p == pm && p != 0u) { if (itop & 1) co &= ~(1u << (itop >> 1)); else ce &= ~(1u << (itop >> 1)); }
            --excess;
        }
        const unsigned se = ae | ce, so = ao | co;
#pragma unroll
        for (int j = 0; j < 8; ++j) mrow[(size_t)j * 262144] = (unsigned char)(((se >> (4 * j)) & 0xfu) | (((so >> (4 * j)) & 0xfu) << 4));
        {
          const int ie = se ? 31 - __builtin_clz(se) : -1, io = so ? 31 - __builtin_clz(so) : -1;
          const int i0 = ie >= 0 ? 2 * ie : -1, i1 = io >= 0 ? 2 * io + 1 : -1, itop = i0 > i1 ? i0 : i1;
          const unsigned p = itop >= 0 ? (unsigned)(((itop >> 3) << 9) | (lane << 3) | (itop & 7)) : 0u;
          const unsigned Lq = wave_max_dpp(p);
          lmv = umax_(lmv, 4095u - Lq); }
    }
    { LAS unsigned* lm = (LAS unsigned*)(C.lds + 132096);
      if (lane == 0) lm[wid] = lmv;
      __syncthreads();
      if (C.tid == 0) { unsigned m_ = lm[0];
#pragma unroll
          for (int i = 1; i < 8; ++i) m_ = umax_(m_, lm[i]);
          ((unsigned*)(C.ws + WS_LMINV))[b * 256 + blk] = m_; } }
}

constexpr int HG_BC = 0, HG_KK = 32768, HG_Q4 = 65536, HG_R = 67584;
constexpr int HG_LBT = 131072;
constexpr int HG_ONB = HG_LBT + 2048;
__device__ __forceinline__ void hgrn_lbt_to_lds(Ctx& C, const float* onb = nullptr) { ((LAS float*)(C.lds + HG_LBT))[C.tid] = ((const float*)(C.ws + WS_LBT))[C.tid]; if (onb != nullptr && C.tid < 128) ((LAS float*)(C.lds + HG_ONB))[C.tid] = onb[C.tid]; __syncthreads(); }
struct HgIn { u32x4 fb0, fb1; unsigned iv[16]; };
struct HgOIn { u32x4 fb0, fb1, qb0, qb1, gb0, gb1; unsigned iv[16]; bf16x8 sf[8]; };
__device__ __forceinline__ void hg_rc(int unit, size_t& R0, int& cb) { const int bh = unit >> 6, n = unit & 63; R0 = (size_t)(bh >> 2) * SEQ + 64 * n; cb = (bh & 3) * 128; }
__device__ __forceinline__ void hg_ld16(Ctx& C, const bf16_t* X, int unit, u32x4& a, u32x4& b) {
    size_t R0; int cb; hg_rc(unit, R0, cb); const bf16_t* p = X + (R0 + (C.tid >> 3)) * 512 + cb + (C.tid & 7) * 16; a = *(const u32x4*)p; b = *(const u32x4*)(p + 8); }
__device__ __forceinline__ void hg_ldiv(Ctx& C, int unit, unsigned (&iv)[16]) {
    size_t R0; int cb; hg_rc(unit, R0, cb); const bf16_t* p = WSP(WS_IB) + (R0 + 16 * (C.tid >> 7)) * 512 + cb + (C.tid & 127);
#pragma unroll
    for (int i = 0; i < 16; ++i) iv[i] = p[(size_t)i * 512]; }
__device__ __forceinline__ void hg_ldsf(Ctx& C, const bf16_t* SinT, int unit, bf16x8 (&sf)[8]) {
    const bf16_t* sp = SinT + (size_t)unit * 16384 + (size_t)(32 * (C.wave >> 1) + (C.lane & 31)) * 128 + 8 * (C.lane >> 5);
#pragma unroll
    for (int ks = 0; ks < 8; ++ks) sf[ks] = *(const bf16x8*)(sp + 16 * ks); }
__device__ __forceinline__ void hgrn_stage(Ctx& C, int cb, const float* lbin, u32x4 fb0, u32x4 fb1) {
    LAS float* Bc = (LAS float*)(C.lds + HG_BC); LAS float* KK = (LAS float*)(C.lds + HG_KK); LAS float* Q4 = (LAS float*)(C.lds + HG_Q4);
    const int tid = C.tid;
    { const int row = tid >> 3, seg = tid & 7;
      float fp[16]; { float a[8], b[8]; unpack8(fb0, a); unpack8(fb1, b);
#pragma unroll
          for (int i = 0; i < 8; ++i) { fp[i] = a[i]; fp[8 + i] = b[i]; } }
      float lbv[16]; { const LAS f32x4* lp = (const LAS f32x4*)(C.lds + HG_LBT + (cb + seg * 16) * 4);
#pragma unroll
          for (int i = 0; i < 4; ++i) { const f32x4 t_ = lp[i]; lbv[4 * i] = t_.x; lbv[4 * i + 1] = t_.y; lbv[4 * i + 2] = t_.z; lbv[4 * i + 3] = t_.w; } }
#pragma unroll
      for (int i = 0; i < 16; ++i) { const float lb = lbv[i];
          const float f = lb + (1.f - lb) * sigm(fp[i]);
          Bc[row * 128 + seg * 16 + i] = __builtin_amdgcn_logf(f);
          KK[row * 128 + seg * 16 + i] = 1.f - f; } }
    __syncthreads();
    const int col = tid & 127, q = tid >> 7;
    float pre[16];
#pragma unroll
    for (int r = 0; r < 16; ++r) pre[r] = Bc[(16 * q + r) * 128 + col];
    { float s = 0.f;
#pragma unroll
      for (int r = 0; r < 16; ++r) { s += pre[r]; pre[r] = s; }
      Q4[q * 128 + col] = s; }
    __syncthreads();
    { const float o0 = Q4[col], o1 = Q4[128 + col], o2 = Q4[256 + col];
      const float off = (q > 0 ? o0 : 0.f) + (q > 1 ? o1 : 0.f) + (q > 2 ? o2 : 0.f);
#pragma unroll
      for (int r = 0; r < 16; ++r) Bc[(16 * q + r) * 128 + col] = pre[r] + off; }
    __syncthreads();
}
__device__ __forceinline__ void hgrn_stage_vT(Ctx& C, LAS bf16_t* vsT, const unsigned (&t)[16]) {
    const int v = C.tid & 127, sq = C.tid >> 7;
    u32x4 w0, w1; w0.x = t[0] | (t[1] << 16); w0.y = t[2] | (t[3] << 16); w0.z = t[4] | (t[5] << 16); w0.w = t[6] | (t[7] << 16);
    w1.x = t[8] | (t[9] << 16); w1.y = t[10] | (t[11] << 16); w1.z = t[12] | (t[13] << 16); w1.w = t[14] | (t[15] << 16);
    *(LAS u32x4*)(vsT + v * 72 + 16 * sq) = w0; *(LAS u32x4*)(vsT + v * 72 + 16 * sq + 8) = w1;
}
__device__ __forceinline__ void hgrn_local_unit(Ctx& C, int unit, int unext, HgIn& R, bf16_t* LcT, float* DEC, const float* lbin) {
    size_t R0; int cb; hg_rc(unit, R0, cb);
    LAS float* Bc = (LAS float*)(C.lds + HG_BC); LAS float* KK = (LAS float*)(C.lds + HG_KK);
    LAS bf16_t* kdecT = (LAS bf16_t*)(C.lds + HG_R); LAS bf16_t* vsT = (LAS bf16_t*)(C.lds + HG_R + 18432);
    { const u32x4 f0 = R.fb0, f1 = R.fb1; hg_ld16(C, WSP(WS_FB), unext, R.fb0, R.fb1); hgrn_stage(C, cb, lbin, f0, f1); }
    { const int d = C.tid & 127, sq = C.tid >> 7; const float bl = Bc[63 * 128 + d];
      unsigned w[8];
#pragma unroll
      for (int i = 0; i < 8; ++i) { const int s0 = 16 * sq + 2 * i;
          const float a = KK[s0 * 128 + d] * ex2(bl - Bc[s0 * 128 + d]), bb = KK[(s0 + 1) * 128 + d] * ex2(bl - Bc[(s0 + 1) * 128 + d]);
          w[i] = pk2(a, bb); }
      u32x4 w0 = {w[0], w[1], w[2], w[3]}, w1 = {w[4], w[5], w[6], w[7]};
      *(LAS u32x4*)(kdecT + d * 72 + 16 * sq) = w0; *(LAS u32x4*)(kdecT + d * 72 + 16 * sq + 8) = w1; }
    hgrn_stage_vT(C, vsT, R.iv); hg_ldiv(C, unext, R.iv);
#ifdef DUP_IV
    { unsigned x_[16]; hg_ldiv(C, unext, x_); asm volatile("" :: "v"(x_[0]), "v"(x_[1]), "v"(x_[2]), "v"(x_[3]), "v"(x_[4]), "v"(x_[5]), "v"(x_[6]), "v"(x_[7]), "v"(x_[8]), "v"(x_[9]), "v"(x_[10]), "v"(x_[11]), "v"(x_[12]), "v"(x_[13]), "v"(x_[14]), "v"(x_[15])); }
#endif
    if (C.tid < 128) DEC[(size_t)unit * 128 + C.tid] = ex2(Bc[63 * 128 + C.tid]);
    __syncthreads();
    { const int r32 = C.lane & 31, hi = C.lane >> 5, vb = C.wave >> 1, dbp = C.wave & 1;
      f32x16 c0, c1;
#pragma unroll
      for (int r = 0; r < 16; ++r) { c0[r] = 0.f; c1[r] = 0.f; }
#pragma unroll
      for (int ks = 0; ks < 4; ++ks) {
          const bf16x8 a = *(const LAS bf16x8*)(vsT + (32 * vb + r32) * 72 + 16 * ks + 8 * hi);
          const bf16x8 b0 = *(const LAS bf16x8*)(kdecT + (64 * dbp + r32) * 72 + 16 * ks + 8 * hi);
          const bf16x8 b1 = *(const LAS bf16x8*)(kdecT + (64 * dbp + 32 + r32) * 72 + 16 * ks + 8 * hi);
          c0 = mfma32(a, b0, c0); c1 = mfma32(a, b1, c1); }
      bf16_t* o = LcT + (size_t)unit * 16384;
#pragma unroll
      for (int r = 0; r < 16; ++r) { const int v = 32 * vb + crow(r, hi); o[v * 128 + 64 * dbp + r32] = f2bf(c0[r]); o[v * 128 + 64 * dbp + 32 + r32] = f2bf(c1[r]); } }
    __syncthreads();
}
__device__ __forceinline__ void hgrn_scan(Ctx& C, const bf16_t* __restrict__ LcT, const float* __restrict__ DEC, bf16_t* __restrict__ SinT) {
#ifndef SCAN_G
#define SCAN_G 32
#endif
    for (int gid = C.bid * NTHR + C.tid; gid < 32 * 4096; gid += C.G * NTHR) {
        const int bh = gid >> 12, quad = gid & 4095, v = quad >> 5, d0 = (quad & 31) * 4;
        float st[4] = {0.f, 0.f, 0.f, 0.f};
        const size_t e0 = (size_t)(bh * 64) * 16384 + v * 128 + d0;
        u32x2 lcA[SCAN_G], lcB[SCAN_G];
#define SCAN_LOAD(LC, N0) _Pragma("unroll") for (int i = 0; i < SCAN_G; ++i) { LC[i] = *(const u32x2*)(LcT + e0 + (size_t)((N0) + i) * 16384); }
        SCAN_LOAD(lcA, 0)
        { const f32x4* dsrc = (const f32x4*)(DEC + (size_t)(bh * 64) * 128); LAS f32x4* ddst = (LAS f32x4*)C.lds;
          f32x4 t_[4];
#pragma unroll
          for (int i = 0; i < 4; ++i) t_[i] = dsrc[C.tid + i * NTHR];
#pragma unroll
          for (int i = 0; i < 4; ++i) ddst[C.tid + i * NTHR] = t_[i]; }
        __syncthreads();
        const LAS float* dl = (const LAS float*)C.lds + d0;
#define SCAN_RUN(LC, N0) _Pragma("unroll") for (int i = 0; i < SCAN_G; ++i) { u32x2 w; w.x = pk2(st[0], st[1]); w.y = pk2(st[2], st[3]); *(u32x2*)(SinT + e0 + (size_t)((N0) + i) * 16384) = w; \
            const f32x4 dc = *(const LAS f32x4*)(dl + ((N0) + i) * 128); \
            st[0] = dc.x * st[0] + bf2f(LC[i].x & 0xffffu); st[1] = dc.y * st[1] + bf2f(LC[i].x >> 16); st[2] = dc.z * st[2] + bf2f(LC[i].y & 0xffffu); st[3] = dc.w * st[3] + bf2f(LC[i].y >> 16); }
#pragma unroll 1
        for (int n0 = 0; n0 < 64; n0 += 2 * SCAN_G) {
            SCAN_LOAD(lcB, n0 + SCAN_G)
            SCAN_RUN(lcA, n0)
            if (n0 + 2 * SCAN_G < 64) { SCAN_LOAD(lcA, n0 + 2 * SCAN_G) }
            SCAN_RUN(lcB, n0 + SCAN_G)
        }
#undef SCAN_LOAD
#undef SCAN_RUN
        __syncthreads();
    }
}
__device__ __forceinline__ void hgrn_out_unit(Ctx& C, int unit, int unext, HgOIn& R, const bf16_t* SinT, const float* lbin, const float* onb) {
    size_t R0; int cb; hg_rc(unit, R0, cb);
    LAS float* Bc = (LAS float*)(C.lds + HG_BC); LAS float* KK = (LAS float*)(C.lds + HG_KK);
    LAS bf16_t* QTl = (LAS bf16_t*)(C.lds + HG_R); LAS bf16_t* KTl = (LAS bf16_t*)(C.lds + HG_R + 17408);
    LAS bf16_t* vsT = (LAS bf16_t*)(C.lds + HG_R + 34816); LAS bf16_t* Pl = (LAS bf16_t*)(C.lds + HG_R + 34816 + 18432);
    LAS float* OF = (LAS float*)(C.lds + 0);
    { const u32x4 f0 = R.fb0, f1 = R.fb1; hg_ld16(C, WSP(WS_FB), unext, R.fb0, R.fb1); hgrn_stage(C, cb, lbin, f0, f1);
#ifdef HGO_REP_A
      hgrn_stage(C, cb, lbin, f0, f1);
#endif
    }
#ifdef HGO_REP_B
    for (int rb_ = 0; rb_ < 2; ++rb_)
#endif
    { const int row = C.tid >> 3, seg = C.tid & 7;
      float qv[16]; { float a[8], bq[8]; unpack8(R.qb0, a); unpack8(R.qb1, bq);
#pragma unroll
          for (int i = 0; i < 8; ++i) { qv[i] = a[i]; qv[8 + i] = bq[i]; } }
#ifdef HGO_REP_B
      if (rb_ == 1)
#endif
      hg_ld16(C, WSP(WS_QB), unext, R.qb0, R.qb1);
      unsigned wq[8], wk[8];
#pragma unroll
      for (int i = 0; i < 8; ++i) { const int d = seg * 16 + 2 * i;
          const float b0 = Bc[row * 128 + d], b1 = Bc[row * 128 + d + 1];
          wq[i] = pk2(qv[2 * i] * ex2(b0), qv[2 * i + 1] * ex2(b1));
          wk[i] = pk2(KK[row * 128 + d] * ex2(-b0), KK[row * 128 + d + 1] * ex2(-b1)); }
      u32x4 a0 = {wq[0], wq[1], wq[2], wq[3]}, a1 = {wq[4], wq[5], wq[6], wq[7]}, k0 = {wk[0], wk[1], wk[2], wk[3]}, k1 = {wk[4], wk[5], wk[6], wk[7]};
      *(LAS u32x4*)(QTl + row * 136 + seg * 16) = a0; *(LAS u32x4*)(QTl + row * 136 + seg * 16 + 8) = a1;
      *(LAS u32x4*)(KTl + row * 136 + seg * 16) = k0; *(LAS u32x4*)(KTl + row * 136 + seg * 16 + 8) = k1; }
    hgrn_stage_vT(C, vsT, R.iv); hg_ldiv(C, unext, R.iv);
#ifdef DUP_IV
    { unsigned x_[16]; hg_ldiv(C, unext, x_); asm volatile("" :: "v"(x_[0]), "v"(x_[1]), "v"(x_[2]), "v"(x_[3]), "v"(x_[4]), "v"(x_[5]), "v"(x_[6]), "v"(x_[7]), "v"(x_[8]), "v"(x_[9]), "v"(x_[10]), "v"(x_[11]), "v"(x_[12]), "v"(x_[13]), "v"(x_[14]), "v"(x_[15])); }
#endif
    __syncthreads();
    const int r32 = C.lane & 31, hi = C.lane >> 5;
#ifdef HGO_REP_C
    for (int rc_ = 0; rc_ < 2; ++rc_) {
    if (rc_) __syncthreads();
#else
    {
#endif
    if (C.wave < 4) {
        const int tb = C.wave >> 1, sb = C.wave & 1;
        f32x16 c;
#pragma unroll
        for (int r = 0; r < 16; ++r) c[r] = 0.f;
        if (!(tb == 0 && sb == 1)) {
#pragma unroll
            for (int ks = 0; ks < 8; ++ks) {
                const bf16x8 a = *(const LAS bf16x8*)(QTl + (32 * tb + r32) * 136 + 16 * ks + 8 * hi);
                const bf16x8 bb = *(const LAS bf16x8*)(KTl + (32 * sb + r32) * 136 + 16 * ks + 8 * hi);
                c = mfma32(a, bb, c); }
        }
#pragma unroll
        for (int r = 0; r < 16; ++r) { const int t = 32 * tb + crow(r, hi), s = 32 * sb + r32; Pl[t * 72 + s] = f2bf((s <= t) ? c[r] : 0.f); }
    }
    __syncthreads();
    { const int tb = C.wave & 1, vb = C.wave >> 1;
      f32x16 c;
#pragma unroll
      for (int r = 0; r < 16; ++r) c[r] = 0.f;
#pragma unroll
      for (int ks = 0; ks < 4; ++ks) {
          const bf16x8 a = *(const LAS bf16x8*)(Pl + (32 * tb + r32) * 72 + 16 * ks + 8 * hi);
          const bf16x8 bb = *(const LAS bf16x8*)(vsT + (32 * vb + r32) * 72 + 16 * ks + 8 * hi);
          c = mfma32(a, bb, c); }
#pragma unroll
      for (int ks = 0; ks < 8; ++ks) {
          const bf16x8 a = *(const LAS bf16x8*)(QTl + (32 * tb + r32) * 136 + 16 * ks + 8 * hi);
          c = mfma32(a, R.sf[ks], c); }
#ifdef HGO_REP_C
      if (rc_ == 1)
#endif
      hg_ldsf(C, SinT, unext, R.sf);
#ifdef DUP_SF
      { bf16x8 x_[8]; hg_ldsf(C, SinT, unext ^ 1, x_); asm volatile("" :: "v"(x_[0]), "v"(x_[1]), "v"(x_[2]), "v"(x_[3]), "v"(x_[4]), "v"(x_[5]), "v"(x_[6]), "v"(x_[7])); }
#endif
#pragma unroll
      for (int r = 0; r < 16; ++r) OF[(32 * tb + crow(r, hi)) * 132 + 32 * vb + r32] = c[r]; }
    }
    __syncthreads();
#ifdef HGO_REP_D
    for (int rd_ = 0; rd_ < 2; ++rd_)
#endif
    { const int row = C.tid >> 3, seg = C.tid & 7;
      float o[16]; float ss = 0.f;
#pragma unroll
      for (int i = 0; i < 16; ++i) { o[i] = OF[row * 132 + seg * 16 + i]; ss += o[i] * o[i]; }
      ss += __shfl_xor(ss, 1); ss += __shfl_xor(ss, 2); ss += __shfl_xor(ss, 4);
      const float rs = 1.f / sqrtf(ss * (1.f / 128.f) + EPS);
      float g[16]; { float a[8], bq[8]; unpack8(R.gb0, a); unpack8(R.gb1, bq);
#pragma unroll
          for (int i = 0; i < 8; ++i) { g[i] = a[i]; g[8 + i] = bq[i]; } }
#ifdef HGO_REP_D
      if (rd_ == 1)
#endif
      hg_ld16(C, WSP(WS_GB), unext, R.gb0, R.gb1);
      float ov[16];
#pragma unroll
      for (int i = 0; i < 16; ++i) ov[i] = o[i] * (rs * O8_SCALE) * ((const LAS float*)(C.lds + HG_ONB))[seg * 16 + i] * g[i];
      u32x4 w8; w8.x = pk4_fp8(ov[0], ov[1], ov[2], ov[3]); w8.y = pk4_fp8(ov[4], ov[5], ov[6], ov[7]); w8.z = pk4_fp8(ov[8], ov[9], ov[10], ov[11]); w8.w = pk4_fp8(ov[12], ov[13], ov[14], ov[15]);
      *(u32x4*)(C.ws + WS_O8B + (size_t)(R0 + row) * 512 + cb + seg * 16) = w8; }
    __syncthreads();
}

template <int D, bool MASKED, bool QN>
__device__ __forceinline__ void attn_unit(Ctx& C, const float* qgain, float qscale, const bf16_t* Qu, int ldq, const bf16_t* Kh, const bf16_t* Vh, int ldkv, const bf16_t* Zu, bf16_t* Ou, int ldo,
                                          int ntiles, const unsigned long long* mask_u, float sl2, int kvref) {
    constexpr int KS = D + 8, VS = 72, NDB = D / 32, NKS = D / 16;
    LAS bf16_t* Kt = (LAS bf16_t*)C.lds; LAS bf16_t* Vt = (LAS bf16_t*)(C.lds + 64 * KS * 2);
    const int tid = C.tid, wid = C.wave, lane = C.lane, r32 = lane & 31, hi = lane >> 5;
    bf16x8 qr[NKS];
    { const bf16_t* Qw = Qu + (size_t)(wid * 32 + r32) * ldq;
#pragma unroll
      for (int ks = 0; ks < NKS; ++ks) qr[ks] = *(const bf16x8*)(Qw + ks * 16 + hi * 8); }
    if (QN) {
        float ss = 0.f;
#pragma unroll
        for (int ks = 0; ks < NKS; ++ks) { float f[8]; unpack8(__builtin_bit_cast(u32x4, qr[ks]), f);
#pragma unroll
            for (int i = 0; i < 8; ++i) ss += f[i] * f[i]; }
        ss += __shfl_xor(ss, 32);
        const float rs = qscale / sqrtf(ss * (1.f / (float)D) + EPS);
#pragma unroll
        for (int ks = 0; ks < NKS; ++ks) { float f[8]; unpack8(__builtin_bit_cast(u32x4, qr[ks]), f); const float* gp = qgain + ks * 16 + hi * 8;
            u32x4 w; w.x = pk2(f[0] * rs * gp[0], f[1] * rs * gp[1]); w.y = pk2(f[2] * rs * gp[2], f[3] * rs * gp[3]); w.z = pk2(f[4] * rs * gp[4], f[5] * rs * gp[5]); w.w = pk2(f[6] * rs * gp[6], f[7] * rs * gp[7]);
            qr[ks] = __builtin_bit_cast(bf16x8, w); }
    }
    f32x16 o[NDB];
#pragma unroll
    for (int db = 0; db < NDB; ++db)
#pragma unroll
        for (int r = 0; r < 16; ++r) o[db][r] = 0.f;
    float m = -1e30f, l = 0.f;
    for (int j = 0; j < ntiles; ++j) {
        __syncthreads();
        for (int i = tid; i < 64 * D / 8; i += NTHR) { const int key = i / (D / 8), seg = i % (D / 8);
            *(LAS u32x4*)(Kt + key * KS + seg * 8) = *(const u32x4*)(Kh + (size_t)(64 * j + key) * ldkv + seg * 8); }
        { constexpr int NK = 64 / (NTHR / D); const int d = tid % D, sq = tid / D;
          const bf16_t* vp = Vh + (size_t)(64 * j + sq * NK) * ldkv + d;
          unsigned t[NK];
#pragma unroll
          for (int i = 0; i < NK; ++i) t[i] = vp[(size_t)i * ldkv];
#pragma unroll
          for (int c = 0; c < NK / 8; ++c) { u32x4 w; w.x = t[8 * c] | (t[8 * c + 1] << 16); w.y = t[8 * c + 2] | (t[8 * c + 3] << 16); w.z = t[8 * c + 4] | (t[8 * c + 5] << 16); w.w = t[8 * c + 6] | (t[8 * c + 7] << 16);
              *(LAS u32x4*)(Vt + d * VS + sq * NK + c * 8) = w; } }
        __syncthreads();
        f32x16 p0, p1;
#pragma unroll
        for (int r = 0; r < 16; ++r) { p0[r] = 0.f; p1[r] = 0.f; }
#pragma unroll
        for (int ks = 0; ks < NKS; ++ks) {
            const bf16x8 a0 = *(const LAS bf16x8*)(Kt + r32 * KS + ks * 16 + hi * 8);
            const bf16x8 a1 = *(const LAS bf16x8*)(Kt + (32 + r32) * KS + ks * 16 + hi * 8);
            p0 = mfma32(a0, qr[ks], p0); p1 = mfma32(a1, qr[ks], p1); }
        if (MASKED) {
            const unsigned long long w = mask_u[(size_t)(wid * 32 + r32) * 64 + j];
            const unsigned wlo = (unsigned)w >> (4 * hi), whi = (unsigned)(w >> 32) >> (4 * hi);
            const float bb = sl2 * (float)(64 * j + 4 * hi - kvref);
#pragma unroll
            for (int r = 0; r < 16; ++r) { const int kc = (r & 3) + 8 * (r >> 2);
                p0[r] = ((wlo >> kc) & 1u) ? p0[r] + (bb + sl2 * (float)kc) : -INFINITY;
                p1[r] = ((whi >> kc) & 1u) ? p1[r] + (bb + sl2 * (float)(kc + 32)) : -INFINITY; }
        }
        float mt = fmaxf(p0[0], p1[0]);
#pragma unroll
        for (int r = 1; r < 16; ++r) mt = fmaxf(mt, fmaxf(p0[r], p1[r]));
        mt = fmaxf(mt, __shfl_xor(mt, 32));
        const float mn = fmaxf(m, mt), alpha = ex2(m - mn); m = mn;
        float s = 0.f;
#pragma unroll
        for (int r = 0; r < 16; ++r) { p0[r] = ex2(p0[r] - mn); p1[r] = ex2(p1[r] - mn); s += p0[r] + p1[r]; }
        l = l * alpha + s;
#pragma unroll
        for (int r = 0; r < 16; ++r) { const float a = __shfl(alpha, crow(r, hi));
#pragma unroll
            for (int db = 0; db < NDB; ++db) o[db][r] *= a; }
        bf16x8 pa[4];
        { u32x4 w;
          w.x = pk2(p0[0], p0[1]); w.y = pk2(p0[2], p0[3]); w.z = pk2(p0[4], p0[5]); w.w = pk2(p0[6], p0[7]); pa[0] = __builtin_bit_cast(bf16x8, w);
          w.x = pk2(p0[8], p0[9]); w.y = pk2(p0[10], p0[11]); w.z = pk2(p0[12], p0[13]); w.w = pk2(p0[14], p0[15]); pa[1] = __builtin_bit_cast(bf16x8, w);
          w.x = pk2(p1[0], p1[1]); w.y = pk2(p1[2], p1[3]); w.z = pk2(p1[4], p1[5]); w.w = pk2(p1[6], p1[7]); pa[2] = __builtin_bit_cast(bf16x8, w);
          w.x = pk2(p1[8], p1[9]); w.y = pk2(p1[10], p1[11]); w.z = pk2(p1[12], p1[13]); w.w = pk2(p1[14], p1[15]); pa[3] = __builtin_bit_cast(bf16x8, w); }
#pragma unroll
        for (int s4 = 0; s4 < 4; ++s4)
#pragma unroll
            for (int db = 0; db < NDB; ++db) {
                const LAS bf16_t* vp = Vt + (db * 32 + r32) * VS + s4 * 16 + hi * 4;
                const u32x2 lo = *(const LAS u32x2*)vp, h2 = *(const LAS u32x2*)(vp + 8);
                u32x4 w = {lo.x, lo.y, h2.x, h2.y};
                o[db] = mfma32(pa[s4], __builtin_bit_cast(bf16x8, w), o[db]); }
    }
    l += __shfl_xor(l, 32);
    const float inv = 1.f / l;
#pragma unroll
    for (int r = 0; r < 16; ++r) { const int q = crow(r, hi); const float iq = __shfl(inv, q); const size_t off = (size_t)(wid * 32 + q) * ldo;
#pragma unroll
        for (int db = 0; db < NDB; ++db) { const int d = db * 32 + r32; const float z = bf2f(Zu[off + d]); Ou[off + d] = f2bf(o[db][r] * iq * z); } }
}
__device__ __forceinline__ void cross_unit(Ctx& C, int b, int h, int qpair, const float* qgain) {
    constexpr int KS = 136, VS = 264;
    LAS bf16_t* Kt = (LAS bf16_t*)C.lds; LAS bf16_t* Vt = (LAS bf16_t*)(C.lds + 256 * KS * 2);
    int tid = C.tid; asm volatile("" : "+v"(tid));
    const int wid = C.wave, lane = tid & 63, r32 = lane & 31, hi = lane >> 5;
    LAS float* wsf = (LAS float*)(C.lds + 256 * KS * 2 + 128 * VS * 2) + wid * 32 + 4 * hi;
    const bf16_t* Kh = WSP(WS_MKV) + (size_t)b * MEMLEN * 512 + h * 128;
    const bf16_t* Vh = WSP(WS_MKVT) + (size_t)h * 128 * TM + b * MEMLEN;
    { u32x4 kv[8], vv[8];
#pragma unroll
      for (int c = 0; c < 8; ++c) { const int i = tid + c * NTHR; kv[c] = *(const u32x4*)(Kh + (size_t)(i >> 4) * 512 + (i & 15) * 8); }
#pragma unroll
      for (int c = 0; c < 8; ++c) { const int i = tid + c * NTHR; vv[c] = *(const u32x4*)(Vh + (size_t)(i >> 5) * TM + (i & 31) * 8); }
#pragma unroll
      for (int c = 0; c < 8; ++c) { const int i = tid + c * NTHR; *(LAS u32x4*)(Kt + (i >> 4) * KS + (i & 15) * 8) = kv[c]; }
#pragma unroll
      for (int c = 0; c < 8; ++c) { const int i = tid + c * NTHR; *(LAS u32x4*)(Vt + (i >> 5) * VS + (i & 31) * 8) = vv[c]; }
      if (tid < 128) ((LAS float*)(C.lds + 139264))[tid] = qgain[tid]; }
    __syncthreads();
#pragma unroll 1
    for (int qq = 0; qq < 2; ++qq) {
        const size_t qrow = (size_t)b * SEQ + (size_t)(qpair * 2 + qq) * 256 + wid * 32;
        const bf16_t* Qw = WSP(WS_QC) + qrow * 512 + h * 128; const bf16_t* Zw = WSP(WS_ZC) + qrow * 512 + h * 128; unsigned char* O8w = C.ws + WS_O8C + qrow * 512 + h * 128;
        bf16x8 qr[8];
#pragma unroll
        for (int ks = 0; ks < 8; ++ks) qr[ks] = *(const bf16x8*)(Qw + (size_t)r32 * 512 + ks * 16 + hi * 8);
        int lo_ = hi * 2048 + r32 * 4; asm volatile("" : "+v"(lo_));
        u32x2 zv[16];
#pragma unroll
        for (int r = 0; r < 16; ++r) zv[r] = *(const u32x2*)(Zw + (unsigned)((r & 3) + 8 * (r >> 2)) * 512u + (unsigned)lo_);
        { float ss = 0.f;
#pragma unroll
          for (int ks = 0; ks < 8; ++ks) { float f[8]; unpack8(__builtin_bit_cast(u32x4, qr[ks]), f);
#pragma unroll
              for (int i = 0; i < 8; ++i) ss += f[i] * f[i]; }
          ss += __shfl_xor(ss, 32);
          const float rs = C2C / sqrtf(ss * (1.f / 128.f) + EPS);
#pragma unroll
          for (int ks = 0; ks < 8; ++ks) { float f[8]; unpack8(__builtin_bit_cast(u32x4, qr[ks]), f); const LAS float* gp = (const LAS float*)(C.lds + 139264) + ks * 16 + hi * 8;
              u32x4 w; w.x = pk2(f[0] * rs * gp[0], f[1] * rs * gp[1]); w.y = pk2(f[2] * rs * gp[2], f[3] * rs * gp[3]); w.z = pk2(f[4] * rs * gp[4], f[5] * rs * gp[5]); w.w = pk2(f[6] * rs * gp[6], f[7] * rs * gp[7]);
              qr[ks] = __builtin_bit_cast(bf16x8, w); } }
        f32x16 o[4];
#pragma unroll
        for (int db = 0; db < 4; ++db)
#pragma unroll
            for (int r = 0; r < 16; ++r) o[db][r] = 0.f;
        float m = 0.f, l = 0.f;
#pragma unroll 1
        for (int j = 0; j < 4; ++j) {
            f32x16 p0, p1;
#pragma unroll
            for (int r = 0; r < 16; ++r) { p0[r] = -m; p1[r] = -m; }
#pragma unroll
            for (int ks = 0; ks < 8; ++ks) {
                const bf16x8 a0 = *(const LAS bf16x8*)(Kt + (64 * j + r32) * KS + ks * 16 + hi * 8);
                const bf16x8 a1 = *(const LAS bf16x8*)(Kt + (64 * j + 32 + r32) * KS + ks * 16 + hi * 8);
                p0 = mfma32(a0, qr[ks], p0); p1 = mfma32(a1, qr[ks], p1); }
            float mt = fmaxf(p0[0], p1[0]);
#pragma unroll
            for (int r = 1; r < 16; ++r) mt = fmaxf(mt, fmaxf(p0[r], p1[r]));
            mt = fmaxf(mt, __shfl_xor(mt, 32));
            const bool grow = (j == 0) || __any(mt > 8.f);
            float alpha = 1.f;
            if (grow) { const float dl = (j == 0) ? mt : fmaxf(mt, 0.f); alpha = (j == 0) ? 1.f : ex2(-dl); m += dl;
#pragma unroll
                for (int r = 0; r < 16; ++r) { p0[r] -= dl; p1[r] -= dl; } }
            float s_ = 0.f;
#pragma unroll
            for (int r = 0; r < 16; ++r) { p0[r] = ex2(p0[r]); p1[r] = ex2(p1[r]); s_ += p0[r] + p1[r]; }
            l = l * alpha + s_;
            if (j > 0 && grow) {
                if (hi == 0) wsf[r32] = alpha;
                asm volatile("s_waitcnt lgkmcnt(0)" ::: "memory");
#pragma unroll
                for (int r = 0; r < 16; ++r) { const float a = wsf[(r & 3) + 8 * (r >> 2)];
#pragma unroll
                    for (int db = 0; db < 4; ++db) o[db][r] *= a; }
                asm volatile("s_waitcnt lgkmcnt(0)" ::: "memory"); }
            bf16x8 pa[4];
            { u32x4 w;
              w.x = pk2(p0[0], p0[1]); w.y = pk2(p0[2], p0[3]); w.z = pk2(p0[4], p0[5]); w.w = pk2(p0[6], p0[7]); pa[0] = __builtin_bit_cast(bf16x8, w);
              w.x = pk2(p0[8], p0[9]); w.y = pk2(p0[10], p0[11]); w.z = pk2(p0[12], p0[13]); w.w = pk2(p0[14], p0[15]); pa[1] = __builtin_bit_cast(bf16x8, w);
              w.x = pk2(p1[0], p1[1]); w.y = pk2(p1[2], p1[3]); w.z = pk2(p1[4], p1[5]); w.w = pk2(p1[6], p1[7]); pa[2] = __builtin_bit_cast(bf16x8, w);
              w.x = pk2(p1[8], p1[9]); w.y = pk2(p1[10], p1[11]); w.z = pk2(p1[12], p1[13]); w.w = pk2(p1[14], p1[15]); pa[3] = __builtin_bit_cast(bf16x8, w); }
#pragma unroll
            for (int s4 = 0; s4 < 4; ++s4)
#pragma unroll
                for (int db = 0; db < 4; ++db) {
                    const LAS bf16_t* vp = Vt + (db * 32 + r32) * VS + 64 * j + s4 * 16 + hi * 4;
                    const u32x2 lo = *(const LAS u32x2*)vp, h2 = *(const LAS u32x2*)(vp + 8);
                    u32x4 w = {lo.x, lo.y, h2.x, h2.y};
                    o[db] = mfma32(pa[s4], __builtin_bit_cast(bf16x8, w), o[db]); }
        }
        l += __shfl_xor(l, 32);
        const float inv = 1.f / l;
        if (hi == 0) wsf[r32] = inv;
        asm volatile("s_waitcnt lgkmcnt(0)" ::: "memory");
#pragma unroll
        for (int r = 0; r < 16; ++r) { const float iq = wsf[(r & 3) + 8 * (r >> 2)] * O8_SCALE;
            const float z0 = bf2f(zv[r].x & 0xffffu), z1 = bf2f(zv[r].x >> 16), z2 = bf2f(zv[r].y & 0xffffu), z3 = bf2f(zv[r].y >> 16);
            *(unsigned*)(O8w + (unsigned)((r & 3) + 8 * (r >> 2)) * 512u + (unsigned)lo_) = pk4_fp8(o[0][r] * iq * z0, o[1][r] * iq * z1, o[2][r] * iq * z2, o[3][r] * iq * z3); }
        asm volatile("s_waitcnt lgkmcnt(0)" ::: "memory");
    }
    __syncthreads();
}
}
#define ATTN_OUT_FP8 16
#include <hip/hip_bf16.h>
#include <cmath>
namespace attn_a {
using bf16=__hip_bfloat16;
using bf16x8=__attribute__((ext_vector_type(8)))short;
using s16x4=__attribute__((ext_vector_type(4)))short;
using f32x16=__attribute__((ext_vector_type(16)))float;
using u32x4=__attribute__((ext_vector_type(4)))unsigned;
constexpr int BATCH=8,NHEAD=8,SEQ=4096,D=64,DM=NHEAD*D;
constexpr int NW=8,QBLK=32,QB=QBLK*NW,KVBLK=64,NQB=SEQ/QB;
constexpr int ATTN_PITCH=DM, ATTN_UNIT_ROWS=QB;
__device__ __forceinline__ int crow(int r,int hi){return (r&3)+8*(r>>2)+4*hi;}
#define SBAR() __builtin_amdgcn_sched_barrier(0)
__device__ __forceinline__ void kmask(f32x16&p0,f32x16&p1,unsigned long long M,float sl2,int hi){
  const unsigned wlo=(unsigned)M>>(2*hi), whi=(unsigned)(M>>32)>>(2*hi);
  #pragma unroll
  for(int r=0;r<16;++r){ const int kc=(r&3)+8*(r>>2), kb=8*(r>>2)+((r>>1)&1)+4*(r&1);
    const unsigned m0=(unsigned)(((int)(wlo<<(31-kb)))>>31), m1=(unsigned)(((int)(whi<<(31-kb)))>>31);
    const unsigned v0=__float_as_uint(p0[r]), v1=__float_as_uint(p1[r]); (void)kc; (void)sl2;
    unsigned r0_,r1_; asm("v_bfi_b32 %0, %1, %2, %3":"=v"(r0_):"v"(m0),"v"(v0),"s"(0xff800000u)); asm("v_bfi_b32 %0, %1, %2, %3":"=v"(r1_):"v"(m1),"v"(v1),"s"(0xff800000u));
    p0[r]=__uint_as_float(r0_); p1[r]=__uint_as_float(r1_); }
}

constexpr int NSLOT=3, SLOTB=8192;
constexpr int LDS_K=0, LDS_V=NSLOT*SLOTB, LDS_WS=2*NSLOT*SLOTB, LDS_OST=LDS_WS+NW*64*4, LDS_BYTES=LDS_OST+NW*4096;
constexpr float C2=0.125f*1.4426950408889634f;
__device__ __forceinline__ void glds16(const void*gsrc,unsigned lds_dst){unsigned keep;
  asm volatile("s_mov_b32 %0, m0\n\ts_mov_b32 m0, %2\n\ts_nop 0\n\tglobal_load_lds_dwordx4 %1, off\n\ts_mov_b32 m0, %0":"=&s"(keep):"v"(gsrc),"s"(lds_dst):"memory");}
__device__ __forceinline__ void glds4(const void*gsrc,unsigned lds_dst){unsigned keep;
  asm volatile("s_mov_b32 %0, m0\n\ts_mov_b32 m0, %2\n\ts_nop 0\n\tglobal_load_lds_dword %1, off\n\ts_mov_b32 m0, %0":"=&s"(keep):"v"(gsrc),"s"(lds_dst):"memory");}
__device__ __forceinline__ float max3f(float a,float b,float c){float r;asm("v_max3_f32 %0, %1, %2, %3":"=v"(r):"v"(a),"v"(b),"v"(c));return r;}
__device__ __forceinline__ float max2f(float a,float b){float r;asm("v_max_f32_e32 %0, %1, %2":"=v"(r):"v"(a),"v"(b));return r;}
__device__ __forceinline__ float fadd_s(float a,float b){float r;asm("v_add_f32_e32 %0, %1, %2":"=v"(r):"v"(a),"v"(b));return r;}
__device__ __forceinline__ float fsub_s(float a,float b){float r;asm("v_sub_f32_e32 %0, %1, %2":"=v"(r):"v"(a),"v"(b));return r;}
typedef float f32x2_t __attribute__((ext_vector_type(2))); typedef __bf16 bf16x2_t __attribute__((ext_vector_type(2)));
__device__ __forceinline__ unsigned cvtpk_s(float lo,float hi){f32x2_t v={lo,hi};bf16x2_t b=__builtin_convertvector(v,bf16x2_t);return __builtin_bit_cast(unsigned,b);}
#define WAIT_BAR(N) asm volatile("s_waitcnt vmcnt(" #N ") lgkmcnt(0)\n\ts_barrier":::"memory")

__device__ __forceinline__ void qkt(f32x16&p0,f32x16&p1,const char*Kslot,const bf16x8*qr,const f32x16&negm,int r32,int hi,bf16x8 kx0,bf16x8 kx1,bf16x8 qx){
  const char*kb=Kslot+hi*1024+r32*16;
  p0=__builtin_amdgcn_mfma_f32_32x32x16_bf16(kx0,qx,negm,0,0,0);p1=__builtin_amdgcn_mfma_f32_32x32x16_bf16(kx1,qx,negm,0,0,0);
  #pragma unroll
  for(int d0=0;d0<4;++d0){
    const bf16x8 b0=*reinterpret_cast<const bf16x8*>(kb+d0*2048);
    const bf16x8 b1=*reinterpret_cast<const bf16x8*>(kb+d0*2048+512);
    {p0=__builtin_amdgcn_mfma_f32_32x32x16_bf16(b0,qr[d0],p0,0,0,0);p1=__builtin_amdgcn_mfma_f32_32x32x16_bf16(b1,qr[d0],p1,0,0,0);}}
}
typedef __attribute__((address_space(3))) const char* lds_cptr;
typedef short v4i16_t __attribute__((ext_vector_type(4)));
__device__ __forceinline__ void kload8(bf16x8*kf,lds_cptr kp){
  kf[0]=*(const __attribute__((address_space(3))) bf16x8*)(kp);      kf[1]=*(const __attribute__((address_space(3))) bf16x8*)(kp+512);
  kf[2]=*(const __attribute__((address_space(3))) bf16x8*)(kp+2048); kf[3]=*(const __attribute__((address_space(3))) bf16x8*)(kp+2560);
  kf[4]=*(const __attribute__((address_space(3))) bf16x8*)(kp+4096); kf[5]=*(const __attribute__((address_space(3))) bf16x8*)(kp+4608);
  kf[6]=*(const __attribute__((address_space(3))) bf16x8*)(kp+6144); kf[7]=*(const __attribute__((address_space(3))) bf16x8*)(kp+6656);
}
__device__ __forceinline__ void kload2(bf16x8*kf,lds_cptr kp,int j){ kf[2*j]=*(const __attribute__((address_space(3))) bf16x8*)(kp+j*2048); kf[2*j+1]=*(const __attribute__((address_space(3))) bf16x8*)(kp+j*2048+512); }
__device__ __forceinline__ s16x4 vtr(lds_cptr p){ return __builtin_bit_cast(s16x4,__builtin_amdgcn_ds_read_tr16_b64_v4i16((__attribute__((address_space(3))) v4i16_t*)p)); }
__device__ __forceinline__ float rowmax(const f32x16&p0,const f32x16&p1){
  float a=max3f(p0[0],p0[1],p1[0]),b=max3f(p0[2],p0[3],p1[1]);a=max3f(a,p1[2],p1[3]);
  #pragma unroll
  for(int r=4;r<16;r+=4){a=max3f(a,p0[r],p0[r+1]);b=max3f(b,p0[r+2],p0[r+3]);a=max3f(a,p1[r],p1[r+1]);b=max3f(b,p1[r+2],p1[r+3]);}
  const float m=max2f(a,b);
  auto rr=__builtin_amdgcn_permlane32_swap(__float_as_uint(m),__float_as_uint(m),false,false);
  return max2f(__uint_as_float(rr[0]),__uint_as_float(rr[1]));
}
__device__ __forceinline__ void pv(f32x16*o,int vb,bf16x8 pa0,bf16x8 pa1,bf16x8 pa2,bf16x8 pa3){
  #pragma unroll
  for(int d0=0;d0<2;++d0){s16x4 lo[4],hi[4];
    #pragma unroll
    for(int ks=0;ks<4;++ks){
      asm volatile("ds_read_b64_tr_b16 %0,%1 offset:%c2":"=&v"(lo[ks]):"v"(vb),"i"(d0*4096+ks*1024):"memory");
      asm volatile("ds_read_b64_tr_b16 %0,%1 offset:%c2":"=&v"(hi[ks]):"v"(vb),"i"(d0*4096+ks*1024+512):"memory");}
    asm volatile("s_waitcnt lgkmcnt(0)":::"memory");SBAR();
    #define PK(k) (bf16x8){lo[k][0],lo[k][1],lo[k][2],lo[k][3],hi[k][0],hi[k][1],hi[k][2],hi[k][3]}
    o[d0]=__builtin_amdgcn_mfma_f32_32x32x16_bf16(pa0,PK(0),o[d0],0,0,0);
    o[d0]=__builtin_amdgcn_mfma_f32_32x32x16_bf16(pa1,PK(1),o[d0],0,0,0);
    o[d0]=__builtin_amdgcn_mfma_f32_32x32x16_bf16(pa2,PK(2),o[d0],0,0,0);
    o[d0]=__builtin_amdgcn_mfma_f32_32x32x16_bf16(pa3,PK(3),o[d0],0,0,0);
    #undef PK
  }
}

#ifndef ATTN_STORE16
#define ATTN_STORE16(p,v) (*(u32x4*)(p)=(v))
#endif
template<int THRL> __device__ __forceinline__ void attn_unit(int b,int h,int qb,const bf16*Q,const bf16*__restrict__ K,const bf16*__restrict__ V,bf16*O,const bf16*Z,const unsigned long long*MK,float sl2,int tstart,char*shm){
  int tid_=threadIdx.x; asm volatile("":"+v"(tid_));
  const int tid=tid_,lane=tid&63,r32=lane&31,hi=lane>>5; const int wid=__builtin_amdgcn_readfirstlane(tid>>6);
  const long rowbase=(long)b*SEQ; const int q0=qb*QB;
  const bf16*Qw=Q+(((rowbase+q0+wid*QBLK)>>5)*NHEAD+h)*2048;
  const bf16*Kh=K+(rowbase+(long)tstart*KVBLK)*DM+h*D,*Vh=V+(rowbase+(long)tstart*KVBLK)*DM+h*D;
  const unsigned lds0=(unsigned)(uintptr_t)shm;
  float*wsf=(float*)(shm+LDS_WS)+wid*64;
  const bf16*ksrc=Kh+(long)lane*DM+wid*8;
  const bf16*vsrc=Vh+(long)(16*(wid&3)+(lane>>2))*DM+(wid>>2)*32+(lane&3)*8;
  const unsigned kdst=lds0+LDS_K+wid*1024, vdst=lds0+LDS_V+wid*1024;
  #define DMA_K(t,slot) glds16(ksrc+(long)(t)*KVBLK*DM,(unsigned)__builtin_amdgcn_readfirstlane(kdst+(slot)))
  #define DMA_V(t,slot) glds16(vsrc+(long)(t)*KVBLK*DM,(unsigned)__builtin_amdgcn_readfirstlane(vdst+(slot)))
  const int vb0=(int)(lds0+LDS_V)+((lane>>4)&1)*32+(lane&3)*8+(4*hi+((lane&15)>>2))*64;
  const char*Kbase=shm+LDS_K; bf16x8 kf[8];
  const lds_cptr shm3=(lds_cptr)shm; const lds_cptr kp0=shm3+LDS_K+hi*1024+r32*16; const lds_cptr vp0=shm3+LDS_V+((lane>>4)&1)*32+(lane&3)*8+(4*hi+((lane&15)>>2))*64;
  const int NT=(q0+QB)/KVBLK-tstart;
  const unsigned*msrc=(const unsigned*)(MK+((size_t)(b*64+tstart))*4096+(q0+wid*QBLK+(lane>>1)))+(lane&1);
  const unsigned mdst=lds0+LDS_BYTES+wid*512; const lds_cptr mrd=(lds_cptr)shm+LDS_BYTES+wid*512+r32*8;
  glds4(msrc,(unsigned)__builtin_amdgcn_readfirstlane(mdst)); glds4(msrc+8192,(unsigned)__builtin_amdgcn_readfirstlane(mdst+256));
  DMA_K(0,0);DMA_V(0,0);DMA_K(1,SLOTB);
  bf16x8 qr[4];
  #pragma unroll
  for(int d0=0;d0<4;++d0)qr[d0]=*reinterpret_cast<const bf16x8*>(&Qw[d0*512+lane*8]);
  float mhat=0.f,l_reg=0.f;f32x16 o[2];o[0]=f32x16{};o[1]=f32x16{};
  const int qrel=wid*QBLK+r32;
  const float tbias=sl2*(float)(64*tstart-(q0+QB-1));
  f32x16 negm; _Pragma("unroll") for(int r=0;r<16;++r)negm[r]=tbias; asm volatile("":"+v"(negm));
  bf16x8 qx,kx0,kx1; float jt=0.f;
  { const float shi=__uint_as_float(cvtpk_s(sl2,0.f)<<16), slo=sl2-shi; const unsigned qw=hi?0u:cvtpk_s(shi,slo); const u32x4 q4={qw,qw,0u,0u}; qx=__builtin_bit_cast(bf16x8,q4);
    const u32x4 a4={cvtpk_s((float)r32,(float)r32),0u,0u,0u}, b4={cvtpk_s((float)(r32+32),(float)(r32+32)),0u,0u,0u}; kx0=__builtin_bit_cast(bf16x8,a4); kx1=__builtin_bit_cast(bf16x8,b4); }
  #define NEGM_SET() do{ const float nb_=tbias-mhat; _Pragma("unroll") for(int r=0;r<16;++r)negm[r]=nb_; asm volatile("":"+v"(negm)); }while(0)
  #define TILE_NEXT() do{ jt+=64.f; const unsigned tw_=cvtpk_s(jt,jt); u32x4 a_=__builtin_bit_cast(u32x4,kx0), b_=__builtin_bit_cast(u32x4,kx1); a_[1]=tw_; b_[1]=tw_; kx0=__builtin_bit_cast(bf16x8,a_); kx1=__builtin_bit_cast(bf16x8,b_); }while(0)
  #define MLOAD(boff,tt) glds4(msrc+(size_t)8192*(tt),(unsigned)__builtin_amdgcn_readfirstlane(mdst+(boff)))
  #define MWORD(boff) (*(const __attribute__((address_space(3))) unsigned long long*)(mrd+(boff)))
  #define CMASK(P0,P1,boff) kmask(P0,P1,MWORD(boff),sl2,hi)
  bool resc=false;
  #define START(P0,P1) do{ const float rm=rowmax(P0,P1); resc=false; \
    { const float dl=max2f(rm,-16000.f); mhat=fadd_s(mhat,dl); \
      _Pragma("unroll") for(int r=0;r<16;++r){P0[r]=fsub_s(P0[r],dl);P1[r]=fsub_s(P1[r],dl);} } \
    _Pragma("unroll") for(int r=0;r<16;++r)P0[r]=__builtin_amdgcn_exp2f(P0[r]); }while(0)
  #define RESC() do{ if(resc){ asm volatile("s_waitcnt lgkmcnt(0)":::"memory"); \
      _Pragma("unroll") for(int d_=0;d_<2;++d_) _Pragma("unroll") for(int r=0;r<16;++r)o[d_][r]*=wsf[crow(r,hi)]; } }while(0)
  f32x16 pA0,pA1,pB0,pB1;
  int sl_prev=0,sl_cur=0,sl_next=SLOTB;
  #define ROT() do{sl_prev=sl_cur;sl_cur=sl_next;sl_next=(sl_next==(NSLOT-1)*SLOTB)?0:sl_next+SLOTB;}while(0)
  DMA_K(2,2*SLOTB);
  WAIT_BAR(3);
  qkt(pA0,pA1,Kbase,qr,negm,r32,hi,kx0,kx1,qx);asm volatile("s_nop 15\n\ts_nop 7":"+v"(pA0),"+v"(pA1));CMASK(pA0,pA1,0);
  START(pA0,pA1); NEGM_SET(); TILE_NEXT();
  _Pragma("unroll") for(int r=0;r<16;++r)pA1[r]=__builtin_amdgcn_exp2f(pA1[r]);
  WAIT_BAR(0);
  DMA_K(3,0);DMA_V(1,SLOTB);
  ROT();
  kload8(kf,kp0+sl_cur);
  WAIT_BAR(2);
  s16x4 vlo[8],vhi[8]; u32x4 pw0,pw1,pw2,pw3;
  #define PKW(P,B) cvtpk_s(P[B],P[B+1])
  #define PAF(k) __builtin_bit_cast(bf16x8,pw##k)
  #define VFR(i) (bf16x8){vlo[i][0],vlo[i][1],vlo[i][2],vlo[i][3],vhi[i][0],vhi[i][1],vhi[i][2],vhi[i][3]}
  #define PIN(x) asm volatile("":"+v"(x))
  #define MX3(a,b,c) __builtin_fmaxf(__builtin_fmaxf((a),(b)),(c))
  #define GAPA(MF,A0,A1,A2,A3,W0,W1,PW) do{ MF; sacc+=A0; sacc+=A1; sacc+=A2; sacc+=A3; PIN(sacc); W0; W1; PIN(PW); SBAR(); }while(0)
  #define EX(v) __builtin_amdgcn_exp2f(v)
  #define GAPB(MF,X,B) do{ MF; X[B]=EX(X[B]); X[B+1]=EX(X[B+1]); X[B+2]=EX(X[B+2]); X[B+3]=EX(X[B+3]); PIN(X); SBAR(); }while(0)
  #define VRD(i) do{ vlo[i]=vtr(vp_+(((i)>>2)*4096+((i)&3)*1024)); vhi[i]=vtr(vp_+(((i)>>2)*4096+((i)&3)*1024+512)); }while(0)
  #define KRD(G,j) do{ if(G){ kload2(kf,kp0+sl_next,j); SBAR(); } }while(0)
  #define STEP(C0,C1,P0,P1,t,GK,GV,GL,MCUR,MNXT,GM) do{ SBAR(); \
    const lds_cptr vp_=vp0+sl_prev; \
    C0=__builtin_amdgcn_mfma_f32_32x32x16_bf16(kx0,qx,negm,0,0,0); C1=__builtin_amdgcn_mfma_f32_32x32x16_bf16(kx1,qx,negm,0,0,0); SBAR(); \
    VRD(0); SBAR(); float sacc=(P0[0]+P0[1]); \
    GAPA(C0=__builtin_amdgcn_mfma_f32_32x32x16_bf16(kf[0],qr[0],C0,0,0,0), P0[2],P0[3],P0[4],P0[5],     pw0[0]=PKW(P0,0), pw0[1]=PKW(P0,2), pw0); \
    VRD(4); SBAR(); GAPA(C1=__builtin_amdgcn_mfma_f32_32x32x16_bf16(kf[1],qr[0],C1,0,0,0), P0[6],P0[7],P0[8],P0[9],     pw0[2]=PKW(P0,4), pw0[3]=PKW(P0,6), pw0); \
    VRD(1); SBAR(); GAPA(C0=__builtin_amdgcn_mfma_f32_32x32x16_bf16(kf[2],qr[1],C0,0,0,0),   P0[10],P0[11],P0[12],P0[13], pw1[0]=PKW(P0,8), pw1[1]=PKW(P0,10), pw1); \
    VRD(5); SBAR(); GAPA(C1=__builtin_amdgcn_mfma_f32_32x32x16_bf16(kf[3],qr[1],C1,0,0,0),   P0[14],P0[15],P1[0],P1[1],   pw1[2]=PKW(P0,12),pw1[3]=PKW(P0,14), pw1); \
    VRD(2); SBAR(); GAPA(C0=__builtin_amdgcn_mfma_f32_32x32x16_bf16(kf[4],qr[2],C0,0,0,0),   P1[2],P1[3],P1[4],P1[5],     pw2[0]=PKW(P1,0), pw2[1]=PKW(P1,2), pw2); \
    VRD(6); SBAR(); GAPA(C1=__builtin_amdgcn_mfma_f32_32x32x16_bf16(kf[5],qr[2],C1,0,0,0),   P1[6],P1[7],P1[8],P1[9],     pw2[2]=PKW(P1,4), pw2[3]=PKW(P1,6), pw2); \
    VRD(3); SBAR(); GAPA(C0=__builtin_amdgcn_mfma_f32_32x32x16_bf16(kf[6],qr[3],C0,0,0,0),   P1[10],P1[11],P1[12],P1[13], pw3[0]=PKW(P1,8), pw3[1]=PKW(P1,10), pw3); \
    VRD(7); SBAR(); GAPA(C1=__builtin_amdgcn_mfma_f32_32x32x16_bf16(kf[7],qr[3],C1,0,0,0),   P1[14],P1[15],0.f,0.f,       pw3[2]=PKW(P1,12),pw3[3]=PKW(P1,14), pw3); \
    l_reg+=sacc; \
    if(GM){MLOAD(MNXT,(t)+1);} if(GK){DMA_K((t)+3,sl_cur);} if(GV){DMA_V((t)+1,sl_next);} \
    CMASK(C0,C1,MCUR); \
    { float a=MX3(C0[0],C0[1],C1[0]),b=MX3(C0[2],C0[3],C1[1]); a=MX3(a,C1[2],C1[3]); \
      _Pragma("unroll") for(int r=4;r<16;r+=4){a=MX3(a,C0[r],C0[r+1]);b=MX3(b,C0[r+2],C0[r+3]);a=MX3(a,C1[r],C1[r+1]);b=MX3(b,C1[r+2],C1[r+3]);} \
      float rm=__builtin_fmaxf(a,b); { auto rr=__builtin_amdgcn_permlane32_swap(__float_as_uint(rm),__float_as_uint(rm),false,false); rm=__builtin_fmaxf(__uint_as_float(rr[0]),__uint_as_float(rr[1])); } \
      resc=false; \
      if(__builtin_expect(__any(rm>(float)THRL),0)){ const float dl=__builtin_fmaxf(rm,0.f); mhat+=dl; \
        _Pragma("unroll") for(int r=0;r<16;++r){C0[r]-=dl;C1[r]-=dl;} \
        const float f=__builtin_amdgcn_exp2f(-dl); l_reg*=f; if(hi==0)wsf[r32]=f; resc=true; NEGM_SET(); } } \
    TILE_NEXT(); \
    SBAR(); \
    GAPB(o[0]=__builtin_amdgcn_mfma_f32_32x32x16_bf16(PAF(0),VFR(0),o[0],0,0,0), C0,0); \
    GAPB(o[1]=__builtin_amdgcn_mfma_f32_32x32x16_bf16(PAF(0),VFR(4),o[1],0,0,0), C0,4); \
    KRD(GL,0); GAPB(o[0]=__builtin_amdgcn_mfma_f32_32x32x16_bf16(PAF(1),VFR(1),o[0],0,0,0), C0,8); \
    KRD(GL,1); GAPB(o[1]=__builtin_amdgcn_mfma_f32_32x32x16_bf16(PAF(1),VFR(5),o[1],0,0,0), C0,12); \
    KRD(GL,2); GAPB(o[0]=__builtin_amdgcn_mfma_f32_32x32x16_bf16(PAF(2),VFR(2),o[0],0,0,0), C1,0); \
    KRD(GL,3); GAPB(o[1]=__builtin_amdgcn_mfma_f32_32x32x16_bf16(PAF(2),VFR(6),o[1],0,0,0), C1,4); \
    GAPB(o[0]=__builtin_amdgcn_mfma_f32_32x32x16_bf16(PAF(3),VFR(3),o[0],0,0,0), C1,8); \
    GAPB(o[1]=__builtin_amdgcn_mfma_f32_32x32x16_bf16(PAF(3),VFR(7),o[1],0,0,0), C1,12); \
    }while(0)
  int t=1;
  for(;t+5<NT;t+=2){
    STEP(pB0,pB1,pA0,pA1,t,true,true,true,256,0,true);     WAIT_BAR(2); RESC(); ROT();
    STEP(pA0,pA1,pB0,pB1,t+1,true,true,true,0,256,true);   WAIT_BAR(2); RESC(); ROT();
  }
  #define ENDW(tt) do{ if((tt)+3<NT){WAIT_BAR(2);} else if((tt)+2<NT){WAIT_BAR(1);} else {WAIT_BAR(0);} }while(0)
  for(;t+1<NT;t+=2){
    STEP(pB0,pB1,pA0,pA1,t,(t+3<NT),(t+1<NT),(t+1<NT),256,0,(t+1<NT));       ENDW(t);   RESC(); ROT();
    STEP(pA0,pA1,pB0,pB1,t+1,(t+4<NT),(t+2<NT),(t+2<NT),0,256,(t+2<NT));     ENDW(t+1); RESC(); ROT();
  }
  STEP(pB0,pB1,pA0,pA1,NT-1,false,false,false,256,0,false); RESC();
  { float sacc=pB0[0]+pB0[1]; _Pragma("unroll") for(int r=2;r<16;++r)sacc+=pB0[r]; _Pragma("unroll") for(int r=0;r<16;++r)sacc+=pB1[r]; l_reg+=sacc;
    pw0=(u32x4){PKW(pB0,0),PKW(pB0,2),PKW(pB0,4),PKW(pB0,6)};pw1=(u32x4){PKW(pB0,8),PKW(pB0,10),PKW(pB0,12),PKW(pB0,14)};pw2=(u32x4){PKW(pB1,0),PKW(pB1,2),PKW(pB1,4),PKW(pB1,6)};pw3=(u32x4){PKW(pB1,8),PKW(pB1,10),PKW(pB1,12),PKW(pB1,14)};
    SBAR(); pv(o,vb0+sl_cur,PAF(0),PAF(1),PAF(2),PAF(3)); }
  #undef PKW
  #undef PAF
  #undef VFR
  #undef PIN
  #undef MX3
  #undef GAPA
  #undef GAPB
  #undef EX
  #undef VRD
  #undef KRD
  #undef STEP
  #undef ENDW
  const bf16*Zw=Z+(rowbase+q0+wid*QBLK)*DM+h*D;
  u32x4 zq[2][2];
  #pragma unroll
  for(int i=0;i<2;++i){const bf16*zp=Zw+(long)(i*16+(lane>>2))*DM+(lane&3)*16; zq[i][0]=*(const u32x4*)zp; zq[i][1]=*(const u32x4*)(zp+8);}
  {auto rr=__builtin_amdgcn_permlane32_swap(__float_as_uint(l_reg),__float_as_uint(l_reg),false,false);l_reg=__uint_as_float(rr[0])+__uint_as_float(rr[1]);}
  if(hi==0)wsf[32+r32]=l_reg;asm volatile("s_waitcnt lgkmcnt(0)":::"memory");
  float rli[16];
  #pragma unroll
  for(int r=0;r<16;++r)rli[r]=__builtin_amdgcn_rcpf(wsf[32+crow(r,hi)]);
  { bf16*stg=(bf16*)(shm+LDS_OST)+wid*2048;
    #pragma unroll
    for(int r=0;r<16;++r){const int orow=crow(r,hi);
      #pragma unroll
      for(int d0=0;d0<2;++d0)stg[orow*64+d0*32+r32]=__float2bfloat16(o[d0][r]*rli[r]);}
    asm volatile("s_waitcnt lgkmcnt(0)":::"memory");
    #pragma unroll
    for(int i=0;i<2;++i){const int row=i*16+(lane>>2),c16=lane&3; int pk[4];
      #pragma unroll
      for(int hlf=0;hlf<2;++hlf){ const u32x4 v=*(const u32x4*)(stg+row*64+c16*16+hlf*8); const u32x4 z=zq[i][hlf]; float f[8];
        #pragma unroll
        for(int e=0;e<4;++e){ f[2*e]=__builtin_amdgcn_fmed3f(__uint_as_float(v[e]<<16)*__uint_as_float(z[e]<<16)*(float)(ATTN_OUT_FP8),-448.f,448.f);
                              f[2*e+1]=__builtin_amdgcn_fmed3f(__uint_as_float(v[e]&0xffff0000u)*__uint_as_float(z[e]&0xffff0000u)*(float)(ATTN_OUT_FP8),-448.f,448.f); }
        int p0=__builtin_amdgcn_cvt_pk_fp8_f32(f[0],f[1],0,false); p0=__builtin_amdgcn_cvt_pk_fp8_f32(f[2],f[3],p0,true);
        int p1=__builtin_amdgcn_cvt_pk_fp8_f32(f[4],f[5],0,false); p1=__builtin_amdgcn_cvt_pk_fp8_f32(f[6],f[7],p1,true);
        pk[2*hlf]=p0; pk[2*hlf+1]=p1; }
      const u32x4 w8={(unsigned)pk[0],(unsigned)pk[1],(unsigned)pk[2],(unsigned)pk[3]};
      *(u32x4*)((unsigned char*)O+((rowbase+q0+wid*QBLK+row)*(long)DM+h*D+c16*16))=w8; } }
  asm volatile("s_waitcnt lgkmcnt(0)\n\ts_barrier":::"memory");
  #undef DMA_K
  #undef DMA_V
  #undef CMASK
  #undef NEGM_SET
  #undef TILE_NEXT
  #undef MLOAD
  #undef MWORD
  #undef START
  #undef RESC
  #undef ROT
}
constexpr int ATTN_LDS_BYTES=LDS_BYTES;
#undef SBAR
#undef WAIT_BAR
}
__device__ const unsigned char att_order[128] = {127, 111, 126, 110, 125, 109, 95, 94, 93, 124, 108, 92, 123, 107, 91, 122, 106, 90, 121, 105, 89, 120, 104, 88, 119, 103, 87, 79, 78, 77, 76, 75, 74, 73, 72, 71, 118, 102, 86, 70, 117, 101, 85, 69, 116, 100, 84, 68, 63, 62, 61, 60, 59, 58, 57, 56, 55, 54, 53, 52, 115, 99, 83, 67, 51, 114, 98, 82, 66, 50, 47, 46, 45, 44, 43, 42, 41, 40, 39, 38, 37, 36, 35, 34, 113, 97, 81, 65, 49, 33, 31, 30, 29, 28, 27, 26, 25, 24, 23, 22, 21, 20, 19, 18, 17, 15, 14, 13, 12, 11, 10, 9, 8, 7, 6, 5, 4, 3, 2, 1, 112, 96, 80, 64, 48, 32, 16, 0};
#define GAS __attribute__((address_space(1)))
typedef GAS unsigned gu32;
#define RLX_AGENT __ATOMIC_RELAXED, __HIP_MEMORY_SCOPE_AGENT
#define XB_TMO      128
#define XB_XCNT(j)  (256  + 64 * (j))
#define XB_XSUB(j)  (1280 + 64 * (j))
#define XB_XGEN(j)  (2304 + 64 * (j))
#define XB_TOP      3328
#define XB_TOPGEN   3392
#define XCD_BAR_WORDS 3456
#define XB_SPIN_CAP (1u << 18)

__device__ __forceinline__ unsigned xb_ld(unsigned* p)              { return __hip_atomic_load(p, __ATOMIC_RELAXED, __HIP_MEMORY_SCOPE_AGENT); }
__device__ __forceinline__ unsigned xb_add(unsigned* p, unsigned v) { return __hip_atomic_fetch_add(p, v, __ATOMIC_RELAXED, __HIP_MEMORY_SCOPE_AGENT); }
__device__ __forceinline__ unsigned xb_xcc_id() { return (unsigned)__builtin_amdgcn_s_getreg((3 << 11) | 20) & 0xFu; }
#define XB_SPIN(cond, bar) do { unsigned _sp = 0; while (cond) { __builtin_amdgcn_s_sleep(1); \
    if ((++_sp & 255u) == 0u) { if (xb_ld(&(bar)[XB_TMO])) break; if (_sp > XB_SPIN_CAP) { atomicAdd(&(bar)[XB_TMO], 1u); break; } } } } while (0)

struct XcdBarrier {
    unsigned* bar; unsigned x;
    volatile LAS unsigned* st;
};

__device__ __forceinline__ XcdBarrier xcd_barrier_post(unsigned* bar, volatile LAS unsigned* st) {
    XcdBarrier b; b.bar = bar; b.x = xb_xcc_id(); b.st = st;
    if (threadIdx.x == 0) (void)xb_add(&bar[XB_XCNT(b.x)], 1u);
    return b;
}
__device__ __forceinline__ void xcd_barrier_complete(unsigned* bar, unsigned x, unsigned& nloc, unsigned& nx) {
    const unsigned G = gridDim.x * gridDim.y * gridDim.z;
    unsigned sum, cnt, mine, sp = 0u;
    for (;;) {
        sum = 0u; cnt = 0u; mine = 0u;
#pragma unroll
        for (unsigned j = 0; j < 16; ++j) { const unsigned c = xb_ld(&bar[XB_XCNT(j)]); sum += c; cnt += (c > 0u) ? 1u : 0u; mine = (j == x) ? c : mine; }
        if (sum == G) break;
        __builtin_amdgcn_s_sleep(1);
        if ((++sp & 255u) == 0u) { if (xb_ld(&bar[XB_TMO])) break; if (sp > XB_SPIN_CAP) { atomicAdd(&bar[XB_TMO], 1u); break; } }
    }
    nloc = mine > 0u ? mine : 1u; nx = cnt > 0u ? cnt : 1u;
}

__device__ __forceinline__ void xcd_barrier(const XcdBarrier& b) {
    asm volatile("s_waitcnt vmcnt(0)" ::: "memory");
    __syncthreads();
    if (threadIdx.x == 0) {
        unsigned* bar = b.bar;
        __builtin_amdgcn_s_waitcnt(0);
        unsigned nloc = b.st[0], nx = b.st[1];
        if (nloc == 0u) { xcd_barrier_complete(bar, b.x, nloc, nx); b.st[0] = nloc; b.st[1] = nx; }
        const unsigned old = xb_add(&bar[XB_XSUB(b.x)], 1u);
        const unsigned gen = old / nloc;
        if (old + 1u == (gen + 1u) * nloc) {
            __builtin_amdgcn_fence(__ATOMIC_RELEASE, "agent");
            asm volatile("s_waitcnt vmcnt(0)" ::: "memory");
            const unsigned og = xb_add(&bar[XB_TOP], 1u);
            const unsigned tg = og / nx;
            if (og + 1u == (tg + 1u) * nx) xb_add(&bar[XB_TOPGEN], 1u);
            else XB_SPIN(xb_ld(&bar[XB_TOPGEN]) == tg, bar);
            __builtin_amdgcn_fence(__ATOMIC_ACQUIRE, "agent");
            xb_add(&bar[XB_XGEN(b.x)], 1u);
            asm volatile("s_waitcnt vmcnt(0)" ::: "memory");
        } else {
            XB_SPIN(xb_ld(&bar[XB_XGEN(b.x)]) == gen, bar);
            __builtin_amdgcn_fence(__ATOMIC_ACQUIRE, "agent");
            asm volatile("s_waitcnt vmcnt(0)" ::: "memory");
        }
    }
    __syncthreads();
}
#ifndef N_LAUNCH_MODE
#define N_LAUNCH_MODE 1
#endif
namespace cg = cooperative_groups;
#ifndef REPS_HGL
#define REPS_HGL 1
#endif
#ifndef REPS_IDX
#define REPS_IDX 1
#endif
#ifndef REPS_CROSS
#define REPS_CROSS 1
#endif
#ifndef REPS_HGO
#define REPS_HGO 1
#endif
#ifndef G1_NOSTORE
#define G1_NOSTORE 0
#endif
#ifndef REPS_GATE
#define REPS_GATE 1
#endif
#ifndef REPS_P6
#define REPS_P6 1
#endif
#ifndef REPS_BR0
#define REPS_BR0 1
#endif
#ifndef REPS_ATT
#define REPS_ATT 1
#endif
#ifndef P5_ALIGN
#define P5_ALIGN true
#endif
#ifndef G1_ALIGN
#define G1_ALIGN true
#endif
#ifndef REPS_G1F8
#define REPS_G1F8 1
#endif
#ifndef REPS_G1IX
#define REPS_G1IX 1
#endif
#ifndef REPS_P0
#define REPS_P0 1
#endif
#ifdef PROBE_ID
#define PT0(id) do { if ((id) == PROBE_ID) pt0_ = __builtin_amdgcn_s_memrealtime(); } while (0)
#define PT1(id) do { if ((id) == PROBE_ID) pt1_ += __builtin_amdgcn_s_memrealtime() - pt0_; } while (0)
#else
#define PT0(id) do { } while (0)
#define PT1(id) do { } while (0)
#endif
using namespace hy;
constexpr size_t WS_PAIR = 53248;
struct P5OrderSync : pg8::P5Order {
    unsigned* cnt;
    __device__ __forceinline__ void done(const pg8::Unit& u) const {
        if (u.n != 5) return;
        asm volatile("s_waitcnt vmcnt(0)" ::: "memory"); __syncthreads();
        if (threadIdx.x == 0) { __builtin_amdgcn_fence(__ATOMIC_RELEASE, "agent"); asm volatile("s_waitcnt vmcnt(0)" ::: "memory"); (void)xb_add(cnt + 16 * u.pm, 1u); }
    }
};
#ifdef G1_RDV
struct SkipOrderR : pg8::SkipOrder {
    unsigned* xc; unsigned nloc;
    __device__ bool next(int i, pg8::Unit& u) const { if (!pg8::SkipOrder::next(i, u)) return false; u.n = i; return true; }
    __device__ __forceinline__ void done(const pg8::Unit& u) const {
        if ((u.n % G1_RDV) != G1_RDV - 1) return;
        const unsigned gen = (unsigned)(u.n / G1_RDV) + 1u;
        __syncthreads();
        if (threadIdx.x == 0) { (void)xb_add(xc, 1u); unsigned sp = 0; while (xb_ld(xc) < nloc * gen && ++sp < (1u << 22)) __builtin_amdgcn_s_sleep(1); }
        __syncthreads();
    }
};
#endif
#ifdef P5_TPROBE
struct P5OrderT : pg8::P5Order {
    unsigned long long* acc; unsigned long long* last;
    __device__ __forceinline__ void done(const pg8::Unit& u) const { const unsigned long long now = __builtin_amdgcn_s_memrealtime(); if ((u.n & 1) == P5_TPROBE) *acc += now - *last; *last = now; }
};
#endif
struct P6Order : pg8::StaticOrder {
    unsigned* cnt;
    __device__ __forceinline__ void a_ready(const pg8::Unit& u) const {
        unsigned sp = 0; while (xb_ld(cnt + 16 * u.pm) < 4u && ++sp < (1u << 24)) __builtin_amdgcn_s_sleep(2);
        __builtin_amdgcn_fence(__ATOMIC_ACQUIRE, "agent"); asm volatile("s_waitcnt vmcnt(0)" ::: "memory");
    }
};
struct Args { const float* in[14]; float* out; unsigned char* ws; };
constexpr int NPHASE = 7;

template <int PH> __global__ void __launch_bounds__(512, 2) fwd_kernel(Args args) {
    extern __shared__ __attribute__((aligned(16))) unsigned char lds_raw[];
    unsigned long long pt0_ = 0, pt1_ = 0; (void)pt0_; (void)pt1_; PT0(31);
    Ctx C;
    C.out = args.out; C.ws = args.ws; C.lds = (LAS unsigned char*)lds_raw;
    C.tid = threadIdx.x; C.lane = C.tid & 63; C.wave = __builtin_amdgcn_readfirstlane(C.tid >> 6); C.G = gridDim.x; C.bid = blockIdx.x;
#ifndef PHASE_MASK
#define PHASE_MASK 0x7f
#endif
#define IN(k) (((PHASE_MASK >> (k)) & 1) && (PH < 0 || PH == (k)))
    volatile LAS unsigned* bar_st = (volatile LAS unsigned*)(C.lds + LDS_BYTES - 16);
    if (C.tid < 4) bar_st[C.tid] = 0u;
    __syncthreads();
    XcdBarrier bar = xcd_barrier_post((unsigned*)C.ws + 4096, bar_st);
#define QNEXT(qi, var) do { volatile LAS unsigned* qs_ = (volatile LAS unsigned*)(C.lds + LDS_BYTES - 8); if (C.tid == 0) *qs_ = atomicAdd((unsigned*)(C.ws + 36864) + 64 * (qi), 1u); \
        __syncthreads(); var = *qs_; __syncthreads(); } while (0)
#ifdef DUP_BAR
#define SEAM(k) do { if (IN(k) && IN((k) + 1)) { xcd_barrier(bar); xcd_barrier(bar); } } while (0)
#else
#define SEAM(k) do { if (IN(k) && IN((k) + 1)) { xcd_barrier(bar); } } while (0)
#endif
    bf16_t* LcT = (bf16_t*)((unsigned char*)C.out + OUT_LCT); bf16_t* SinT = (bf16_t*)((unsigned char*)C.out + OUT_SINT); bf16_t* OA = WSP(WS_H);     float* DEC = (float*)(C.ws + WS_DEC);

#define SPLIT_ARRIVE(e) do { asm volatile("s_waitcnt vmcnt(0)" ::: "memory"); __syncthreads(); \
        if (C.tid == 0) { const unsigned nloc_ = bar_st[0]; unsigned* xc_ = (unsigned*)(C.ws + 59392 + 1024 * (e)) + 16 * bar.x; \
            if (xb_add(xc_, 1u) + 1u == nloc_) { __builtin_amdgcn_fence(__ATOMIC_RELEASE, "agent"); asm volatile("s_waitcnt vmcnt(0)" ::: "memory"); (void)xb_add((unsigned*)(C.ws + 36864) + 64 * (8 + (e)), nloc_); } } } while (0)
#define SPLIT_WAIT(e) do { if (C.tid == 0) { XB_SPIN(xb_ld((unsigned*)(C.ws + 36864) + 64 * (8 + (e))) < (unsigned)C.G, bar.bar); __builtin_amdgcn_fence(__ATOMIC_ACQUIRE, "agent"); asm volatile("s_waitcnt vmcnt(0)" ::: "memory"); } \
        __syncthreads(); } while (0)
    PT0(0);
    if (IN(0)) for (int rep_ = 0; rep_ < REPS_P0; ++rep_) { if (rep_) __syncthreads();
#ifdef PROBE_ID
        if (PROBE_ID == 50) {
#ifndef PRB_R
#define PRB_R 2
#endif
            PT0(50); const int gw_ = C.bid * NWAVES + C.wave, NGW_ = C.G * NWAVES; float acc_ = 0.f;
            for (int m = gw_; m < T; m += PRB_R * NGW_) { f32x4 v_[PRB_R][4];
#pragma unroll
                for (int r = 0; r < PRB_R; ++r) { const f32x4* xr = (const f32x4*)(args.in[0] + (size_t)(m + r * NGW_) * DM) + C.lane;
#pragma unroll
                    for (int j = 0; j < 4; ++j) v_[r][j] = xr[64 * j]; }
#pragma unroll
                for (int r = 0; r < PRB_R; ++r)
#pragma unroll
                    for (int j = 0; j < 4; ++j) acc_ += v_[r][j].x + v_[r][j].y + v_[r][j].z + v_[r][j].w; }
            if (acc_ == 123.456f) ((float*)(C.ws + 510 * MiB))[gw_] = acc_;
            PT1(50); __syncthreads(); }
        if (PROBE_ID == 51) {
            PT0(51); const int gw_ = C.bid * NWAVES + C.wave, NGW_ = C.G * NWAVES;
            for (int m = gw_; m < T; m += 2 * NGW_) {
#pragma unroll
                for (int r = 0; r < 2; ++r) { const int mr = m + r * NGW_; u32x2* o8 = (u32x2*)(C.ws + WS_KA + (size_t)mr * 2048) + C.lane; unsigned* o4 = (unsigned*)(C.ws + WS_ZA + (size_t)mr * 1024) + C.lane;
#pragma unroll
                    for (int j = 0; j < 4; ++j) { o8[64 * j] = (u32x2){(unsigned)mr, (unsigned)j}; o4[64 * j] = (unsigned)mr; } } }
            PT1(51); __syncthreads(); }
        PT0(21); p0_prologue(C, args.in[0], args.in[1], args.in[2], args.in[3], args.in[4], args.in[9], args.in[12], args.in[13], args.in[7], 1); PT1(21); PT0(22); p0_prologue(C, args.in[0], args.in[1], args.in[2], args.in[3], args.in[4], args.in[9], args.in[12], args.in[13], args.in[7], 2); PT1(22); }
#else
#ifdef P0_MIX
        { const int first = (C.bid & 1) ? 2 : 1;
          p0_prologue(C, args.in[0], args.in[1], args.in[2], args.in[3], args.in[4], args.in[9], args.in[12], args.in[13], args.in[7], first);
          p0_prologue(C, args.in[0], args.in[1], args.in[2], args.in[3], args.in[4], args.in[9], args.in[12], args.in[13], args.in[7], 3 - first); } }
#else
        p0_prologue(C, args.in[0], args.in[1], args.in[2], args.in[3], args.in[4], args.in[9], args.in[12], args.in[13], args.in[7]); }
#endif
#endif

    PT0(40); SEAM(0); PT1(40); PT1(0); PT0(1);
    if (IN(1))
    {
#if IDX_FP8
        { pg8::Gemm g{WSP(WS_H8), (const bf16_t*)(C.ws + WS_W8), T, N1, DM / 2}; pg8::SkipOrder S; S.so.init(T, N1, C.G, C.bid); S.lo = 1 << 20; S.skip = 0; EpiP1 E{C.ws, args.in[5], args.in[6]};
#else
#ifdef G1_RDV
        { pg8::Gemm g{WSP(WS_H8), (const bf16_t*)(C.ws + WS_W8), T, N1 - (IX_HI - IX_LO), DM / 2}; SkipOrderR S; S.so.init(T, N1 - (IX_HI - IX_LO), C.G, C.bid); S.lo = IX_LO / 256; S.skip = (IX_HI - IX_LO) / 256; S.xc = (unsigned*)(C.ws + 53248) + 16 * bar.x; S.nloc = bar_st[0]; EpiP1 E{C.ws, args.in[5], args.in[6]};
#else
        { pg8::Gemm g{WSP(WS_H8), (const bf16_t*)(C.ws + WS_W8), T, N1 - (IX_HI - IX_LO), DM / 2}; pg8::SkipOrder S; S.so.init(T, N1 - (IX_HI - IX_LO), C.G, C.bid); S.lo = IX_LO / 256; S.skip = (IX_HI - IX_LO) / 256; EpiP1F8 E{C.ws, args.in[5], args.in[6]};
#endif
#endif
#ifdef G1_STAGGER
          if (C.bid & 4) { const unsigned long long t0_ = __builtin_amdgcn_s_memrealtime(); while (__builtin_amdgcn_s_memrealtime() - t0_ < (unsigned long long)(G1_STAGGER)) __builtin_amdgcn_s_sleep(4); }
#endif
          PT0(10); for (int rep_ = 0; rep_ < REPS_G1F8; ++rep_) { E.nostore = (rep_ > 0) && G1_NOSTORE;
#ifdef G1_NODMA
              g.nodma = rep_ > 0; pg8::gemm_phase<EpiP1, pg8::SkipOrder, true, true, true, G1_NODMA>(C.lds, g, S, E); } PT1(10); }
#else
#ifdef G1_RDV
              pg8::gemm_phase<EpiP1, SkipOrderR, true, true, true>(C.lds, g, S, E); } PT1(10); }
#else
              pg8::gemm_phase<EpiP1F8, pg8::SkipOrder, G1_ALIGN, true, true>(C.lds, g, S, E); } PT1(10); }
#endif
#endif
        SPLIT_ARRIVE(3);
        if (!IDX_FP8)
        { pg8::Gemm g{WSP(WS_H), WSP(WS_WIX), T, IX_HI - IX_LO, DM}; pg8::SkipOrder S; S.so.init(T, IX_HI - IX_LO, C.G, C.bid); S.lo = 0; S.skip = IX_LO / 256; EpiP1 E{C.ws, args.in[5], args.in[6]};
          for (int rep_ = 0; rep_ < REPS_G1IX; ++rep_) pg8::gemm_phase<EpiP1, pg8::SkipOrder, true, true>(C.lds, g, S, E); }
        if (C.G == 256 ? (C.bid >= 128) : true) { const int G2 = (C.G == 256) ? 128 : C.G, c2 = (C.G == 256) ? C.bid - 128 : C.bid;
          { pg8::Gemm g{WSP(WS_HM), WSP(WS_WM), TM, 512, DM}; pg8::StaticOrder S; S.init(TM, 512, G2, c2); EpiPlain<0> E{WSP(WS_MKV), 512};
            pg8::gemm_phase<EpiPlain<0>, pg8::StaticOrder, true, true>(C.lds, g, S, E); }
          { const int c3 = (c2 + G2 - 16) % G2;
            pg8::Gemm g{WSP(WS_WM) + (size_t)512 * DM, WSP(WS_HM), 512, TM, DM}; pg8::StaticOrder S; S.init(512, TM, G2, c3); EpiPlain<0> E{WSP(WS_MKVT), TM};
            pg8::gemm_phase<EpiPlain<0>, pg8::StaticOrder, true, true>(C.lds, g, S, E); } }
    }
    if (IN(1)) SPLIT_ARRIVE(4);
    PT1(1); PT0(2);
    if (IN(2)) {
        const int gw = C.bid * NWAVES + C.wave, NGW = C.G * NWAVES;
        SPLIT_WAIT(3);
        PT0(12);
        { int u0, ustep, ucnt;
          if (C.G == 256) { if (C.bid < 160) { u0 = C.bid; ucnt = 5; ustep = 160; } else { u0 = 800 + (C.bid - 160); ucnt = 13; ustep = 96; } }
          else { u0 = C.bid; ustep = C.G; ucnt = (2048 - C.bid + C.G - 1) / C.G; }
          HgIn R; if (ucnt > 0) { hg_ld16(C, WSP(WS_FB), u0, R.fb0, R.fb1); hg_ldiv(C, u0, R.iv); }
          hgrn_lbt_to_lds(C);
          for (int j = 0; j < ucnt; ++j) { const int u = u0 + j * ustep; hgrn_local_unit(C, u, (j + 1 < ucnt) ? u + ustep : u, R, LcT, DEC, args.in[7]); } }
        SPLIT_ARRIVE(0);
        SPLIT_WAIT(4);
        norm_rows_inplace(WSP(WS_MKV), 512, TM, 128, args.in[11], 1.f, gw, NGW, C.lane);
        SPLIT_ARRIVE(5);
        PT1(12); PT0(13);
        for (int rep_ = 0; rep_ < REPS_IDX; ++rep_)
        for (int i = 0;; ++i) { const int idx = i * C.G + ((i & 1) ? (C.G - 1 - C.bid) : C.bid); if (idx >= 2048) break; indexer_unit(C, idx & 7, 255 - (idx >> 3)); }
    }
    if (IN(2)) SPLIT_ARRIVE(1);
    PT1(13); PT1(2); PT0(3);
    if (IN(3)) {
        SPLIT_WAIT(0);
        PT0(14); hgrn_scan(C, LcT, DEC, SinT); PT1(14);
        SPLIT_ARRIVE(2);
    }
    PT1(3); PT0(4);
    if (IN(4)) {
        PT0(16);
        bool masks_ready = false, keys_ready = false;
        float Abound;
        { const float gq = fabsf(args.in[5][C.lane]), gk = fabsf(args.in[6][C.lane]);
          Abound = __uint_as_float(__builtin_amdgcn_readfirstlane(__float_as_uint(__uint_as_float(wave_max_dpp(__float_as_uint(gq))) * __uint_as_float(wave_max_dpp(__float_as_uint(gk))) * (64.f * C2A * 1.02f) * 2.f + 32.f))); }
        for (int rep_ = 0; rep_ < REPS_ATT; ++rep_)
        for (;;) {
            unsigned ui; QNEXT(rep_, ui);
            if (ui < 256u) { if (!keys_ready) { SPLIT_WAIT(5); keys_ready = true; } cross_unit(C, ui >> 5, (ui >> 3) & 3, ui & 7, args.in[10]); continue; }
            ui -= 256u;
            if (ui >= 1024u) break;
            if (!masks_ready) { SPLIT_WAIT(1); masks_ready = true; }
            const int combo = att_order[ui >> 3], b = ui & 7, h = combo >> 4, qb = combo & 15;
            const float sl2 = ex2(-(float)(h + 1)) * LOG2E;
            int tstart;
            {
              const unsigned lv = wave_max_dpp(C.lane < 16 ? ((const unsigned*)(C.ws + WS_LMINV))[b * 256 + qb * 16 + C.lane] : 0u);
              const float lim = (float)(4095 - (int)lv) - Abound / sl2 + 1.f;
              int ts = lim > 0.f ? ((int)(lim * (1.f / 64.f))) & ~1 : 0; const int ntl = 4 * (qb + 1);
              ts = ts > ntl - 4 ? ntl - 4 : ts; tstart = __builtin_amdgcn_readfirstlane(ts); }
            attn_a::attn_unit<8>(b, h, qb, (const attn_a::bf16*)WSP(WS_QA), (const attn_a::bf16*)WSP(WS_KA), (const attn_a::bf16*)WSP(WS_VA), (attn_a::bf16*)OA, (const attn_a::bf16*)WSP(WS_ZA),
                                 (const unsigned long long*)(C.ws + WS_MASK), sl2, tstart, (char*)lds_raw);
        }
        PT1(16);
        if (IN(3)) SPLIT_WAIT(2);
        PT0(17);
        for (int rep_ = 0; rep_ < REPS_HGO; ++rep_)
        { hgrn_lbt_to_lds(C, args.in[8]);
          HgOIn R; if (C.bid < 2048) { hg_ld16(C, WSP(WS_FB), C.bid, R.fb0, R.fb1); hg_ld16(C, WSP(WS_QB), C.bid, R.qb0, R.qb1); hg_ldiv(C, C.bid, R.iv); hg_ldsf(C, SinT, C.bid, R.sf); hg_ld16(C, WSP(WS_GB), C.bid, R.gb0, R.gb1); }
          for (int u = C.bid; u < 2048; u += C.G) hgrn_out_unit(C, u, (u + C.G < 2048) ? u + C.G : u, R, SinT, args.in[7], args.in[8]); }
    }
    PT1(17); PT0(44); SEAM(4); PT1(44); PT1(4); PT0(5);
    static_assert(O8_SCALE == (float)(ATTN_OUT_FP8), "attention output scale");
#ifndef P5_SEPARATE
    if (IN(5))
    {
        pg8::Gemm g{nullptr, nullptr, T, DM, DM / 2}; g.K2 = 256;
#ifdef P56_SYNC
        P5OrderSync S; S.cnt = (unsigned*)(C.ws + WS_PAIR);
#elif defined(P5_TPROBE)
        unsigned long long tlast_ = __builtin_amdgcn_s_memrealtime(); P5OrderT S; S.acc = &pt1_; S.last = &tlast_;
#else
        pg8::P5Order S;
#endif
        S.init(T, DM, C.G, C.bid); S.base = (const char*)C.ws;
        S.a_gate = (long)WS_H8; S.a_b0 = (long)WS_H; S.a_b1 = (long)WS_O8B; S.a_b2 = (long)WS_O8C; S.b_gate = (long)WS_WG8; S.b_br = (long)WS_WB; S.sb_gate = (long)DM * DM; S.sb_br = (long)DM * 512;
        EpiP5 E{C.ws};
#ifdef P56_SYNC
        pg8::gemm_phase<EpiP5, P5OrderSync, true, true, true, 0, true>(C.lds, g, S, E);
#elif defined(P5_TPROBE)
        pg8::gemm_phase<EpiP5, P5OrderT, true, true, true, 0, true>(C.lds, g, S, E);
#else
        pg8::gemm_phase<EpiP5, pg8::P5Order, P5_ALIGN, true, true, 0, true>(C.lds, g, S, E);
#endif
    }
#else
    if (IN(5))
    {
#pragma unroll 1
        for (int n = 0; n < 3; ++n) {
            { pg8::Gemm g{WSP(WS_H8), (const bf16_t*)(C.ws + WS_WG8 + (size_t)n * DM * DM), T, DM, DM / 2}; pg8::StaticOrder S; S.init(T, DM, C.G, C.bid); EpiPlain<3> E{WSP(WS_G), DM};
              PT0(18); for (int rep_ = 0; rep_ < REPS_GATE; ++rep_) pg8::gemm_phase<EpiPlain<3>, pg8::StaticOrder, true, true, true>(C.lds, g, S, E); PT1(18); }
            { const bf16_t* br = (n == 0) ? OA : (n == 1) ? WSP(WS_O8B) : WSP(WS_O8C);
              pg8::Gemm g{br, (const bf16_t*)(C.ws + WS_WB + (size_t)n * DM * 512), T, DM, 256}; pg8::StaticOrder S; S.init(T, DM, C.G, C.bid); PT0(19);
              if (n < 2) { EpiMerge<false> E{WSP(WS_G), WSP(WS_MB), n == 0 ? 1 : 0, nullptr}; for (int rep_ = 0; rep_ < (n == 0 ? REPS_BR0 : 1); ++rep_) pg8::gemm_phase<EpiMerge<false>, pg8::StaticOrder, true, true, true>(C.lds, g, S, E); }
              else { EpiMerge<true> E{WSP(WS_G), WSP(WS_MB), 0, C.ws + WS_M8}; pg8::gemm_phase<EpiMerge<true>, pg8::StaticOrder, true, true, true>(C.lds, g, S, E); } PT1(19); }
        }
    }
#endif
#if defined(P5_SEPARATE) || !defined(P56_SYNC)
    PT0(45); SEAM(5); PT1(45);
#endif
    PT1(5); PT0(6);
    if (IN(6))
    {
        pg8::Gemm g{WSP(WS_M8), WSP(WS_WO), T, DM, DM / 2}; EpiOut E{args.in[0], C.out};
#if defined(P5_SEPARATE) || !defined(P56_SYNC)
        pg8::StaticOrder S; S.init(T, DM, C.G, C.bid);
#ifdef P6_STAGGER
        if (C.bid & 4) { const unsigned long long t0_ = __builtin_amdgcn_s_memrealtime(); while (__builtin_amdgcn_s_memrealtime() - t0_ < (unsigned long long)(P6_STAGGER)) __builtin_amdgcn_s_sleep(4); }
#endif
        for (int rep_ = 0; rep_ < REPS_P6; ++rep_) pg8::gemm_phase<EpiOut, pg8::StaticOrder, true, true, true>(C.lds, g, S, E);
#else
        P6Order S; S.init(T, DM, C.G, C.bid); S.cnt = (unsigned*)(C.ws + WS_PAIR);
        pg8::gemm_phase<EpiOut, P6Order, true, true, true>(C.lds, g, S, E);
#endif
    }
    PT1(6); PT1(31);
#ifdef PROBE_ID
    if (blockIdx.x == 0 && threadIdx.x == 0) { const unsigned long long te_ = __builtin_amdgcn_s_memrealtime(), d_ = pt1_; while (__builtin_amdgcn_s_memrealtime() - te_ < d_) __builtin_amdgcn_s_sleep(8); }
#endif
#undef IN
#undef SEAM
}

extern "C" void kernel_launch(void* const* d_in, const int* in_sizes, int n_in, void* d_out, int out_size, void* d_ws, size_t ws_size, hipStream_t stream) {
    static int grid = 0;
    if (grid == 0) {
        if (n_in != 14 || out_size != T * DM || ws_size < WS_END) { fprintf(stderr, "kernel_launch: unexpected problem shape (n_in %d out %d ws %zu)\n", n_in, out_size, ws_size); grid = -1; return; }
        int dev = 0, cus = 0, per_cu = 0;
        hipGetDevice(&dev); hipDeviceGetAttribute(&cus, hipDeviceAttributeMultiprocessorCount, dev);
#if N_LAUNCH_MODE == 1
        if (hipFuncSetAttribute((const void*)fwd_kernel<-1>, hipFuncAttributeMaxDynamicSharedMemorySize, LDS_BYTES) != hipSuccess) { fprintf(stderr, "kernel_launch: hipFuncSetAttribute failed\n"); grid = -1; return; }
        hipOccupancyMaxActiveBlocksPerMultiprocessor(&per_cu, (const void*)fwd_kernel<-1>, NTHR, LDS_BYTES);
        (void)hipGetLastError();
#endif
        if (per_cu < 1) per_cu = 1;
        grid = cus;
    }
    if (grid < 0) return;
#ifdef MEMSET_TWICE
    (void)hipMemsetAsync((char*)d_ws + 65536, 0, 65536, stream);
#endif
    if (hipMemsetAsync(d_ws, 0, 65536, stream) != hipSuccess) { fprintf(stderr, "kernel_launch: hipMemsetAsync failed\n"); return; }
    Args a{};
    for (int i = 0; i < 14; ++i) a.in[i] = (const float*)d_in[i];
    a.out = (float*)d_out; a.ws = (unsigned char*)d_ws;
#if N_LAUNCH_MODE == 1
    void* kargs[] = {&a};
#ifdef HOST_TWICE
    (void)hipLaunchCooperativeKernel((const void*)fwd_kernel<-1>, dim3(grid), dim3(NTHR), kargs, LDS_BYTES, stream);
    (void)hipMemsetAsync(d_ws, 0, 65536, stream);
#endif
#ifdef PLAIN_LAUNCH
    (void)kargs; hipLaunchKernelGGL(fwd_kernel<-1>, dim3(grid), dim3(NTHR), LDS_BYTES, stream, a);
#else
    hipError_t e = hipLaunchCooperativeKernel((const void*)fwd_kernel<-1>, dim3(grid), dim3(NTHR), kargs, LDS_BYTES, stream);
    if (e != hipSuccess) fprintf(stderr, "kernel_launch: cooperative launch failed: %s (grid %d)\n", hipGetErrorString(e), grid);
#endif
#else
#define LAUNCH_PH(p) do { (void)hipFuncSetAttribute((const void*)fwd_kernel<p>, hipFuncAttributeMaxDynamicSharedMemorySize, LDS_BYTES); hipLaunchKernelGGL(fwd_kernel<p>, dim3(grid), dim3(NTHR), LDS_BYTES, stream, a); } while (0)
    LAUNCH_PH(0); LAUNCH_PH(1); LAUNCH_PH(2); LAUNCH_PH(3); LAUNCH_PH(4); LAUNCH_PH(5); LAUNCH_PH(6);
#endif
}
```
